# Optimizing an MI355X kernel written in HIP

```python
import math
import jax, jax.numpy as jnp
from jax import lax
import numpy as np

D_MODEL = 1024
BATCH = 2
SEQ = 16384
DEPTH = 2

FOX_HEADS = 8
FOX_HEAD_DIM = 64
DIFF_HEADS = 4
DIFF_HEAD_DIM = 64
DIFF_V_DIM = 2 * DIFF_HEAD_DIM
FOX_WIDTH = FOX_HEADS * FOX_HEAD_DIM
DIFF_WIDTH = DIFF_HEADS * DIFF_V_DIM
MIX_WIDTH = FOX_WIDTH + DIFF_WIDTH
D_FF = 2816
Q_BLOCK = 128
ROPE_THETA = 10000.0
NORM_EPS = 1e-5
FFN_RES_WEIGHT = 0.5
IN_SPLITS = [FOX_WIDTH, FOX_WIDTH, FOX_WIDTH, FOX_HEADS,
             2 * DIFF_HEADS * DIFF_HEAD_DIM, 2 * DIFF_HEADS * DIFF_HEAD_DIM, DIFF_WIDTH]
IN_COLS = int(sum(IN_SPLITS))
IN_OFFSETS = [int(v) for v in np.cumsum(IN_SPLITS)[:-1]]

kernel_name = "hymba_fox_diffattn_macaron"


def _rmsnorm(x, gain):
    x32 = x.astype(jnp.float32)
    y = x32 * lax.rsqrt(jnp.mean(x32 * x32, axis=-1, keepdims=True) + NORM_EPS)
    return (y * gain.astype(jnp.float32)).astype(x.dtype)


def _swiglu(h, w_gate_up, w_down):
    g, u = jnp.split(h @ w_gate_up, 2, axis=-1)
    return (jax.nn.silu(g) * u) @ w_down


def _rope_tables(seq, dim):
    inv_freq = 1.0 / (ROPE_THETA ** (jnp.arange(0, dim, 2, dtype=jnp.float32) / dim))
    pos = jnp.arange(seq, dtype=jnp.float32)
    freqs = pos[:, None] * inv_freq[None, :]
    emb = jnp.concatenate([freqs, freqs], axis=-1)
    return jnp.cos(emb), jnp.sin(emb)


def _apply_rope(t, cos, sin):
    t32 = t.astype(jnp.float32)
    t1, t2 = jnp.split(t32, 2, axis=-1)
    rot = jnp.concatenate([-t2, t1], axis=-1)
    return (t32 * cos + rot * sin).astype(t.dtype)


def _causal_block_attention(q_f, k_f, v_f, cum_f, q_d, k_d, v_d, lam):
    B, Hf, S, Df = q_f.shape
    Hd, Dh = q_d.shape[1], q_d.shape[-1]
    Dv = v_d.shape[-1]
    nb = S // Q_BLOCK
    qf_blk = jnp.moveaxis(q_f.reshape(B, Hf, nb, Q_BLOCK, Df), 2, 0)
    cf_blk = jnp.moveaxis(cum_f.reshape(B, Hf, nb, Q_BLOCK), 2, 0)
    qd_blk = jnp.moveaxis(q_d.reshape(B, Hd, 2, nb, Q_BLOCK, Dh), 3, 0)
    k_pos = jnp.arange(S)
    scale_f = Df ** -0.5
    scale_d = Dh ** -0.5

    def one_block(args):
        qf, cf, qd, blk = args
        q_pos = blk * Q_BLOCK + jnp.arange(Q_BLOCK)
        causal = k_pos[None, :] <= q_pos[:, None]
        s_f = jnp.einsum('bhqd,bhkd->bhqk', qf, k_f).astype(jnp.float32) * scale_f
        s_f = s_f + cf[..., :, None] - cum_f[..., None, :]
        s_f = jnp.where(causal, s_f, -jnp.inf)
        p_f = jax.nn.softmax(s_f, axis=-1)
        o_f = jnp.einsum('bhqk,bhkd->bhqd', p_f.astype(v_f.dtype), v_f)
        s_d = jnp.einsum('bhcqd,bhckd->bhcqk', qd, k_d).astype(jnp.float32) * scale_d
        s_d = jnp.where(causal, s_d, -jnp.inf)
        p_d = jax.nn.softmax(s_d, axis=-1)
        a_d = p_d[:, :, 0] - lam * p_d[:, :, 1]
        o_d = jnp.einsum('bhqk,bhkd->bhqd', a_d.astype(v_d.dtype), v_d)
        return o_f, o_d

    o_f, o_d = lax.map(one_block, (qf_blk, cf_blk, qd_blk, jnp.arange(nb)))
    o_f = jnp.moveaxis(o_f, 0, 2).reshape(B, Hf, S, Df)
    o_d = jnp.moveaxis(o_d, 0, 2).reshape(B, Hd, S, Dv)
    return o_f, o_d


def _hybrid_mixer(h, w_in, forget_bias, lq1, lk1, lq2, lk2, subln, w_out, lambda_init):
    B, S, _ = h.shape
    proj = h @ w_in
    fq, fk, fv, ff, dq, dk, dv = jnp.split(proj, IN_OFFSETS, axis=-1)
    to_heads_f = lambda t: t.reshape(B, S, FOX_HEADS, FOX_HEAD_DIM).transpose(0, 2, 1, 3)
    q_f, k_f, v_f = to_heads_f(fq), to_heads_f(fk), to_heads_f(fv)
    log_f = jax.nn.log_sigmoid((ff + forget_bias).astype(jnp.float32))
    cum_f = jnp.cumsum(log_f.transpose(0, 2, 1), axis=-1)
    to_heads_d = lambda t: t.reshape(B, S, DIFF_HEADS, 2, DIFF_HEAD_DIM).transpose(0, 2, 3, 1, 4)
    cos, sin = _rope_tables(S, DIFF_HEAD_DIM)
    q_d = _apply_rope(to_heads_d(dq), cos, sin)
    k_d = _apply_rope(to_heads_d(dk), cos, sin)
    v_d = dv.reshape(B, S, DIFF_HEADS, DIFF_V_DIM).transpose(0, 2, 1, 3)
    lam = (jnp.exp(jnp.sum(lq1.astype(jnp.float32) * lk1.astype(jnp.float32)))
           - jnp.exp(jnp.sum(lq2.astype(jnp.float32) * lk2.astype(jnp.float32)))
           + lambda_init)
    o_f, o_d = _causal_block_attention(q_f, k_f, v_f, cum_f, q_d, k_d, v_d, lam)
    o_d = _rmsnorm(o_d, subln) * (1.0 - lambda_init)
    o_f = o_f.transpose(0, 2, 1, 3).reshape(B, S, FOX_WIDTH)
    o_d = o_d.transpose(0, 2, 1, 3).reshape(B, S, DIFF_WIDTH)
    return jnp.concatenate([o_f, o_d], axis=-1) @ w_out


def setup_inputs(seed: int = 0) -> dict:
    key = jax.random.key(seed)
    ks = jax.random.split(key, 20)
    nrm = lambda k, shape, fan_in: jax.random.normal(k, shape, jnp.float32) * fan_in ** -0.5
    gain = lambda k, shape: 1.0 + 0.02 * jax.random.normal(k, shape, jnp.float32)
    return {
        "x": jax.random.normal(ks[0], (BATCH, SEQ, D_MODEL), jnp.float32),
        "ffn1_norm": gain(ks[1], (DEPTH, D_MODEL)),
        "ffn1_w_gate_up": nrm(ks[2], (DEPTH, D_MODEL, 2 * D_FF), D_MODEL),
        "ffn1_w_down": nrm(ks[3], (DEPTH, D_FF, D_MODEL), D_FF),
        "mix_norm": gain(ks[4], (DEPTH, D_MODEL)),
        "w_in": nrm(ks[5], (DEPTH, D_MODEL, IN_COLS), D_MODEL),
        "forget_bias": jax.random.uniform(ks[6], (DEPTH, FOX_HEADS), jnp.float32, 1.0, 4.0),
        "lambda_q1": 0.1 * jax.random.normal(ks[7], (DEPTH, DIFF_HEAD_DIM), jnp.float32),
        "lambda_k1": 0.1 * jax.random.normal(ks[8], (DEPTH, DIFF_HEAD_DIM), jnp.float32),
        "lambda_q2": 0.1 * jax.random.normal(ks[9], (DEPTH, DIFF_HEAD_DIM), jnp.float32),
        "lambda_k2": 0.1 * jax.random.normal(ks[10], (DEPTH, DIFF_HEAD_DIM), jnp.float32),
        "diff_subln": gain(ks[11], (DEPTH, DIFF_V_DIM)),
        "w_out": nrm(ks[12], (DEPTH, MIX_WIDTH, D_MODEL), MIX_WIDTH),
        "ffn2_norm": gain(ks[13], (DEPTH, D_MODEL)),
        "ffn2_w_gate_up": nrm(ks[14], (DEPTH, D_MODEL, 2 * D_FF), D_MODEL),
        "ffn2_w_down": nrm(ks[15], (DEPTH, D_FF, D_MODEL), D_FF),
        "final_norm": gain(ks[16], (D_MODEL,)),
    }


def reference(x, ffn1_norm, ffn1_w_gate_up, ffn1_w_down, mix_norm, w_in, forget_bias,
              lambda_q1, lambda_k1, lambda_q2, lambda_k2, diff_subln, w_out,
              ffn2_norm, ffn2_w_gate_up, ffn2_w_down, final_norm):
    for layer in range(DEPTH):
        lambda_init = 0.8 - 0.6 * math.exp(-0.3 * layer)
        x = x + FFN_RES_WEIGHT * _swiglu(_rmsnorm(x, ffn1_norm[layer]),
                                         ffn1_w_gate_up[layer], ffn1_w_down[layer])
        x = x + _hybrid_mixer(_rmsnorm(x, mix_norm[layer]), w_in[layer], forget_bias[layer],
                              lambda_q1[layer], lambda_k1[layer], lambda_q2[layer],
                              lambda_k2[layer], diff_subln[layer], w_out[layer], lambda_init)
        x = x + FFN_RES_WEIGHT * _swiglu(_rmsnorm(x, ffn2_norm[layer]),
                                         ffn2_w_gate_up[layer], ffn2_w_down[layer])
    return _rmsnorm(x, final_norm)
```

```cpp
#include <hip/hip_runtime.h>
#include <cstdio>
#include <cstdint>
template <int CTRL> __device__ __forceinline__ float dpp_f(float v) { return __builtin_bit_cast(float, __builtin_amdgcn_update_dpp(0, __builtin_bit_cast(int, v), CTRL, 0xf, 0xf, true)); }
__device__ __forceinline__ float row16_sum(float v) { v += dpp_f<0xB1>(v); v += dpp_f<0x4E>(v); v += dpp_f<0x141>(v); v += dpp_f<0x140>(v); return v; }
__device__ __forceinline__ float row16_max(float v) { v = fmaxf(v, dpp_f<0xB1>(v)); v = fmaxf(v, dpp_f<0x4E>(v)); v = fmaxf(v, dpp_f<0x141>(v)); v = fmaxf(v, dpp_f<0x140>(v)); return v; }
__device__ __forceinline__ float sum_x16_x32(float v) {
    float a = v, b = v; asm volatile("s_nop 1\n\tv_permlane16_swap_b32 %0, %1" : "+v"(a), "+v"(b)); v = a + b;
    a = v; b = v;       asm volatile("s_nop 1\n\tv_permlane32_swap_b32 %0, %1" : "+v"(a), "+v"(b)); return a + b; }
__device__ __forceinline__ float wave_sum_u(float v) { v = row16_sum(v); return (__builtin_bit_cast(float, __builtin_amdgcn_readlane(__builtin_bit_cast(int, v), 0)) + __builtin_bit_cast(float, __builtin_amdgcn_readlane(__builtin_bit_cast(int, v), 16)))
    + (__builtin_bit_cast(float, __builtin_amdgcn_readlane(__builtin_bit_cast(int, v), 32)) + __builtin_bit_cast(float, __builtin_amdgcn_readlane(__builtin_bit_cast(int, v), 48))); }
namespace pg8 {
#define PG8_LAS __attribute__((address_space(3)))
typedef unsigned short bf16_t;
typedef short bf16x8 __attribute__((ext_vector_type(8)));
typedef float f32x4 __attribute__((ext_vector_type(4)));
typedef unsigned u32x4 __attribute__((ext_vector_type(4)));
constexpr int BM = 256, BK = 64, HALF = 128, HTB = HALF * BK * 2  , STAGE_BYTES = 8 * HTB, NXCD = 8, WGM = 8;

__host__ __device__ __forceinline__ int lds_byte(int r, int c) { const int st = (r >> 4) * 2 + (c >> 5), rr = r & 15, cc = c & 31, ob = rr * 64 + cc * 2; return st * 1024 + (ob ^ (((ob >> 9) & 1) << 5)); }
__host__ __device__ __forceinline__ void stage_rc(int b, int& R, int& C) { const int st = b / 1024, sb = b % 1024, swz = sb ^ (((sb >> 9) & 1) << 5); R = (st >> 1) * 16 + swz / 64; C = (st & 1) * 32 + (swz % 64) / 2; }
__host__ __device__ __forceinline__ int perm32(int rho) { const int n = rho >> 4, i = rho & 15; return 8 * (i >> 2) + 4 * n + (i & 3); }

struct Unit { int pm, pn; };
struct Gemm { const bf16_t* A; const bf16_t* Bt; int M, N, K, lda; };

struct StaticOrder {
    int nM, nN, nwg, G, c;
    __host__ __device__ void init(int M, int N, int G_, int c_) { nM = M / BM; nN = N / BM; nwg = nM * nN; G = G_; c = c_; }
    __host__ __device__ bool next(int i, Unit& u) const {
        const long L = (long)i * G + c; if (L >= nwg) return false;
        int wgid = (int)L; { const int q = nwg / NXCD, r = nwg % NXCD, xcd = wgid % NXCD, off = wgid / NXCD; wgid = (xcd < r ? xcd * (q + 1) : r * (q + 1) + (xcd - r) * q) + off; }
        const int nig = WGM * nN, gid = wgid / nig, fm = gid * WGM, gsz = (nM - fm) < WGM ? (nM - fm) : WGM;
        u.pm = fm + ((wgid % nig) % gsz); u.pn = (wgid % nig) / gsz; return true;
    }
    __device__ __forceinline__ void a_ready(const Unit&) const {}
    __device__ __forceinline__ void done(const Unit&) const {}
};

__device__ __forceinline__ unsigned cvt_pk_bf16(float lo, float hi) { unsigned r; asm volatile("v_cvt_pk_bf16_f32 %0, %1, %2" : "=v"(r) : "v"(lo), "v"(hi)); return r; }
typedef float f32x2 __attribute__((ext_vector_type(2)));
constexpr float RMS_EPS = 1e-5f;
__device__ __forceinline__ void row_rstd(float (&rs)[2][4], const float* ss, int row0, int fq) {
#pragma unroll
    for (int ai = 0; ai < 2; ++ai)
#pragma unroll
        for (int m = 0; m < 4; ++m) { const f32x4 v = *(const f32x4*)(ss + (size_t)(row0 + ai * HALF + m * 16) * 16 + fq * 4);
            float s = (v[0] + v[1]) + (v[2] + v[3]); s = sum_x16_x32(s); rs[ai][m] = __builtin_amdgcn_rsqf(s * (1.0f / 1024.0f) + RMS_EPS);     }
}
constexpr int RSC_TAG_OFF = 131072, RSC_VAL_OFF = 131072 + 64;
extern __shared__ __attribute__((aligned(16))) unsigned char pg8_dyn_lds[];
__device__ __forceinline__ void rstd_cache_reset() { if ((threadIdx.x & 63) == 0) ((PG8_LAS int*)((PG8_LAS unsigned char*)pg8_dyn_lds + RSC_TAG_OFF))[threadIdx.x >> 6] = -1; }
__device__ __forceinline__ void row_rstd_cached(float (&rs)[2][4], const float* ss, int pm, int wr, int wc, int fr, int fq) {
    const int wid = wr * 4 + wc, lane = fq * 16 + fr;
    PG8_LAS int* tag = (PG8_LAS int*)((PG8_LAS unsigned char*)pg8_dyn_lds + RSC_TAG_OFF) + wid;
    PG8_LAS f32x4* val = (PG8_LAS f32x4*)((PG8_LAS unsigned char*)pg8_dyn_lds + RSC_VAL_OFF) + (wid * 64 + lane) * 2;
    if (__builtin_amdgcn_readfirstlane(tag[0]) == pm) { const f32x4 a = val[0], b = val[1];
        rs[0][0] = a[0]; rs[0][1] = a[1]; rs[0][2] = a[2]; rs[0][3] = a[3]; rs[1][0] = b[0]; rs[1][1] = b[1]; rs[1][2] = b[2]; rs[1][3] = b[3]; }
    else { row_rstd(rs, ss, pm * BM + wr * 64 + fr, fq);
        val[0] = (f32x4){rs[0][0], rs[0][1], rs[0][2], rs[0][3]}; val[1] = (f32x4){rs[1][0], rs[1][1], rs[1][2], rs[1][3]};
        if (lane == 0) tag[0] = pm; }
}
__device__ __forceinline__ float silu_mul(float g, float u) { const float e = __builtin_amdgcn_exp2f(g * -1.4426950408889634f); return g * u * __builtin_amdgcn_rcpf(1.0f + e); }
struct EpiSwiGLU {
    static constexpr bool PERM = false, AFTER_DRAIN = false;
    bf16_t* H; const float* ss; int ldh;
    __device__ __forceinline__ void operator()(const f32x4 (&acc)[2][2][4][2], const Unit& u, int wr, int wc, int fr, int fq) const {
        const int row0 = u.pm * BM + wr * 64 + fr; float rs[2][4]; row_rstd_cached(rs, ss, u.pm, wr, wc, fr, fq);
        const int col0 = u.pn * HALF + wc * 32 + 8 * fq;
#pragma unroll
        for (int ai = 0; ai < 2; ++ai)
#pragma unroll
            for (int m = 0; m < 4; ++m) { const float r = rs[ai][m]; bf16_t* rowp = H + (size_t)(row0 + ai * HALF + m * 16) * ldh + col0;
                const f32x4 g0 = acc[ai][0][m][0] * r, g1 = acc[ai][0][m][1] * r, u0 = acc[ai][1][m][0] * r, u1 = acc[ai][1][m][1] * r;
                u32x4 w; w.x = cvt_pk_bf16(silu_mul(g0[0], u0[0]), silu_mul(g0[1], u0[1])); w.y = cvt_pk_bf16(silu_mul(g0[2], u0[2]), silu_mul(g0[3], u0[3]));
                w.z = cvt_pk_bf16(silu_mul(g1[0], u1[0]), silu_mul(g1[1], u1[1])); w.w = cvt_pk_bf16(silu_mul(g1[2], u1[2]), silu_mul(g1[3], u1[3]));
                *(u32x4*)rowp = w; }
    }
};
struct EpiResidual {
    static constexpr bool PERM = false, AFTER_DRAIN = false;
    const float* src; const bf16_t* srcb; float* dst; bf16_t* xb; float* ss_out; float scale;
    __device__ __forceinline__ void operator()(const f32x4 (&acc)[2][2][4][2], const Unit& u, int wr, int wc, int fr, int fq) const {
        const int row0 = u.pm * BM + wr * 64 + fr, col0 = u.pn * BM + wc * 32 + 8 * fq;
#pragma unroll
        for (int ai = 0; ai < 2; ++ai) {
          u32x4 xov[4][2];
          if (!src) {
#pragma unroll
                for (int m = 0; m < 4; ++m)
#pragma unroll
                    for (int bj = 0; bj < 2; ++bj) xov[m][bj] = *(const u32x4*)(srcb + (size_t)(row0 + ai * HALF + m * 16) * 1024 + col0 + bj * HALF);
          }
#pragma unroll
            for (int m = 0; m < 4; ++m) { const int row = row0 + ai * HALF + m * 16; float q = 0.f;
#pragma unroll
                for (int bj = 0; bj < 2; ++bj) { const size_t off = (size_t)row * 1024 + col0 + bj * HALF;
                    f32x4 a, b;
                    if (src) { a = *(const f32x4*)(src + off); b = *(const f32x4*)(src + off + 4); }
                    else { const u32x4 xo = xov[m][bj];
                        a = (f32x4){__uint_as_float(xo.x << 16), __uint_as_float(xo.x & 0xffff0000u), __uint_as_float(xo.y << 16), __uint_as_float(xo.y & 0xffff0000u)};
                        b = (f32x4){__uint_as_float(xo.z << 16), __uint_as_float(xo.z & 0xffff0000u), __uint_as_float(xo.w << 16), __uint_as_float(xo.w & 0xffff0000u)}; }
                    a = a + acc[ai][bj][m][0] * scale; b = b + acc[ai][bj][m][1] * scale;
                    if (dst) { *(f32x4*)(dst + off) = a; *(f32x4*)(dst + off + 4) = b; }
                    u32x4 w; w.x = cvt_pk_bf16(a[0], a[1]); w.y = cvt_pk_bf16(a[2], a[3]); w.z = cvt_pk_bf16(b[0], b[1]); w.w = cvt_pk_bf16(b[2], b[3]);
                    if (xb) *(u32x4*)(xb + off) = w;
                    q += (a[0] * a[0] + a[1] * a[1]) + (a[2] * a[2] + a[3] * a[3]) + (b[0] * b[0] + b[1] * b[1]) + (b[2] * b[2] + b[3] * b[3]); }
                q = sum_x16_x32(q);
                if (fq == 0) ss_out[(size_t)row * 16 + u.pn * 4 + wc] = q; }
        }
    }
};
struct EpiQKV {
    static constexpr bool PERM = false, AFTER_DRAIN = false;
    bf16_t* O; const float* ss; const float* cosT; const float* sinT; float qscale; unsigned* nrm;
    __device__ __forceinline__ void operator()(const f32x4 (&acc)[2][2][4][2], const Unit& u, int wr, int wc, int fr, int fq) const {
        typedef unsigned u32x2v __attribute__((ext_vector_type(2)));
        const int row0 = u.pm * BM + wr * 64 + fr; float rs[2][4]; row_rstd_cached(rs, ss, u.pm, wr, wc, fr, fq);
        const int pn = u.pn, rg = pn >> 1; const bool rope = (pn >= 6 && pn < 10);
        const int cbase = (rg == 0 ? 0 : rg == 1 ? 1024 : rg == 2 ? 1536 : rg == 3 ? 512 : rg == 4 ? 2048 : 2560) + (pn & 1) * 256; const float sc = (pn < 2 || pn == 6 || pn == 7) ? qscale : 1.0f;
        if (!rope) {
            const int col0 = cbase + wc * 32 + 8 * fq; float mx[2] = {0.f, 0.f};
#pragma unroll
            for (int ai = 0; ai < 2; ++ai)
#pragma unroll
                for (int m = 0; m < 4; ++m) { const float r = rs[ai][m] * sc; bf16_t* rowp = O + (size_t)(row0 + ai * HALF + m * 16) * 3584 + col0;
#pragma unroll
                    for (int bj = 0; bj < 2; ++bj) { const f32x4 v0 = acc[ai][bj][m][0] * r, v1 = acc[ai][bj][m][1] * r;
                        u32x4 w; w.x = cvt_pk_bf16(v0[0], v0[1]); w.y = cvt_pk_bf16(v0[2], v0[3]); w.z = cvt_pk_bf16(v1[0], v1[1]); w.w = cvt_pk_bf16(v1[2], v1[3]);
                        *(u32x4*)(rowp + bj * HALF) = w;
                        if (pn < 4) { float q = (v0[0] * v0[0] + v0[1] * v0[1]) + (v0[2] * v0[2] + v0[3] * v0[3]) + (v1[0] * v1[0] + v1[1] * v1[1]) + (v1[2] * v1[2] + v1[3] * v1[3]);
                            q = sum_x16_x32(q); mx[bj] = fmaxf(mx[bj], q); } } }
            if (pn < 4) {
#pragma unroll
                for (int bj = 0; bj < 2; ++bj) { float v = mx[bj]; v = row16_max(v);
                    if (fr == 0 && fq == 0) atomicMax(nrm + (((pn >> 1) * 2 + (u.pm >> 6)) * 8 + (pn & 1) * 4 + 2 * bj + (wc >> 1)) * 2 + (wc & 1), __float_as_uint(v)); } }
        } else {
            const int d0 = 16 * (wc & 1) + 4 * fq, colb = cbase + (wc >> 1) * 64 + d0; float mx[2] = {0.f, 0.f};
#pragma unroll
            for (int ai = 0; ai < 2; ++ai)
#pragma unroll
                for (int m = 0; m < 4; ++m) { const int row = row0 + ai * HALF + m * 16; const float r = rs[ai][m] * sc; const int pos = row & 16383;
                    const f32x4 c4 = *(const f32x4*)(cosT + pos * 32 + d0), s4 = *(const f32x4*)(sinT + pos * 32 + d0);
                    bf16_t* rowp = O + (size_t)row * 3584 + colb;
#pragma unroll
                    for (int bj = 0; bj < 2; ++bj) { const f32x4 x1 = acc[ai][bj][m][0] * r, x2 = acc[ai][bj][m][1] * r;
                        const f32x4 o1 = x1 * c4 - x2 * s4, o2 = x2 * c4 + x1 * s4;
                        u32x2v w1, w2; w1.x = cvt_pk_bf16(o1[0], o1[1]); w1.y = cvt_pk_bf16(o1[2], o1[3]); w2.x = cvt_pk_bf16(o2[0], o2[1]); w2.y = cvt_pk_bf16(o2[2], o2[3]);
                        *(u32x2v*)(rowp + bj * HALF) = w1; *(u32x2v*)(rowp + bj * HALF + 32) = w2;
                        { float q = (x1[0] * x1[0] + x1[1] * x1[1]) + (x1[2] * x1[2] + x1[3] * x1[3]) + (x2[0] * x2[0] + x2[1] * x2[1]) + (x2[2] * x2[2] + x2[3] * x2[3]);
                          q = sum_x16_x32(q); mx[bj] = fmaxf(mx[bj], q); } } }
#pragma unroll
            for (int bj = 0; bj < 2; ++bj) { float v = row16_max(mx[bj]);
                if (fr == 0 && fq == 0) atomicMax(nrm + (((pn >> 1) * 2 - 2 + (u.pm >> 6)) * 8 + (pn & 1) * 4 + 2 * bj + (wc >> 1)) * 2 + (wc & 1), __float_as_uint(v)); }
        }
    }
};

template <class Epi, class Sched, bool ALIGN_EPI = false, bool SP2 = false>
__device__ __forceinline__ void gemm_phase(PG8_LAS unsigned char* lds, const Gemm g, const Sched& S, const Epi& E) {
    int tid_ = threadIdx.x; asm volatile("" : "+v"(tid_));
    const int tid = tid_, wid = __builtin_amdgcn_readfirstlane(tid >> 6), lane = tid & 63, wr = wid >> 2, wc = wid & 3, fr = lane & 15, fq = lane >> 4;
    const int K = g.K, nt = K / BK;
    unsigned voffA[2], voffB[2];
#pragma unroll
    for (int i = 0; i < 2; ++i) { int R, C; stage_rc(tid * 16 + i * 8192, R, C); const int Rb = Epi::PERM ? ((R & ~31) + perm32(R & 31)) : R;
        voffA[i] = (unsigned)(R * g.lda + C) * 2u; voffB[i] = (unsigned)(Rb * K + C) * 2u; }
    const size_t kstep = (size_t)(BK * 2);
    const size_t hstep = (size_t)HALF * K * 2;
    const size_t tstep = 2 * hstep;
    const size_t hstepA = (size_t)HALF * g.lda * 2, tstepA = 2 * hstepA;
    const unsigned ldsw = (unsigned)wid * 1024u;
    const int aoff = lds_byte(wr * 64 + fr, fq * 8), boff = lds_byte(wc * 32 + fr, fq * 8);
#define PG8_SA(b, h) (((b) * 2 + (h)) * HTB)
#define PG8_SB(b, h) ((4 + (b) * 2 + (h)) * HTB)
#define PG8_STAGE(bufoff, gbase, voff) do { _Pragma("unroll") for (int _i = 0; _i < 2; ++_i) \
        __builtin_amdgcn_global_load_lds((const unsigned*)((const char*)(gbase) + (voff)[_i]), (PG8_LAS unsigned*)(lds + (bufoff) + ldsw + _i * 8192), 16, 0, 0); } while (0)
#define PG8_LDA(dst, b, h) do { _Pragma("unroll") for (int m = 0; m < 4; ++m) _Pragma("unroll") for (int k = 0; k < 2; ++k) dst[m][k] = *(const PG8_LAS bf16x8*)(lds + PG8_SA(b, h) + aoff + m * 2048 + k * 1024); } while (0)
#define PG8_LDB(dst, b, h) do { _Pragma("unroll") for (int n = 0; n < 2; ++n) _Pragma("unroll") for (int k = 0; k < 2; ++k) dst[n][k] = *(const PG8_LAS bf16x8*)(lds + PG8_SB(b, h) + boff + n * 2048 + k * 1024); } while (0)
#define PG8_MMA(ai, bj, At, Bt) do { __builtin_amdgcn_s_setprio(1); _Pragma("unroll") for (int m = 0; m < 4; ++m) _Pragma("unroll") for (int n = 0; n < 2; ++n) _Pragma("unroll") for (int k = 0; k < 2; ++k) \
        acc[ai][bj][m][n] = __builtin_amdgcn_mfma_f32_16x16x32_bf16(Bt[n][k], At[m][k], acc[ai][bj][m][n], 0, 0, 0); __builtin_amdgcn_s_setprio(0); } while (0)
#define PG8_WAIT_V(n) asm volatile("s_waitcnt vmcnt(" #n ")" ::: "memory")
#define PG8_WAIT_L(n) asm volatile("s_waitcnt lgkmcnt(" #n ")" ::: "memory")
#define PG8_BAR __builtin_amdgcn_s_barrier()
#define PG8_SCHED __builtin_amdgcn_sched_barrier(0)
    Unit cur, nxt; int ui = 0;
    if (!S.next(0, cur)) return;
    f32x4 acc[2][2][4][2];
#pragma unroll
    for (int a = 0; a < 2; ++a)
#pragma unroll
        for (int b = 0; b < 2; ++b)
#pragma unroll
            for (int m = 0; m < 4; ++m)
#pragma unroll
                for (int n = 0; n < 2; ++n) acc[a][b][m][n] = (f32x4){0.f, 0.f, 0.f, 0.f};
    bf16x8 At[4][2], B0[2][2], B1[2][2];
    const char* cA = (const char*)g.A + (size_t)cur.pm * tstepA; const char* cB = (const char*)g.Bt + (size_t)cur.pn * tstep;
    S.a_ready(cur);
    if constexpr (SP2) {
        PG8_STAGE(PG8_SB(0, 0), cB, voffB); PG8_STAGE(PG8_SB(0, 1), cB + hstep, voffB); PG8_STAGE(PG8_SA(0, 0), cA, voffA); PG8_STAGE(PG8_SA(0, 1), cA + hstepA, voffA);
        if (wr == 1) PG8_BAR;
        PG8_WAIT_V(2); PG8_BAR;
        PG8_STAGE(PG8_SB(1, 0), cB + kstep, voffB); PG8_STAGE(PG8_SA(1, 0), cA + kstep, voffA); PG8_STAGE(PG8_SB(1, 1), cB + hstep + kstep, voffB);
        PG8_WAIT_V(6); PG8_BAR;
    } else {
        PG8_STAGE(PG8_SB(0, 0), cB, voffB); PG8_STAGE(PG8_SA(0, 0), cA, voffA); PG8_STAGE(PG8_SB(0, 1), cB + hstep, voffB); PG8_STAGE(PG8_SA(0, 1), cA + hstepA, voffA);
        if (wr == 1) PG8_BAR;
        PG8_WAIT_V(4); PG8_BAR;
        PG8_STAGE(PG8_SB(1, 0), cB + kstep, voffB); PG8_STAGE(PG8_SA(1, 0), cA + kstep, voffA); PG8_STAGE(PG8_SB(1, 1), cB + hstep + kstep, voffB);
        PG8_WAIT_V(6); PG8_BAR;
    }
    for (;;) {
        const bool has_next = S.next(ui + 1, nxt);
        const char* nA = has_next ? (const char*)g.A + (size_t)nxt.pm * tstepA : cA; const char* nB = has_next ? (const char*)g.Bt + (size_t)nxt.pn * tstep : cB;
        for (int t = 0; t < nt; t += 2) {
            const bool last = (t == nt - 2);
            const char* a1 = cA + (size_t)(t + 1) * kstep;
            const char* a2 = last ? nA : cA + (size_t)(t + 2) * kstep; const char* b2 = last ? nB : cB + (size_t)(t + 2) * kstep;
            const char* a3 = a2 + kstep; const char* b3 = b2 + kstep;
            if (last && has_next) S.a_ready(nxt);
            if constexpr (SP2) {
            PG8_LDB(B0, 0, 0); PG8_LDB(B1, 0, 1); PG8_SCHED; PG8_LDA(At, 0, 0); PG8_STAGE(PG8_SA(1, 1), a1 + hstepA, voffA);
            PG8_WAIT_V(8); PG8_WAIT_L(0); PG8_BAR; PG8_MMA(0, 0, At, B0); PG8_MMA(0, 1, At, B1); PG8_BAR; PG8_SCHED;
            PG8_LDA(At, 0, 1); PG8_STAGE(PG8_SB(0, 0), b2, voffB); PG8_STAGE(PG8_SB(0, 1), b2 + hstep, voffB); PG8_STAGE(PG8_SA(0, 0), a2, voffA);
            PG8_WAIT_V(8); PG8_WAIT_L(0); PG8_BAR; PG8_MMA(1, 0, At, B0); PG8_MMA(1, 1, At, B1); PG8_BAR; PG8_SCHED;
            PG8_LDB(B0, 1, 0); PG8_LDB(B1, 1, 1); PG8_SCHED; PG8_LDA(At, 1, 0); PG8_STAGE(PG8_SA(0, 1), a2 + hstepA, voffA);
            PG8_WAIT_V(8); PG8_WAIT_L(0); PG8_BAR; PG8_MMA(0, 0, At, B0); PG8_MMA(0, 1, At, B1); PG8_BAR; PG8_SCHED;
            PG8_LDA(At, 1, 1); PG8_STAGE(PG8_SB(1, 0), b3, voffB); PG8_STAGE(PG8_SB(1, 1), b3 + hstep, voffB); PG8_STAGE(PG8_SA(1, 0), a3, voffA);
            PG8_WAIT_V(8); PG8_WAIT_L(0); PG8_BAR; PG8_MMA(1, 0, At, B0); PG8_MMA(1, 1, At, B1); PG8_BAR; PG8_SCHED;
            } else {
            PG8_LDB(B0, 0, 0); PG8_SCHED; PG8_LDA(At, 0, 0); PG8_STAGE(PG8_SA(1, 1), a1 + hstepA, voffA);
            PG8_WAIT_L(8); PG8_BAR; PG8_WAIT_L(0); PG8_MMA(0, 0, At, B0); PG8_BAR; PG8_SCHED;
            PG8_LDB(B1, 0, 1); PG8_STAGE(PG8_SB(0, 0), b2, voffB);
            PG8_BAR; PG8_WAIT_L(0); PG8_MMA(0, 1, At, B1); PG8_BAR;
            PG8_LDA(At, 0, 1); PG8_STAGE(PG8_SA(0, 0), a2, voffA);
            PG8_BAR; PG8_WAIT_L(0); PG8_MMA(1, 0, At, B0); PG8_BAR; PG8_SCHED;
            PG8_STAGE(PG8_SB(0, 1), b2 + hstep, voffB);
            PG8_WAIT_V(6); PG8_BAR; PG8_MMA(1, 1, At, B1); PG8_BAR;
            PG8_LDB(B0, 1, 0); PG8_SCHED; PG8_LDA(At, 1, 0); PG8_STAGE(PG8_SA(0, 1), a2 + hstepA, voffA);
            PG8_WAIT_L(8); PG8_BAR; PG8_WAIT_L(0); PG8_MMA(0, 0, At, B0); PG8_BAR; PG8_SCHED;
            PG8_LDB(B1, 1, 1); PG8_STAGE(PG8_SB(1, 0), b3, voffB);
            PG8_BAR; PG8_WAIT_L(0); PG8_MMA(0, 1, At, B1); PG8_BAR;
            PG8_LDA(At, 1, 1); PG8_STAGE(PG8_SA(1, 0), a3, voffA);
            PG8_BAR; PG8_WAIT_L(0); PG8_MMA(1, 0, At, B0); PG8_BAR; PG8_SCHED;
            PG8_STAGE(PG8_SB(1, 1), b3 + hstep, voffB);
            PG8_WAIT_V(6); PG8_BAR; PG8_MMA(1, 1, At, B1); PG8_BAR;
            }
        }
        if constexpr (ALIGN_EPI) { if (wr == 0) PG8_BAR; }
        if constexpr (!Epi::AFTER_DRAIN) { E(acc, cur, wr, wc, fr, fq); S.done(cur); }
        if (!has_next) break;
#pragma unroll
        for (int a = 0; a < 2; ++a)
#pragma unroll
            for (int b = 0; b < 2; ++b)
#pragma unroll
                for (int m = 0; m < 4; ++m)
#pragma unroll
                    for (int n = 0; n < 2; ++n) acc[a][b][m][n] = (f32x4){0.f, 0.f, 0.f, 0.f};
        cur = nxt; cA = nA; cB = nB; ++ui;
        if constexpr (ALIGN_EPI) { if (wr == 1) PG8_BAR; }
    }
    PG8_WAIT_V(0);
    if constexpr (!ALIGN_EPI) { if (wr == 0) PG8_BAR; }
    PG8_BAR;
    if constexpr (Epi::AFTER_DRAIN) { E.fused(acc, cur, wr, wc, fr, fq, lds, wid, lane); S.done(cur); }
#undef PG8_SA
#undef PG8_SB
#undef PG8_STAGE
#undef PG8_LDA
#undef PG8_LDB
#undef PG8_MMA
#undef PG8_WAIT_V
#undef PG8_WAIT_L
#undef PG8_BAR
#undef PG8_SCHED
}
}

#ifndef PG8_SP2
#define PG8_SP2 true
#endif
#ifndef PG8_ALIGN
#define PG8_ALIGN true
#endif
#include <hip/hip_bf16.h>
#include <cmath>
namespace attn_body {
using bf16=__hip_bfloat16;
using bf16x8=__attribute__((ext_vector_type(8)))short;
using s16x4=__attribute__((ext_vector_type(4)))short;
using f32x16=__attribute__((ext_vector_type(16)))float;
using u32x4=__attribute__((ext_vector_type(4)))unsigned;
constexpr int BATCH=2,SEQ=16384,D=64,PQ=3584;
constexpr int NW=8,QBLK=32,QB=QBLK*NW,KVBLK=64,NQB=SEQ/QB;
constexpr int ATTN_UNIT_ROWS=QB; typedef float f32x4_t __attribute__((ext_vector_type(4)));
__device__ __forceinline__ int crow(int r,int hi){return (r&3)+8*(r>>2)+4*hi;}
#define SBAR() __builtin_amdgcn_sched_barrier(0)
__device__ __forceinline__ void cmask(f32x16&p0,f32x16&p1,int jb,int qrel,int hi){
  const float NEG=-INFINITY; int kb=64*jb+4*hi;
  #pragma unroll
  for(int r=0;r<16;++r){int kv=kb+(r&3)+8*(r>>2); if(kv>qrel)p0[r]=NEG; if(kv+32>qrel)p1[r]=NEG;}
}

constexpr int NSLOT=3, SLOTB=8192;
constexpr int LDS_K=0, LDS_V=NSLOT*SLOTB, LDS_WS=2*NSLOT*SLOTB, LDS_OST=LDS_WS+NW*64*4, LDS_BYTES=LDS_OST+NW*4096;
constexpr int NCS_OFF=LDS_BYTES;
constexpr float C2=0.125f*1.4426950408889634f;
__device__ __forceinline__ void glds16(const void*gsrc,unsigned lds_dst){unsigned keep;
  asm volatile("s_mov_b32 %0, m0\n\ts_mov_b32 m0, %2\n\ts_nop 0\n\tglobal_load_lds_dwordx4 %1, off\n\ts_mov_b32 m0, %0":"=&s"(keep):"v"(gsrc),"s"(lds_dst):"memory");}
__device__ __forceinline__ float max3f(float a,float b,float c){float r;asm("v_max3_f32 %0, %1, %2, %3":"=v"(r):"v"(a),"v"(b),"v"(c));return r;}
__device__ __forceinline__ float max2f(float a,float b){float r;asm("v_max_f32_e32 %0, %1, %2":"=v"(r):"v"(a),"v"(b));return r;}
__device__ __forceinline__ float fadd_s(float a,float b){float r;asm("v_add_f32_e32 %0, %1, %2":"=v"(r):"v"(a),"v"(b));return r;}
__device__ __forceinline__ float fsub_s(float a,float b){float r;asm("v_sub_f32_e32 %0, %1, %2":"=v"(r):"v"(a),"v"(b));return r;}
typedef float f32x2_t __attribute__((ext_vector_type(2))); typedef __bf16 bf16x2_t __attribute__((ext_vector_type(2)));
__device__ __forceinline__ unsigned cvtpk_s(float lo,float hi){f32x2_t v={lo,hi};bf16x2_t b=__builtin_convertvector(v,bf16x2_t);return __builtin_bit_cast(unsigned,b);}
#define WAIT_BAR(N) asm volatile("s_waitcnt vmcnt(" #N ") lgkmcnt(0)\n\ts_barrier":::"memory")

__device__ __forceinline__ void qkt(f32x16&p0,f32x16&p1,const char*Kslot,const bf16x8*qr,const f32x16&negm,int r32,int hi){
  const char*kb=Kslot+hi*1024+r32*16;
  #pragma unroll
  for(int d0=0;d0<4;++d0){
    const bf16x8 b0=*reinterpret_cast<const bf16x8*>(kb+d0*2048);
    const bf16x8 b1=*reinterpret_cast<const bf16x8*>(kb+d0*2048+512);
    if(d0==0){p0=__builtin_amdgcn_mfma_f32_32x32x16_bf16(b0,qr[0],negm,0,0,0);p1=__builtin_amdgcn_mfma_f32_32x32x16_bf16(b1,qr[0],negm,0,0,0);}
    else{p0=__builtin_amdgcn_mfma_f32_32x32x16_bf16(b0,qr[d0],p0,0,0,0);p1=__builtin_amdgcn_mfma_f32_32x32x16_bf16(b1,qr[d0],p1,0,0,0);}}
}
typedef __attribute__((address_space(3))) const char* lds_cptr;
typedef short v4i16_t __attribute__((ext_vector_type(4)));
__device__ __forceinline__ void kload8(bf16x8*kf,lds_cptr kp){
  kf[0]=*(const __attribute__((address_space(3))) bf16x8*)(kp);      kf[1]=*(const __attribute__((address_space(3))) bf16x8*)(kp+512);
  kf[2]=*(const __attribute__((address_space(3))) bf16x8*)(kp+2048); kf[3]=*(const __attribute__((address_space(3))) bf16x8*)(kp+2560);
  kf[4]=*(const __attribute__((address_space(3))) bf16x8*)(kp+4096); kf[5]=*(const __attribute__((address_space(3))) bf16x8*)(kp+4608);
  kf[6]=*(const __attribute__((address_space(3))) bf16x8*)(kp+6144); kf[7]=*(const __attribute__((address_space(3))) bf16x8*)(kp+6656);
}
__device__ __forceinline__ void kload2(bf16x8*kf,lds_cptr kp,int j){ kf[2*j]=*(const __attribute__((address_space(3))) bf16x8*)(kp+j*2048); kf[2*j+1]=*(const __attribute__((address_space(3))) bf16x8*)(kp+j*2048+512); }
__device__ __forceinline__ s16x4 vtr(lds_cptr p){ return __builtin_bit_cast(s16x4,__builtin_amdgcn_ds_read_tr16_b64_v4i16((__attribute__((address_space(3))) v4i16_t*)p)); }
__device__ __forceinline__ float rowmax(const f32x16&p0,const f32x16&p1){
  float a=max3f(p0[0],p0[1],p1[0]),b=max3f(p0[2],p0[3],p1[1]);a=max3f(a,p1[2],p1[3]);
  #pragma unroll
  for(int r=4;r<16;r+=4){a=max3f(a,p0[r],p0[r+1]);b=max3f(b,p0[r+2],p0[r+3]);a=max3f(a,p1[r],p1[r+1]);b=max3f(b,p1[r+2],p1[r+3]);}
  const float m=max2f(a,b);
  auto rr=__builtin_amdgcn_permlane32_swap(__float_as_uint(m),__float_as_uint(m),false,false);
  return max2f(__uint_as_float(rr[0]),__uint_as_float(rr[1]));
}
__device__ __forceinline__ void pv(f32x16*o,int vb,bf16x8 pa0,bf16x8 pa1,bf16x8 pa2,bf16x8 pa3){
  #pragma unroll
  for(int d0=0;d0<2;++d0){s16x4 lo[4],hi[4];
    #pragma unroll
    for(int ks=0;ks<4;++ks){
      asm volatile("ds_read_b64_tr_b16 %0,%1 offset:%c2":"=&v"(lo[ks]):"v"(vb),"i"(d0*4096+ks*1024):"memory");
      asm volatile("ds_read_b64_tr_b16 %0,%1 offset:%c2":"=&v"(hi[ks]):"v"(vb),"i"(d0*4096+ks*1024+512):"memory");}
    asm volatile("s_waitcnt lgkmcnt(0)":::"memory");SBAR();
    #define PK(k) (bf16x8){lo[k][0],lo[k][1],lo[k][2],lo[k][3],hi[k][0],hi[k][1],hi[k][2],hi[k][3]}
    o[d0]=__builtin_amdgcn_mfma_f32_32x32x16_bf16(pa0,PK(0),o[d0],0,0,0);
    o[d0]=__builtin_amdgcn_mfma_f32_32x32x16_bf16(pa1,PK(1),o[d0],0,0,0);
    o[d0]=__builtin_amdgcn_mfma_f32_32x32x16_bf16(pa2,PK(2),o[d0],0,0,0);
    o[d0]=__builtin_amdgcn_mfma_f32_32x32x16_bf16(pa3,PK(3),o[d0],0,0,0);
    #undef PK
  }
}

#ifndef ATTN_STORE16
#define ATTN_STORE16(p,v) (*(u32x4*)(p)=(v))
#endif
template<int THRL,bool FOX,bool NOMX> __device__ __forceinline__ void attn_unit(int b,int qb,const bf16*Q,const bf16*__restrict__ K,const bf16*__restrict__ V,bf16*O,const float*lc,const float*ctot,const float*nq,const float*nk,char*shm){
  int tid_=threadIdx.x; asm volatile("":"+v"(tid_));   const int tid=tid_,lane=tid&63,r32=lane&31,hi=lane>>5; const int wid=__builtin_amdgcn_readfirstlane(tid>>6);
  const long rowbase=(long)b*SEQ; const int q0=qb*QB;
  const bf16*Qw=Q+(rowbase+q0+wid*QBLK)*PQ;
    typedef __attribute__((address_space(3))) float* lds_fptr;
  const lds_fptr ncs3=(lds_fptr)((__attribute__((address_space(3))) char*)shm+NCS_OFF); float ctq=0.f; int kofs=0;
  if(FOX){
    const lds_fptr pref3=(lds_fptr)((__attribute__((address_space(3))) char*)shm+NCS_OFF+65536);
    __attribute__((address_space(3))) unsigned* cnt3=(__attribute__((address_space(3))) unsigned*)((__attribute__((address_space(3))) char*)shm+NCS_OFF+65536+512);
    if(wid==0){ const float a_=ctot[2*lane],b_=ctot[2*lane+1]; float s_=a_+b_;
      _Pragma("unroll") for(int o_=1;o_<64;o_<<=1){ const float t_=__builtin_bit_cast(float,__builtin_amdgcn_ds_bpermute((lane-o_)<<2,__builtin_bit_cast(int,s_))); if(lane>=o_)s_+=t_; }
      const float ex_=s_-(a_+b_); pref3[2*lane]=ex_; pref3[2*lane+1]=ex_+a_; if(lane==0)cnt3[0]=0u; }
    asm volatile("s_waitcnt lgkmcnt(0)\n\ts_barrier":::"memory");
    { const float thb_=42.0f+2.1f*sqrtf((nq[0]+nq[1])*(nk[0]+nk[1])); const int ntf_=(q0+QB)/KVBLK;
      const float cq0_=(lc[q0]+pref3[q0>>7])*1.4426950408889634f; bool skip_=false;
      if(tid<ntf_-4){ const int s_=64*tid+63; const float cj_=(lc[s_]+pref3[s_>>7])*1.4426950408889634f; skip_=(cq0_-cj_)<=-thb_; }
      const unsigned long long bal_=__ballot(skip_); if(lane==0&&bal_)__hip_atomic_fetch_add(cnt3,(unsigned)__popcll(bal_),__ATOMIC_RELAXED,__HIP_MEMORY_SCOPE_WORKGROUP); }
    asm volatile("s_waitcnt lgkmcnt(0)\n\ts_barrier":::"memory");
    kofs=__builtin_amdgcn_readfirstlane((int)(cnt3[0]&~1u))*KVBLK;
    const int n4_=(q0+QB)>>2;
    for(int i_=tid+(kofs>>2);i_<n4_;i_+=NW*64){ const f32x4_t v_=*(const f32x4_t*)(lc+4*i_); const float p_=pref3[i_>>5];
      f32x4_t w_; w_[0]=(v_[0]+p_)*-1.4426950408889634f; w_[1]=(v_[1]+p_)*-1.4426950408889634f; w_[2]=(v_[2]+p_)*-1.4426950408889634f; w_[3]=(v_[3]+p_)*-1.4426950408889634f;
      *(__attribute__((address_space(3))) f32x4_t*)(ncs3+4*i_)=w_; }
  }
  const bf16*Kh=K+(rowbase+kofs)*PQ,*Vh=V+(rowbase+kofs)*PQ;
  const unsigned lds0=(unsigned)(uintptr_t)shm;
  float*wsf=(float*)(shm+LDS_WS)+wid*64;
  const bf16*ksrc=Kh+(long)lane*PQ+wid*8;
  const bf16*vsrc=Vh+(long)(16*(wid&3)+(lane>>2))*PQ+(wid>>2)*32+(lane&3)*8;
  const unsigned kdst=lds0+LDS_K+wid*1024, vdst=lds0+LDS_V+wid*1024;
  #define DMA_K(t,slot) glds16(ksrc+(long)(t)*KVBLK*PQ,(unsigned)__builtin_amdgcn_readfirstlane(kdst+(slot)))
  #define DMA_V(t,slot) glds16(vsrc+(long)(t)*KVBLK*PQ,(unsigned)__builtin_amdgcn_readfirstlane(vdst+(slot)))
  const int vb0=(int)(lds0+LDS_V)+((lane>>4)&1)*32+(lane&3)*8+(4*hi+((lane&15)>>2))*64;
  const char*Kbase=shm+LDS_K; bf16x8 kf[8];
  const lds_cptr shm3=(lds_cptr)shm; const lds_cptr kp0=shm3+LDS_K+hi*1024+r32*16; const lds_cptr vp0=shm3+LDS_V+((lane>>4)&1)*32+(lane&3)*8+(4*hi+((lane&15)>>2))*64;
  const int NT=(q0+QB-kofs)/KVBLK;
  #define CINIT (FOX?f32x16{}:negm)
  #define FBIAS(P0,P1,t) do{ if(FOX){ const float nm_=ctq-mhat; const __attribute__((address_space(3))) f32x4_t* bp_=(const __attribute__((address_space(3))) f32x4_t*)(ncs3+kofs+64*(t)+4*hi); \
    _Pragma("unroll") for(int g_=0;g_<4;++g_){ const f32x4_t b0_=bp_[2*g_]+nm_, b1_=bp_[2*g_+8]+nm_; \
      _Pragma("unroll") for(int j_=0;j_<4;++j_){ P0[4*g_+j_]+=b0_[j_]; P1[4*g_+j_]+=b1_[j_]; } } } \
    }while(0)
  DMA_K(0,0);DMA_V(0,0);DMA_K(1,SLOTB);
  bf16x8 qr[4];
  #pragma unroll
  for(int d0=0;d0<4;++d0)qr[d0]=*reinterpret_cast<const bf16x8*>(&Qw[(long)r32*PQ+d0*16+hi*8]);
  float mhat=0.f,l_reg=0.f;f32x16 o[2];o[0]=f32x16{};o[1]=f32x16{};f32x16 negm=f32x16{}; if(!FOX){asm volatile("":"+v"(negm));}
  const int qrel=wid*QBLK+r32;
  #define CMASK(P0,P1,t) do{int jb_=(t)-(NT-4); if(jb_>=0)cmask(P0,P1,jb_,qrel,hi);}while(0)
  bool resc=false;
  #define START(P0,P1) do{ resc=false; \
    if(!NOMX){ const float rm=rowmax(P0,P1); const float dl=rm; mhat=fadd_s(mhat,dl); \
      _Pragma("unroll") for(int r=0;r<16;++r){P0[r]=fsub_s(P0[r],dl);P1[r]=fsub_s(P1[r],dl);} \
      if(!FOX){ _Pragma("unroll") for(int r=0;r<16;++r)negm[r]=-mhat; asm volatile("":"+v"(negm)); } } \
    _Pragma("unroll") for(int r=0;r<16;++r)P0[r]=__builtin_amdgcn_exp2f(P0[r]); }while(0)
  #define RESC() do{ if(resc){ asm volatile("s_waitcnt lgkmcnt(0)":::"memory"); \
      _Pragma("unroll") for(int d_=0;d_<2;++d_) _Pragma("unroll") for(int r=0;r<16;++r)o[d_][r]*=wsf[crow(r,hi)]; } }while(0)
  f32x16 pA0,pA1,pB0,pB1;
  int sl_prev=0,sl_cur=0,sl_next=SLOTB;
  #define ROT() do{sl_prev=sl_cur;sl_cur=sl_next;sl_next=(sl_next==(NSLOT-1)*SLOTB)?0:sl_next+SLOTB;}while(0)
  DMA_K(2,2*SLOTB);
  WAIT_BAR(3); if(FOX){ ctq=-ncs3[q0+wid*QBLK+r32]; }
  qkt(pA0,pA1,Kbase,qr,CINIT,r32,hi);asm volatile("s_nop 15\n\ts_nop 7":"+v"(pA0),"+v"(pA1));FBIAS(pA0,pA1,0);CMASK(pA0,pA1,0);
  START(pA0,pA1);
  _Pragma("unroll") for(int r=0;r<16;++r)pA1[r]=__builtin_amdgcn_exp2f(pA1[r]);
  WAIT_BAR(0);
  DMA_K(3,0);DMA_V(1,SLOTB);
  ROT();
  kload8(kf,kp0+sl_cur);
  WAIT_BAR(2);
  s16x4 vlo[8],vhi[8]; u32x4 pw0,pw1,pw2,pw3;
  #define PKW(P,B) cvtpk_s(P[B],P[B+1])
  #define PAF(k) __builtin_bit_cast(bf16x8,pw##k)
  #define VFR(i) (bf16x8){vlo[i][0],vlo[i][1],vlo[i][2],vlo[i][3],vhi[i][0],vhi[i][1],vhi[i][2],vhi[i][3]}
  #define PIN(x) asm volatile("":"+v"(x))
  #define MX3(a,b,c) __builtin_fmaxf(__builtin_fmaxf((a),(b)),(c))
  #define GAPA(MF,A0,A1,A2,A3,W0,W1,PW) do{ MF; sacc+=A0; sacc+=A1; sacc+=A2; sacc+=A3; PIN(sacc); W0; W1; PIN(PW); SBAR(); }while(0)
  #define EX(v) __builtin_amdgcn_exp2f(v)
  #define GAPB(MF,X,B) do{ MF; X[B]=EX(X[B]); X[B+1]=EX(X[B+1]); X[B+2]=EX(X[B+2]); X[B+3]=EX(X[B+3]); PIN(X); SBAR(); }while(0)
  #define VRD(i) do{ vlo[i]=vtr(vp_+(((i)>>2)*4096+((i)&3)*1024)); vhi[i]=vtr(vp_+(((i)>>2)*4096+((i)&3)*1024+512)); }while(0)
  #define KRD(G,j) do{ if(G){ kload2(kf,kp0+sl_next,j); SBAR(); } }while(0)
  #define STEP(C0,C1,P0,P1,t,GK,GV,GL) do{ SBAR(); \
    const lds_cptr vp_=vp0+sl_prev; \
    VRD(0); SBAR(); float sacc=(P0[0]+P0[1]); \
    GAPA(C0=__builtin_amdgcn_mfma_f32_32x32x16_bf16(kf[0],qr[0],CINIT,0,0,0), P0[2],P0[3],P0[4],P0[5],     pw0[0]=PKW(P0,0), pw0[1]=PKW(P0,2), pw0); \
    VRD(4); SBAR(); GAPA(C1=__builtin_amdgcn_mfma_f32_32x32x16_bf16(kf[1],qr[0],CINIT,0,0,0), P0[6],P0[7],P0[8],P0[9],     pw0[2]=PKW(P0,4), pw0[3]=PKW(P0,6), pw0); \
    VRD(1); SBAR(); GAPA(C0=__builtin_amdgcn_mfma_f32_32x32x16_bf16(kf[2],qr[1],C0,0,0,0),   P0[10],P0[11],P0[12],P0[13], pw1[0]=PKW(P0,8), pw1[1]=PKW(P0,10), pw1); \
    VRD(5); SBAR(); GAPA(C1=__builtin_amdgcn_mfma_f32_32x32x16_bf16(kf[3],qr[1],C1,0,0,0),   P0[14],P0[15],P1[0],P1[1],   pw1[2]=PKW(P0,12),pw1[3]=PKW(P0,14), pw1); \
    VRD(2); SBAR(); GAPA(C0=__builtin_amdgcn_mfma_f32_32x32x16_bf16(kf[4],qr[2],C0,0,0,0),   P1[2],P1[3],P1[4],P1[5],     pw2[0]=PKW(P1,0), pw2[1]=PKW(P1,2), pw2); \
    VRD(6); SBAR(); GAPA(C1=__builtin_amdgcn_mfma_f32_32x32x16_bf16(kf[5],qr[2],C1,0,0,0),   P1[6],P1[7],P1[8],P1[9],     pw2[2]=PKW(P1,4), pw2[3]=PKW(P1,6), pw2); \
    VRD(3); SBAR(); GAPA(C0=__builtin_amdgcn_mfma_f32_32x32x16_bf16(kf[6],qr[3],C0,0,0,0),   P1[10],P1[11],P1[12],P1[13], pw3[0]=PKW(P1,8), pw3[1]=PKW(P1,10), pw3); \
    VRD(7); SBAR(); GAPA(C1=__builtin_amdgcn_mfma_f32_32x32x16_bf16(kf[7],qr[3],C1,0,0,0),   P1[14],P1[15],0.f,0.f,       pw3[2]=PKW(P1,12),pw3[3]=PKW(P1,14), pw3); \
    l_reg+=sacc; \
    if(GK){DMA_K((t)+3,sl_cur);} if(GV){DMA_V((t)+1,sl_next);} \
    FBIAS(C0,C1,t); CMASK(C0,C1,t); \
    { float a=MX3(C0[0],C0[1],C1[0]),b=MX3(C0[2],C0[3],C1[1]); a=MX3(a,C1[2],C1[3]); \
      _Pragma("unroll") for(int r=4;r<16;r+=4){a=MX3(a,C0[r],C0[r+1]);b=MX3(b,C0[r+2],C0[r+3]);a=MX3(a,C1[r],C1[r+1]);b=MX3(b,C1[r+2],C1[r+3]);} \
      float rm=__builtin_fmaxf(a,b); if(NOMX){rm=0.f;} else { auto rr=__builtin_amdgcn_permlane32_swap(__float_as_uint(rm),__float_as_uint(rm),false,false); rm=__builtin_fmaxf(__uint_as_float(rr[0]),__uint_as_float(rr[1])); } \
      resc=false; \
      if(!NOMX&&__builtin_expect(__any(rm>(float)THRL),0)){ const float dl=__builtin_fmaxf(rm,0.f); mhat+=dl; \
        _Pragma("unroll") for(int r=0;r<16;++r){C0[r]-=dl;C1[r]-=dl;} \
        if(!FOX){ _Pragma("unroll") for(int r=0;r<16;++r)negm[r]=-mhat; asm volatile("":"+v"(negm)); } \
        const float f=__builtin_amdgcn_exp2f(-dl); l_reg*=f; if(hi==0)wsf[r32]=f; resc=true; } } \
    SBAR(); \
    GAPB(o[0]=__builtin_amdgcn_mfma_f32_32x32x16_bf16(PAF(0),VFR(0),o[0],0,0,0), C0,0); \
    GAPB(o[1]=__builtin_amdgcn_mfma_f32_32x32x16_bf16(PAF(0),VFR(4),o[1],0,0,0), C0,4); \
    KRD(GL,0); GAPB(o[0]=__builtin_amdgcn_mfma_f32_32x32x16_bf16(PAF(1),VFR(1),o[0],0,0,0), C0,8); \
    KRD(GL,1); GAPB(o[1]=__builtin_amdgcn_mfma_f32_32x32x16_bf16(PAF(1),VFR(5),o[1],0,0,0), C0,12); \
    KRD(GL,2); GAPB(o[0]=__builtin_amdgcn_mfma_f32_32x32x16_bf16(PAF(2),VFR(2),o[0],0,0,0), C1,0); \
    KRD(GL,3); GAPB(o[1]=__builtin_amdgcn_mfma_f32_32x32x16_bf16(PAF(2),VFR(6),o[1],0,0,0), C1,4); \
    GAPB(o[0]=__builtin_amdgcn_mfma_f32_32x32x16_bf16(PAF(3),VFR(3),o[0],0,0,0), C1,8); \
    GAPB(o[1]=__builtin_amdgcn_mfma_f32_32x32x16_bf16(PAF(3),VFR(7),o[1],0,0,0), C1,12); \
    }while(0)
  int t=1;
  #undef CMASK
  #define CMASK(P0,P1,t) do{}while(0)
  for(;t+5<NT;t+=2){
    STEP(pB0,pB1,pA0,pA1,t,true,true,true);     WAIT_BAR(2); RESC(); ROT();
    STEP(pA0,pA1,pB0,pB1,t+1,true,true,true);   WAIT_BAR(2); RESC(); ROT();
  }
  #undef CMASK
  #define CMASK(P0,P1,t) do{int jb_=(t)-(NT-4); if(jb_>=0)cmask(P0,P1,jb_,qrel,hi);}while(0)
  #define ENDW(tt) do{ if((tt)+3<NT){WAIT_BAR(2);} else if((tt)+2<NT){WAIT_BAR(1);} else {WAIT_BAR(0);} }while(0)
  for(;t+1<NT;t+=2){
    STEP(pB0,pB1,pA0,pA1,t,(t+3<NT),(t+1<NT),(t+1<NT));       ENDW(t);   RESC(); ROT();
    STEP(pA0,pA1,pB0,pB1,t+1,(t+4<NT),(t+2<NT),(t+2<NT));     ENDW(t+1); RESC(); ROT();
  }
  STEP(pB0,pB1,pA0,pA1,NT-1,false,false,false); RESC();
  { float sacc=pB0[0]+pB0[1]; _Pragma("unroll") for(int r=2;r<16;++r)sacc+=pB0[r]; _Pragma("unroll") for(int r=0;r<16;++r)sacc+=pB1[r]; l_reg+=sacc;
    pw0=(u32x4){PKW(pB0,0),PKW(pB0,2),PKW(pB0,4),PKW(pB0,6)};pw1=(u32x4){PKW(pB0,8),PKW(pB0,10),PKW(pB0,12),PKW(pB0,14)};pw2=(u32x4){PKW(pB1,0),PKW(pB1,2),PKW(pB1,4),PKW(pB1,6)};pw3=(u32x4){PKW(pB1,8),PKW(pB1,10),PKW(pB1,12),PKW(pB1,14)};
    SBAR(); pv(o,vb0+sl_cur,PAF(0),PAF(1),PAF(2),PAF(3)); }
  #undef PKW
  #undef PAF
  #undef VFR
  #undef PIN
  #undef MX3
  #undef GAPA
  #undef GAPB
  #undef EX
  #undef VRD
  #undef KRD
  #undef STEP
  #undef ENDW
  {auto rr=__builtin_amdgcn_permlane32_swap(__float_as_uint(l_reg),__float_as_uint(l_reg),false,false);l_reg=__uint_as_float(rr[0])+__uint_as_float(rr[1]);}
  if(hi==0)wsf[32+r32]=l_reg;asm volatile("s_waitcnt lgkmcnt(0)":::"memory");
  float rli[16];
  #pragma unroll
  for(int r=0;r<16;++r)rli[r]=__builtin_amdgcn_rcpf(wsf[32+crow(r,hi)]);
  bf16*Ow=O+(rowbase+q0+wid*QBLK)*PQ;
  { bf16*stg=(bf16*)(shm+LDS_OST)+wid*2048;
    #pragma unroll
    for(int r=0;r<16;++r){const int orow=crow(r,hi);
      #pragma unroll
      for(int d0=0;d0<2;++d0)stg[orow*64+d0*32+r32]=__float2bfloat16(o[d0][r]*rli[r]);}
    asm volatile("s_waitcnt lgkmcnt(0)":::"memory");
    #pragma unroll
    for(int i=0;i<4;++i){const int row=i*8+(lane>>3),ch=lane&7; const u32x4 v=*(const u32x4*)(stg+row*64+ch*8); ATTN_STORE16(Ow+(long)row*PQ+ch*8,v);} }
  asm volatile("s_waitcnt lgkmcnt(0)\n\ts_barrier":::"memory");
  #undef FBIAS
  #undef CINIT
  #undef DMA_K
  #undef DMA_V
  #undef CMASK
  #undef START
  #undef RESC
  #undef ROT
}
constexpr int XK=0, XV=16384, XWS=49152, XOST=51200, DV128_LDS_BYTES=XOST+NW*4096;
template<int THRL> __device__ __forceinline__ void attn_unit_dv128(int b,int qb,const bf16*Q,const bf16*__restrict__ K,const bf16*__restrict__ V,bf16*O,const float*nq,const float*nk,char*shm){
  int tid_=threadIdx.x; asm volatile("":"+v"(tid_)); const int tid=tid_,lane=tid&63,r32=lane&31,hi=lane>>5; const int wid=__builtin_amdgcn_readfirstlane(tid>>6);
  const long rowbase=(long)b*SEQ; const int q0=qb*QB;
  const bf16*Qw=Q+(rowbase+q0+wid*QBLK)*PQ;
  const bf16*Kh=K+rowbase*PQ,*Vh=V+rowbase*PQ;
  const unsigned lds0=(unsigned)(uintptr_t)shm;
  typedef __attribute__((address_space(3))) float* lds_fptr;
  const lds_fptr wsf=(lds_fptr)((__attribute__((address_space(3))) char*)shm+XWS)+wid*64;
  const bf16*ksrc=Kh+(long)lane*PQ+wid*8;
  const bf16*vsrc=Vh+(long)(16*(wid&3)+(lane>>2))*PQ+(wid>>2)*32+(lane&3)*8;
  const unsigned kdst=lds0+XK+wid*1024, vdst=lds0+XV+wid*1024;
  #define DMA_K(t,slot) glds16(ksrc+(long)(t)*KVBLK*PQ,(unsigned)__builtin_amdgcn_readfirstlane(kdst+(slot)*8192))
  #define DMA_V(t,slot) do{ glds16(vsrc+(long)(t)*KVBLK*PQ,(unsigned)__builtin_amdgcn_readfirstlane(vdst+(slot)*16384)); glds16(vsrc+64+(long)(t)*KVBLK*PQ,(unsigned)__builtin_amdgcn_readfirstlane(vdst+(slot)*16384+8192)); }while(0)
  const int vb0=(int)(lds0+XV)+((lane>>4)&1)*32+(lane&3)*8+(4*hi+((lane&15)>>2))*64;
  const int NT=(q0+QB)/KVBLK;
  const lds_cptr kp0=(lds_cptr)shm+XK+hi*1024+r32*16;
  const lds_cptr vp0=(lds_cptr)shm+XV+((lane>>4)&1)*32+(lane&3)*8+(4*hi+((lane&15)>>2))*64;
  DMA_K(0,0);
  bf16x8 qr[4];
  #pragma unroll
  for(int d0=0;d0<4;++d0)qr[d0]=*reinterpret_cast<const bf16x8*>(&Qw[(long)r32*PQ+d0*16+hi*8]);
  float mhat=0.f,l_reg=0.f; f32x16 o[4]; o[0]=f32x16{};o[1]=f32x16{};o[2]=f32x16{};o[3]=f32x16{}; f32x16 negm=f32x16{};
  const int qrel=wid*QBLK+r32;
  u32x4 pw0=u32x4{},pw1=u32x4{},pw2=u32x4{},pw3=u32x4{};
  #define MX3(a,b,c) __builtin_fmaxf(__builtin_fmaxf((a),(b)),(c))
  #define PKW(P,B) cvtpk_s(P[B],P[B+1])
  #define SBAR_() __builtin_amdgcn_sched_barrier(0)
  #define VLOAD(VP) do{ _Pragma("unroll") for(int i_=0;i_<8;++i_){ vlo[i_]=vtr((VP)+(i_>>2)*4096+(i_&3)*1024); vhi[i_]=vtr((VP)+(i_>>2)*4096+(i_&3)*1024+512); } }while(0)
  #define VFR_(i) (bf16x8){vlo[i][0],vlo[i][1],vlo[i][2],vlo[i][3],vhi[i][0],vhi[i][1],vhi[i][2],vhi[i][3]}
  #define PAF_(k) __builtin_bit_cast(bf16x8,pw##k)
  #define VMMA(OA,OB) do{ \
      OA=__builtin_amdgcn_mfma_f32_32x32x16_bf16(PAF_(0),VFR_(0),OA,0,0,0); OB=__builtin_amdgcn_mfma_f32_32x32x16_bf16(PAF_(0),VFR_(4),OB,0,0,0); \
      OA=__builtin_amdgcn_mfma_f32_32x32x16_bf16(PAF_(1),VFR_(1),OA,0,0,0); OB=__builtin_amdgcn_mfma_f32_32x32x16_bf16(PAF_(1),VFR_(5),OB,0,0,0); \
      OA=__builtin_amdgcn_mfma_f32_32x32x16_bf16(PAF_(2),VFR_(2),OA,0,0,0); OB=__builtin_amdgcn_mfma_f32_32x32x16_bf16(PAF_(2),VFR_(6),OB,0,0,0); \
      OA=__builtin_amdgcn_mfma_f32_32x32x16_bf16(PAF_(3),VFR_(3),OA,0,0,0); OB=__builtin_amdgcn_mfma_f32_32x32x16_bf16(PAF_(3),VFR_(7),OB,0,0,0); }while(0)
  #define DV_TILE(T,HASPV,MASKMODE,NOMAX) do{ const int t_=(T); \
    asm volatile("s_waitcnt vmcnt(0) lgkmcnt(0)\n\ts_barrier":::"memory");     \
    if(t_+1<NT){ DMA_K(t_+1,(t_+1)&1); } DMA_V(t_,t_&1); \
    f32x16 p0,p1; float f=1.f; bool resc=false; \
    { bf16x8 kf[8]; kload8(kf,kp0+(t_&1)*8192); SBAR_();                         \
      p0=__builtin_amdgcn_mfma_f32_32x32x16_bf16(kf[0],qr[0],negm,0,0,0); p1=__builtin_amdgcn_mfma_f32_32x32x16_bf16(kf[1],qr[0],negm,0,0,0); \
      p0=__builtin_amdgcn_mfma_f32_32x32x16_bf16(kf[2],qr[1],p0,0,0,0); p1=__builtin_amdgcn_mfma_f32_32x32x16_bf16(kf[3],qr[1],p1,0,0,0); \
      p0=__builtin_amdgcn_mfma_f32_32x32x16_bf16(kf[4],qr[2],p0,0,0,0); p1=__builtin_amdgcn_mfma_f32_32x32x16_bf16(kf[5],qr[2],p1,0,0,0); \
      p0=__builtin_amdgcn_mfma_f32_32x32x16_bf16(kf[6],qr[3],p0,0,0,0); p1=__builtin_amdgcn_mfma_f32_32x32x16_bf16(kf[7],qr[3],p1,0,0,0); } \
    if(MASKMODE==1){ cmask(p0,p1,t_-(NT-4),qrel,hi); } else if(MASKMODE==2){ const int jb=t_-(NT-4); if(jb>=0)cmask(p0,p1,jb,qrel,hi); } \
    if(!(NOMAX)){ \
    float rm; \
    { float a=MX3(p0[0],p0[1],p1[0]),bq=MX3(p0[2],p0[3],p1[1]); a=MX3(a,p1[2],p1[3]); \
      _Pragma("unroll") for(int r=4;r<16;r+=4){a=MX3(a,p0[r],p0[r+1]);bq=MX3(bq,p0[r+2],p0[r+3]);a=MX3(a,p1[r],p1[r+1]);bq=MX3(bq,p1[r+2],p1[r+3]);} \
      rm=__builtin_fmaxf(a,bq); float x0=rm,x1=rm; asm volatile("s_nop 1\n\tv_permlane32_swap_b32 %0, %1":"+v"(x0),"+v"(x1)); rm=__builtin_fmaxf(x0,x1); }     \
      \
    if(HASPV){ resc=__any(rm>(float)THRL); } \
    if(!(HASPV)||resc){ const float dl=(HASPV)?__builtin_fmaxf(rm,0.f):rm; mhat+=dl; f=__builtin_amdgcn_exp2f(-dl);     \
      _Pragma("unroll") for(int r=0;r<16;++r){p0[r]-=dl;p1[r]-=dl;negm[r]=-mhat;} } \
    } \
    { const lds_cptr vp=vp0+((t_-1)&1)*16384; float sacc=0.f;                    \
      s16x4 vlo[8],vhi[8]; \
      if(HASPV){ SBAR_(); VLOAD(vp); SBAR_(); } \
      _Pragma("unroll") for(int r=0;r<16;++r){ p0[r]=__builtin_amdgcn_exp2f(p0[r]); sacc+=p0[r]; } asm volatile("":"+v"(p0),"+v"(sacc));     \
      if(HASPV){ SBAR_(); VMMA(o[0],o[1]); SBAR_(); VLOAD(vp+8192); SBAR_(); } \
      _Pragma("unroll") for(int r=0;r<16;++r){ p1[r]=__builtin_amdgcn_exp2f(p1[r]); sacc+=p1[r]; } asm volatile("":"+v"(p1),"+v"(sacc)); \
      if(HASPV){ SBAR_(); VMMA(o[2],o[3]); SBAR_(); } \
      pw0=(u32x4){PKW(p0,0),PKW(p0,2),PKW(p0,4),PKW(p0,6)}; pw1=(u32x4){PKW(p0,8),PKW(p0,10),PKW(p0,12),PKW(p0,14)}; \
      pw2=(u32x4){PKW(p1,0),PKW(p1,2),PKW(p1,4),PKW(p1,6)}; pw3=(u32x4){PKW(p1,8),PKW(p1,10),PKW(p1,12),PKW(p1,14)}; \
      if(resc){ l_reg*=f; if(hi==0)wsf[r32]=f;                                   \
        asm volatile("s_waitcnt lgkmcnt(0)":::"memory"); \
        _Pragma("unroll") for(int r=0;r<16;++r){ const float fr_=wsf[crow(r,hi)]; o[0][r]*=fr_; o[1][r]*=fr_; o[2][r]*=fr_; o[3][r]*=fr_; } \
        asm volatile("s_waitcnt lgkmcnt(0)":::"memory"); } \
      l_reg+=sacc; } \
  }while(0)
  const float bqk_=1.05f*sqrtf((nq[0]+nq[1])*(nk[0]+nk[1]));
  if(bqk_<40.0f){
    DV_TILE(0,false,2,true);
    { int t=1;
      #pragma unroll 1
      for(;t<NT-4;++t){ DV_TILE(t,true,0,true); }
      #pragma unroll 1
      for(;t<NT;++t){ DV_TILE(t,true,1,true); } }
  } else {
    DV_TILE(0,false,2,false);
    { int t=1;
      #pragma unroll 1
      for(;t<NT-4;++t){ DV_TILE(t,true,0,false); }
      #pragma unroll 1
      for(;t<NT;++t){ DV_TILE(t,true,1,false); } }
  }
  asm volatile("s_waitcnt vmcnt(0) lgkmcnt(0)\n\ts_barrier":::"memory");
  { const lds_cptr vp=vp0+((NT-1)&1)*16384; s16x4 vlo[8],vhi[8]; VLOAD(vp); SBAR_(); VMMA(o[0],o[1]); SBAR_(); VLOAD(vp+8192); SBAR_(); VMMA(o[2],o[3]); }
  #undef DV_TILE
  #undef VLOAD
  #undef VFR_
  #undef PAF_
  #undef VMMA
  #undef SBAR_
  #undef MX3
  #undef PKW
  {float x0=l_reg,x1=l_reg; asm volatile("s_nop 1\n\tv_permlane32_swap_b32 %0, %1":"+v"(x0),"+v"(x1)); l_reg=x0+x1;}
  if(hi==0)wsf[32+r32]=l_reg; asm volatile("s_waitcnt lgkmcnt(0)":::"memory");
  float rli[16];
  #pragma unroll
  for(int r=0;r<16;++r)rli[r]=__builtin_amdgcn_rcpf(wsf[32+crow(r,hi)]);
  bf16*Ow=O+(rowbase+q0+wid*QBLK)*PQ;
  bf16*stg=(bf16*)(shm+XOST)+wid*2048;
  #pragma unroll
  for(int hf=0;hf<2;++hf){
    #pragma unroll
    for(int r=0;r<16;++r){const int orow=crow(r,hi);
      #pragma unroll
      for(int d0=0;d0<2;++d0)stg[orow*64+d0*32+r32]=__float2bfloat16(o[2*hf+d0][r]*rli[r]);}
    asm volatile("s_waitcnt lgkmcnt(0)":::"memory");
    #pragma unroll
    for(int i=0;i<4;++i){const int row=i*8+(lane>>3),ch=lane&7; const u32x4 v=*(const u32x4*)(stg+row*64+ch*8); *(u32x4*)(Ow+(long)row*PQ+hf*64+ch*8)=v;}
    asm volatile("s_waitcnt lgkmcnt(0)":::"memory"); }
  asm volatile("s_waitcnt lgkmcnt(0)\n\ts_barrier":::"memory");
  #undef DMA_K
  #undef DMA_V
}
constexpr int ATTN_LDS_BYTES=LDS_BYTES;
#undef SBAR
#undef WAIT_BAR
}
#include <hip/hip_cooperative_groups.h>
namespace cg = cooperative_groups;
#ifndef MK_LAUNCH_PER_PHASE
#define MK_LAUNCH_PER_PHASE 0
#endif
constexpr int NWAVES = 8;
constexpr int SEQ = 16384, DMODEL = 1024, M = 2 * SEQ, DFF = 2816, INC = 3080, NQKV = 3072, PQ = 3584, NPHASE = 16;
constexpr size_t MiB = 1u << 20;
constexpr size_t WS_CTL = 0  , CTL_ZERO_BYTES = 65536;
constexpr int MISC_OFF = 153600;
constexpr size_t WS_COS = 2 * MiB, WS_SIN = 4 * MiB, WS_LC = 7 * MiB, WS_CT = 8 * MiB, WS_SS = 10 * MiB  , WS_W = 24 * MiB  , WS_XB = 108 * MiB  ,
                 WS_BIG = 172 * MiB, WS_H = WS_BIG  , WS_QKV = WS_BIG  , WS_END = 396 * MiB;
constexpr size_t WL_GU1 = 0, WL_D1 = 11 * MiB, WL_WIN = 11 * MiB + 5632 * 1024, WL_WOUT = WL_WIN + 6 * MiB, WL_GU2 = WL_WOUT + 2 * MiB, WL_D2 = WL_GU2 + 11 * MiB, WL_LAYER = 41 * MiB;
static_assert(WL_D2 + 5632 * 1024 == WL_LAYER, "weight map");
constexpr int LDS_BYTES = 155648;
#define LAS __attribute__((address_space(3)))
typedef unsigned short bf16;
typedef unsigned v4u __attribute__((ext_vector_type(4)));
typedef float f32x4 __attribute__((ext_vector_type(4)));
#define LDS_WAIT() asm volatile("s_waitcnt lgkmcnt(0)" ::: "memory")
__device__ __forceinline__ float wave_sum(float v) { return wave_sum_u(v); }
__device__ __forceinline__ int std8(int o) { return 16 * ((o >> 2) & 1) + 4 * (o >> 3) + (o & 3); }
__device__ __forceinline__ int rowmap(int mode, int nn) {
    if (mode == 0) return (nn & ~31) + std8(nn & 31);
    if (mode == 1) { const int bj = nn >= DFF ? 1 : 0, i = nn - DFF * bj, ip = i & 127; return 256 * (i >> 7) + 128 * bj + (ip & ~31) + std8(ip & 31); }
    const int d = nn & 63; return (nn & ~63) + 32 * ((d >> 4) & 1) + 16 * (d >> 5) + 4 * ((d >> 2) & 3) + (d & 3);
}
__device__ __forceinline__ void conv_item(const float* W, int ldw, int coff, int K, int nblk, const float* gain, bf16* WT, int mode, int base, LAS float* scr, int item, int lane) {
    const int kb = item / nblk, nb = item % nblk, k0 = 64 * kb, n0 = 32 * nb;
    { float wv[32]; const float* wp = W + (size_t)(k0 + (lane >> 5)) * ldw + coff + n0 + (lane & 31);
#pragma unroll
      for (int i = 0; i < 32; ++i) wv[i] = wp[(size_t)(2 * i) * ldw];
      if (gain) {
#pragma unroll
          for (int i = 0; i < 32; ++i) wv[i] *= gain[k0 + 2 * i + (lane >> 5)]; }
#pragma unroll
      for (int i = 0; i < 32; ++i) scr[(2 * i + (lane >> 5)) * 33 + (lane & 31)] = wv[i]; }
    LDS_WAIT(); asm volatile("" ::: "memory");
    const int c = lane & 7;
#pragma unroll
    for (int j = 0; j < 4; ++j) { const int n = (lane >> 3) + 8 * j; const LAS float* s = scr + (8 * c) * 33 + n;
        v4u o; o.x = pg8::cvt_pk_bf16(s[0 * 33], s[1 * 33]); o.y = pg8::cvt_pk_bf16(s[2 * 33], s[3 * 33]); o.z = pg8::cvt_pk_bf16(s[4 * 33], s[5 * 33]); o.w = pg8::cvt_pk_bf16(s[6 * 33], s[7 * 33]);
        *(v4u*)(WT + (size_t)(base + rowmap(mode, n0 + n)) * K + k0 + 8 * c) = o; }
    LDS_WAIT(); asm volatile("" ::: "memory");
}
#define XB_TMO      128
#define XB_XCNT(j)  (256  + 64 * (j))
#define XB_XSUB(j)  (1280 + 64 * (j))
#define XB_XGEN(j)  (2304 + 64 * (j))
#define XB_TOP      3328
#define XB_TOPGEN   3392
#define XCD_BAR_WORDS 3456
#define XB_SPIN_CAP (1u << 18)

__device__ __forceinline__ unsigned xb_ld(unsigned* p)              { return __hip_atomic_load(p, __ATOMIC_RELAXED, __HIP_MEMORY_SCOPE_AGENT); }
__device__ __forceinline__ unsigned xb_add(unsigned* p, unsigned v) { return __hip_atomic_fetch_add(p, v, __ATOMIC_RELAXED, __HIP_MEMORY_SCOPE_AGENT); }
__device__ __forceinline__ unsigned xb_xcc_id() { return (unsigned)__builtin_amdgcn_s_getreg((3 << 11) | 20) & 0xFu; }
#define XB_SPIN(cond, bar) do { unsigned _sp = 0; while (cond) { __builtin_amdgcn_s_sleep(1); \
    if ((++_sp & 255u) == 0u) { if (xb_ld(&(bar)[XB_TMO])) break; if (_sp > XB_SPIN_CAP) { atomicAdd(&(bar)[XB_TMO], 1u); break; } } } } while (0)

struct XcdBarrier {
    unsigned* bar; unsigned x;
    volatile LAS unsigned* st;
};

__device__ __forceinline__ XcdBarrier xcd_barrier_post(unsigned* bar, volatile LAS unsigned* st) {
    XcdBarrier b; b.bar = bar; b.x = xb_xcc_id(); b.st = st;
    if (threadIdx.x == 0) (void)xb_add(&bar[XB_XCNT(b.x)], 1u);
    return b;
}
__device__ __forceinline__ void xcd_barrier_complete(unsigned* bar, unsigned x, unsigned& nloc, unsigned& nx) {
    const unsigned G = gridDim.x * gridDim.y * gridDim.z;
    unsigned sum, cnt, mine, sp = 0u;
    for (;;) {
        sum = 0u; cnt = 0u; mine = 0u;
#pragma unroll
        for (unsigned j = 0; j < 16; ++j) { const unsigned c = xb_ld(&bar[XB_XCNT(j)]); sum += c; cnt += (c > 0u) ? 1u : 0u; mine = (j == x) ? c : mine; }
        if (sum == G) break;
        __builtin_amdgcn_s_sleep(1);
        if ((++sp & 255u) == 0u) { if (xb_ld(&bar[XB_TMO])) break; if (sp > XB_SPIN_CAP) { atomicAdd(&bar[XB_TMO], 1u); break; } }
    }
    nloc = mine > 0u ? mine : 1u; nx = cnt > 0u ? cnt : 1u;
}

__device__ __forceinline__ void xcd_barrier(const XcdBarrier& b) {
    asm volatile("s_waitcnt vmcnt(0)" ::: "memory");
    __syncthreads();
    if (threadIdx.x == 0) {
        unsigned* bar = b.bar;
        __builtin_amdgcn_s_waitcnt(0);
        unsigned nloc = b.st[0], nx = b.st[1];
        if (nloc == 0u) { xcd_barrier_complete(bar, b.x, nloc, nx); b.st[0] = nloc; b.st[1] = nx; }
        const unsigned old = xb_add(&bar[XB_XSUB(b.x)], 1u);
        const unsigned gen = old / nloc;
        if (old + 1u == (gen + 1u) * nloc) {
            __builtin_amdgcn_fence(__ATOMIC_RELEASE, "agent");
            asm volatile("s_waitcnt vmcnt(0)" ::: "memory");
            const unsigned og = xb_add(&bar[XB_TOP], 1u);
            const unsigned tg = og / nx;
            if (og + 1u == (tg + 1u) * nx) xb_add(&bar[XB_TOPGEN], 1u);
            else XB_SPIN(xb_ld(&bar[XB_TOPGEN]) == tg, bar);
            __builtin_amdgcn_fence(__ATOMIC_ACQUIRE, "agent");
            xb_add(&bar[XB_XGEN(b.x)], 1u);
            asm volatile("s_waitcnt vmcnt(0)" ::: "memory");
        } else {
            XB_SPIN(xb_ld(&bar[XB_XGEN(b.x)]) == gen, bar);
            __builtin_amdgcn_fence(__ATOMIC_ACQUIRE, "agent");
            asm volatile("s_waitcnt vmcnt(0)" ::: "memory");
        }
    }
    __syncthreads();
}

struct Args { const float* in[17]; float* out; unsigned char* ws; int ph_lo, ph_hi; };
#define GAS1 __attribute__((address_space(1)))
#define KAS4 __attribute__((address_space(4)))
__device__ __forceinline__ const float* karg_in(int i) { size_t off = 8u * (unsigned)i; asm volatile("" : "+s"(off)); return (const float*)*(const GAS1 float* const KAS4*)((const char KAS4*)__builtin_amdgcn_kernarg_segment_ptr() + off); }
__device__ __forceinline__ float* karg_out() { size_t off = 8u * 17u; asm volatile("" : "+s"(off)); return (float*)*(GAS1 float* const KAS4*)((const char KAS4*)__builtin_amdgcn_kernarg_segment_ptr() + off); }
__device__ __forceinline__ unsigned char* karg_ws() { size_t off = 8u * 18u; asm volatile("" : "+s"(off)); return (unsigned char*)*(GAS1 unsigned char* const KAS4*)((const char KAS4*)__builtin_amdgcn_kernarg_segment_ptr() + off); }
static_assert(offsetof(Args, out) == 8 * 17 && offsetof(Args, ws) == 8 * 18, "kernarg layout");
enum { I_X = 0, I_N1 = 1, I_GU1 = 2, I_D1 = 3, I_NM = 4, I_WIN = 5, I_FB = 6, I_LQ1 = 7, I_LK1 = 8, I_LQ2 = 9, I_LK2 = 10, I_SUB = 11, I_WOUT = 12, I_N2 = 13, I_GU2 = 14, I_D2 = 15, I_NF = 16 };

__device__ __forceinline__ void prologue(LAS unsigned char* lds, int vcu, int G, int tid, int lane, int wave) {
    unsigned char* ws = karg_ws();
    LAS float* scr = (LAS float*)(lds + wave * 16384);
    const int gw = vcu * NWAVES + wave, NGW = G * NWAVES;
    constexpr int J0 = 2816, J1 = 1408, J2 = 768, J3 = 256, J6 = 512, PER_LAYER = 2 * J0 + 2 * J1 + J2 + 3 * J3 + J6;
    for (int it = gw; it < 2 * PER_LAYER; it += NGW) {
        const int l = it / PER_LAYER; int r = it - l * PER_LAYER;
        bf16* wl = (bf16*)(ws + WS_W + (size_t)l * WL_LAYER);
        const float* gu1 = karg_in(I_GU1) + (size_t)l * DMODEL * 2 * DFF; const float* gu2 = karg_in(I_GU2) + (size_t)l * DMODEL * 2 * DFF;
        const float* d1 = karg_in(I_D1) + (size_t)l * DFF * DMODEL; const float* d2 = karg_in(I_D2) + (size_t)l * DFF * DMODEL;
        const float* win = karg_in(I_WIN) + (size_t)l * DMODEL * INC; const float* wout = karg_in(I_WOUT) + (size_t)l * DMODEL * DMODEL;
        const float* n1 = karg_in(I_N1) + l * DMODEL; const float* nm = karg_in(I_NM) + l * DMODEL; const float* n2 = karg_in(I_N2) + l * DMODEL;
        bf16* wwin = (bf16*)((unsigned char*)wl + WL_WIN);
        if (r < J0) { conv_item(gu1, 2 * DFF, 0, DMODEL, 2 * DFF / 32, n1, (bf16*)((unsigned char*)wl + WL_GU1), 1, 0, scr, r, lane); continue; } r -= J0;
        if (r < J1) { conv_item(d1, DMODEL, 0, DFF, DMODEL / 32, nullptr, (bf16*)((unsigned char*)wl + WL_D1), 0, 0, scr, r, lane); continue; } r -= J1;
        if (r < J2) { conv_item(win, INC, 0, DMODEL, 1536 / 32, nm, wwin, 0, 0, scr, r, lane); continue; } r -= J2;
        if (r < J3) { conv_item(win, INC, 1544, DMODEL, 512 / 32, nm, wwin, 2, 1536, scr, r, lane); continue; } r -= J3;
        if (r < J3) { conv_item(win, INC, 2056, DMODEL, 512 / 32, nm, wwin, 2, 2048, scr, r, lane); continue; } r -= J3;
        if (r < J3) { conv_item(win, INC, 2568, DMODEL, 512 / 32, nm, wwin, 0, 2560, scr, r, lane); continue; } r -= J3;
        if (r < J6) { conv_item(wout, DMODEL, 0, DMODEL, DMODEL / 32, nullptr, (bf16*)((unsigned char*)wl + WL_WOUT), 0, 0, scr, r, lane); continue; } r -= J6;
        if (r < J0) { conv_item(gu2, 2 * DFF, 0, DMODEL, 2 * DFF / 32, n2, (bf16*)((unsigned char*)wl + WL_GU2), 1, 0, scr, r, lane); continue; } r -= J0;
        conv_item(d2, DMODEL, 0, DFF, DMODEL / 32, nullptr, (bf16*)((unsigned char*)wl + WL_D2), 0, 0, scr, r, lane);
    }
    const float* x = karg_in(I_X); bf16* XB = (bf16*)(ws + WS_XB); float* ss0 = (float*)(ws + WS_SS);
    for (int m0 = 2 * gw; m0 < M; m0 += 2 * NGW) {
        f32x4 v[2][4];
#pragma unroll
        for (int r = 0; r < 2; ++r)
#pragma unroll
            for (int j = 0; j < 4; ++j) v[r][j] = ((const f32x4*)(x + (size_t)(m0 + r) * DMODEL) + lane)[64 * j];
#pragma unroll
        for (int r = 0; r < 2; ++r) { const int m = m0 + r; float s = 0.f;
#pragma unroll
            for (int j = 0; j < 4; ++j) s += (v[r][j][0] * v[r][j][0] + v[r][j][1] * v[r][j][1]) + (v[r][j][2] * v[r][j][2] + v[r][j][3] * v[r][j][3]);
            s = wave_sum(s);
            unsigned long long* o8 = (unsigned long long*)(XB + (size_t)m * DMODEL) + lane;
#pragma unroll
            for (int j = 0; j < 4; ++j) o8[64 * j] = (unsigned long long)pg8::cvt_pk_bf16(v[r][j][0], v[r][j][1]) | ((unsigned long long)pg8::cvt_pk_bf16(v[r][j][2], v[r][j][3]) << 32);
            if (lane < 16) ss0[(size_t)m * 16 + lane] = lane == 0 ? s : 0.f; }
    }
    float* cosT = (float*)(ws + WS_COS); float* sinT = (float*)(ws + WS_SIN);
    for (int i = vcu * NWAVES * 64 + tid; i < SEQ * 32; i += G * NWAVES * 64) {
        const int pos = i >> 5, d = i & 31; const float inv = 1.0f / powf(10000.0f, (float)d * (1.0f / 32.0f)); const float ang = (float)pos * inv;
        cosT[i] = cosf(ang); sinT[i] = sinf(ang);
    }
}
__device__ __forceinline__ void ff_chunk(int chunk, const bf16* XB, const float* ss, const float* win_l, const float* gain, const float* fbias, float* LC, float* CT, LAS float* sl, int tid, int lane, int wave) {
#pragma unroll 1
    for (int hp = 0; hp < 2; ++hp) {
        float w[16][4];
#pragma unroll
        for (int i = 0; i < 16; ++i) { const int k = (i < 8) ? 8 * lane + i : 512 + 8 * lane + (i - 8); const float g = gain[k];
            const f32x4 a = *(const f32x4*)(win_l + (size_t)k * INC + 1536 + 4 * hp);
            w[i][0] = a[0] * g; w[i][1] = a[1] * g; w[i][2] = a[2] * g; w[i][3] = a[3] * g; }
        const float fb = fbias[4 * hp + (lane & 3)];
#pragma unroll 1
        for (int rr0 = 0; rr0 < 16; rr0 += 4) {
          v4u xav[4], xbv[4]; float ssv[4];
#pragma unroll
          for (int r4 = 0; r4 < 4; ++r4) { const size_t row_ = (size_t)(chunk * 128 + wave * 16 + rr0 + r4);
              xav[r4] = *(const v4u*)(XB + row_ * DMODEL + 8 * lane); xbv[r4] = *(const v4u*)(XB + row_ * DMODEL + 512 + 8 * lane); ssv[r4] = ss[row_ * 16 + (lane & 15)]; }
#pragma unroll
          for (int r4 = 0; r4 < 4; ++r4) {
            const int rr = rr0 + r4;
            const v4u xa = xav[r4], xb = xbv[r4];
            float xs[16];
            xs[0] = __uint_as_float(xa.x << 16); xs[1] = __uint_as_float(xa.x & 0xffff0000u); xs[2] = __uint_as_float(xa.y << 16); xs[3] = __uint_as_float(xa.y & 0xffff0000u);
            xs[4] = __uint_as_float(xa.z << 16); xs[5] = __uint_as_float(xa.z & 0xffff0000u); xs[6] = __uint_as_float(xa.w << 16); xs[7] = __uint_as_float(xa.w & 0xffff0000u);
            xs[8] = __uint_as_float(xb.x << 16); xs[9] = __uint_as_float(xb.x & 0xffff0000u); xs[10] = __uint_as_float(xb.y << 16); xs[11] = __uint_as_float(xb.y & 0xffff0000u);
            xs[12] = __uint_as_float(xb.z << 16); xs[13] = __uint_as_float(xb.z & 0xffff0000u); xs[14] = __uint_as_float(xb.w << 16); xs[15] = __uint_as_float(xb.w & 0xffff0000u);
            float a[4];
#pragma unroll
            for (int h = 0; h < 4; ++h) { float s = 0.f;
#pragma unroll
                for (int i = 0; i < 16; ++i) s += xs[i] * w[i][h];
                a[h] = wave_sum(s); }
            const float q = wave_sum(ssv[r4]) * 0.25f;
            const float rstd = __builtin_amdgcn_rsqf(q * (1.0f / 1024.0f) + 1e-5f);
            const int hh = lane & 3;
            float mine = a[0]; mine = hh == 1 ? a[1] : mine; mine = hh == 2 ? a[2] : mine; mine = hh == 3 ? a[3] : mine;
            const float z = mine * rstd + fb;
            const float lf = fminf(z, 0.f) - log1pf(expf(-fabsf(z)));
            if (lane < 4) sl[(wave * 16 + rr) * 8 + 4 * hp + lane] = lf;
          }
        }
    }
    __syncthreads();
    if (tid < 8) { float c = 0.f; for (int r = 0; r < 128; ++r) { c += sl[r * 8 + tid]; sl[r * 8 + tid] = c; } }
    __syncthreads();
    for (int i = tid; i < 1024; i += NWAVES * 64) { const int h = i >> 7, r = i & 127, row = chunk * 128 + r, b = row >> 14, s = row & 16383; const float v = sl[r * 8 + h];
        LC[((size_t)(b * 8 + h) << 14) + s] = v; if (r == 127) CT[(b * 8 + h) * 128 + (s >> 7)] = v; }
    __syncthreads();
}
__device__ __forceinline__ void diff_combine(int b, int qb, int h, bf16* QKV, float lam, int layer, const float* subln) {
    int tid = threadIdx.x; asm volatile("s_waitcnt vmcnt(0)" : "+v"(tid) :: "memory"); const int lane = tid & 63, wave = __builtin_amdgcn_readfirstlane(tid >> 6);
    int lo_ = layer; asm volatile("" : "+s"(lo_)); const float oscale = lo_ == 0 ? 0.8f : 0.64449094f;
    __builtin_amdgcn_fence(__ATOMIC_ACQUIRE, "agent");
    const size_t row0 = (size_t)b * SEQ + (size_t)qb * 256 + wave * 32; const int ch = lane & 15;
    const f32x4 g0 = *(const f32x4*)(subln + ch * 8) * oscale, g1 = *(const f32x4*)(subln + ch * 8 + 4) * oscale;
    v4u av[8], qv[8];
#pragma unroll
    for (int p = 0; p < 8; ++p) { const size_t row = row0 + p * 4 + (lane >> 4); av[p] = *(const v4u*)(QKV + row * PQ + 3072 + h * 128 + ch * 8); qv[p] = *(const v4u*)(QKV + row * PQ + 512 + h * 128 + ch * 8); }
#pragma unroll
    for (int p = 0; p < 8; ++p) { const size_t row = row0 + p * 4 + (lane >> 4);
        bf16* pq = QKV + row * PQ + 512 + h * 128 + ch * 8;
        const v4u a = av[p], q = qv[p];
        f32x4 d0, d1;
        d0[0] = __uint_as_float(a.x << 16) - lam * __uint_as_float(q.x << 16); d0[1] = __uint_as_float(a.x & 0xffff0000u) - lam * __uint_as_float(q.x & 0xffff0000u);
        d0[2] = __uint_as_float(a.y << 16) - lam * __uint_as_float(q.y << 16); d0[3] = __uint_as_float(a.y & 0xffff0000u) - lam * __uint_as_float(q.y & 0xffff0000u);
        d1[0] = __uint_as_float(a.z << 16) - lam * __uint_as_float(q.z << 16); d1[1] = __uint_as_float(a.z & 0xffff0000u) - lam * __uint_as_float(q.z & 0xffff0000u);
        d1[2] = __uint_as_float(a.w << 16) - lam * __uint_as_float(q.w << 16); d1[3] = __uint_as_float(a.w & 0xffff0000u) - lam * __uint_as_float(q.w & 0xffff0000u);
        float s = (d0[0] * d0[0] + d0[1] * d0[1]) + (d0[2] * d0[2] + d0[3] * d0[3]) + (d1[0] * d1[0] + d1[1] * d1[1]) + (d1[2] * d1[2] + d1[3] * d1[3]);
        s = row16_sum(s);
        const float r = __builtin_amdgcn_rsqf(s * (1.0f / 128.0f) + 1e-5f);
        d0 = d0 * r * g0; d1 = d1 * r * g1;
        v4u o; o.x = pg8::cvt_pk_bf16(d0[0], d0[1]); o.y = pg8::cvt_pk_bf16(d0[2], d0[3]); o.z = pg8::cvt_pk_bf16(d1[0], d1[1]); o.w = pg8::cvt_pk_bf16(d1[2], d1[3]);
        *(v4u*)pq = o; }
}

__global__ void __launch_bounds__(NWAVES * 64, 2) mega_fwd(Args args) {
    extern __shared__ __attribute__((aligned(16))) unsigned char lds[];
    LAS unsigned char* ldsl = (LAS unsigned char*)lds;
#define OPQ_TID() int tid = threadIdx.x; asm volatile("" : "+v"(tid)); const int lane = tid & 63, wave = __builtin_amdgcn_readfirstlane(tid >> 6)
#define UNI() int G = gridDim.x, bx = blockIdx.x; asm volatile("" : "+s"(G), "+s"(bx)); const int vcu = (G % 8 == 0) ? (bx % 8) * (G / 8) + bx / 8 : bx; (void)vcu
    cg::grid_group grid = cg::this_grid();
    if (threadIdx.x < 2) ((volatile LAS unsigned*)(ldsl + MISC_OFF))[threadIdx.x] = 0u;
    __syncthreads();
    XcdBarrier xbar = xcd_barrier_post((unsigned*)(karg_ws() + WS_CTL) + 1024, (volatile LAS unsigned*)(ldsl + MISC_OFF));
#define PTRS() UNI(); unsigned char* ws = karg_ws();     bf16* XB = (bf16*)(ws + WS_XB); bf16* HB = (bf16*)(ws + WS_H); bf16* QKV = (bf16*)(ws + WS_QKV); \
    float* LC = (float*)(ws + WS_LC); float* CT = (float*)(ws + WS_CT); float* SS = (float*)(ws + WS_SS); const float* cosT = (const float*)(ws + WS_COS); const float* sinT = (const float*)(ws + WS_SIN); \
    const unsigned char* wl = ws + WS_W + (size_t)l * WL_LAYER; float* ssl = SS + (size_t)(3 * l) * M * 16; \
    (void)XB; (void)HB; (void)QKV; (void)LC; (void)CT; (void)cosT; (void)sinT; (void)wl; (void)ssl
#ifndef PROBE
#define PROBE 0
#endif
#ifndef PHMASK
#define PHMASK 0x1ff
#endif
#define EN(kind) (((PHMASK) >> (kind)) & 1)
#define IN(k) true
#define SEAM(k) do { if (IN(k) && IN((k) + 1)) { if ((k) == 0) grid.sync(); else xcd_barrier(xbar); } } while (0)
    for (int rp = 0; rp < (PROBE == 1 ? 2 : 1); ++rp)
    if (EN(0) && IN(0)) { UNI(); OPQ_TID(); prologue(ldsl, vcu, G, tid, lane, wave); __syncthreads(); if (PROBE == 1) grid.sync(); }
    if (PROBE == 5) for (int rp = 0; rp < 20; ++rp) grid.sync();
    SEAM(0);
#pragma unroll 1
    for (int l = 0; l < 2; ++l) {
        const int p0 = 1 + 7 * l;
        for (int rp = 0; rp < ((PROBE == 2 && l == 0) ? 3 : 1); ++rp)
        if (EN(1) && IN(p0 + 0)) { PTRS();
            if (PROBE == 2 && rp) grid.sync();
            pg8::Gemm g{XB, (const bf16*)(wl + WL_GU1), M, 2 * DFF, DMODEL, DMODEL}; pg8::StaticOrder S; S.init(M, 2 * DFF, G, bx);
            pg8::EpiSwiGLU E{HB, ssl, DFF};
            pg8::rstd_cache_reset();
            pg8::gemm_phase<pg8::EpiSwiGLU, pg8::StaticOrder, true, true>(ldsl, g, S, E);
        }
        SEAM(p0 + 0);
        if (EN(2) && IN(p0 + 1)) { PTRS();
            pg8::Gemm g{HB, (const bf16*)(wl + WL_D1), M, DMODEL, DFF, DFF}; pg8::StaticOrder S; S.init(M, DMODEL, G, bx);
            pg8::EpiResidual E{l == 0 ? karg_in(I_X) : (const float*)nullptr, XB, (float*)nullptr, XB, ssl + (size_t)1 * M * 16, 0.5f};
            pg8::gemm_phase<pg8::EpiResidual, pg8::StaticOrder, true, true>(ldsl, g, S, E);
        }
        SEAM(p0 + 1);
        for (int rp = 0; rp < (((PROBE == 3 || PROBE == 4) && l == 0) ? 2 : 1); ++rp) {
        if ((PROBE == 3 || PROBE == 4) && rp) grid.sync();
        if (EN(3) && IN(p0 + 2)) { PTRS();
            const float* ssi = ssl + (size_t)1 * M * 16;
            { OPQ_TID();
            for (int chunk = vcu; chunk < M / 128; chunk += G)
                ff_chunk(chunk, XB, ssi, karg_in(I_WIN) + (size_t)l * DMODEL * INC, karg_in(I_NM) + l * DMODEL, karg_in(I_FB) + l * 8, LC, CT, (LAS float*)ldsl, tid, lane, wave); }
            pg8::Gemm g{XB, (const bf16*)(wl + WL_WIN), M, NQKV, DMODEL, DMODEL}; pg8::StaticOrder S; S.init(M, NQKV, G, bx);
            pg8::EpiQKV E{QKV, ssi, cosT, sinT, attn_body::C2, (unsigned*)(ws + WS_CTL + 32768) + l * 128};
            pg8::rstd_cache_reset();
            pg8::gemm_phase<pg8::EpiQKV, pg8::StaticOrder, true, true>(ldsl, g, S, E);
        }
        SEAM(p0 + 2);
        if (EN(4) && IN(p0 + 3)) { PTRS();
            const float lam_init = (l == 0) ? 0.2f : 0.35550906f;
            float lam;
            { OPQ_TID(); (void)wave;
              const float p1 = wave_sum(karg_in(I_LQ1)[l * 64 + lane] * karg_in(I_LK1)[l * 64 + lane]), p2 = wave_sum(karg_in(I_LQ2)[l * 64 + lane] * karg_in(I_LK2)[l * 64 + lane]);
              lam = __int_as_float(__builtin_amdgcn_readfirstlane(__float_as_int(expf(p1) - expf(p2) + lam_init))); }
            const attn_body::bf16* Qb = (const attn_body::bf16*)QKV; attn_body::bf16* Qw = (attn_body::bf16*)QKV;
            for (int v = vcu; v < 256; v += G) {
                { const int bh = v >> 5, b = bh >> 2, h = bh & 3, sp = v & 31;
#pragma unroll 1
                  for (int j = 0; j < 4; ++j) { const int qb = (j & 1) ? sp : 63 - sp, c = j >> 1;
                      const float* nrm = (const float*)(ws + WS_CTL + 32768) + l * 128;
                      attn_body::attn_unit_dv128<8>(b, qb, Qb + 512 + (h * 2 + c) * 64, Qb + 2048 + (h * 2 + c) * 64, Qb + 2560 + h * 128, (c == 0) ? Qw + 3072 + h * 128 : Qw + 512 + h * 128,
                                                    nrm + ((2 * 2 + b) * 8 + h * 2 + c) * 2, nrm + ((3 * 2 + b) * 8 + h * 2 + c) * 2, (char*)lds); }
#pragma unroll 1
                  for (int j = 0; j < 2; ++j) diff_combine(b, j ? sp : 63 - sp, h, QKV, lam, l, karg_in(I_SUB) + l * 128); }
            }
            {
                const float* nrm = (const float*)(ws + WS_CTL + 32768) + l * 128; unsigned* qctr = (unsigned*)(ws + WS_CTL + 40960) + l * 64 + (PROBE == 3 ? rp * 16 : 0);
                volatile LAS unsigned* qw = (volatile LAS unsigned*)(ldsl + MISC_OFF + 16);
#pragma unroll 1
                for (;;) {
                    if (threadIdx.x == 0) qw[0] = atomicAdd(qctr, 1u);
                    __syncthreads();
                    const int idx = __builtin_amdgcn_readfirstlane((int)qw[0]);
                    if (idx >= 1024) break;
                    const int qb = 63 - (idx >> 4), bh = idx & 15, b = bh >> 3, h = bh & 7;
                    const float* nq_ = nrm + ((0 * 2 + b) * 8 + h) * 2; const float* nk_ = nrm + ((1 * 2 + b) * 8 + h) * 2;
                    const bool nomx = 1.05f * sqrtf((nq_[0] + nq_[1]) * (nk_[0] + nk_[1])) < 40.0f;
                    if (nomx) attn_body::attn_unit<8, true, true>(b, qb, Qb + h * 64, Qb + 1024 + h * 64, Qb + 1536 + h * 64, Qw + h * 64, LC + ((size_t)(b * 8 + h) << 14), CT + (b * 8 + h) * 128, nq_, nk_, (char*)lds);
                    else      attn_body::attn_unit<8, true, false>(b, qb, Qb + h * 64, Qb + 1024 + h * 64, Qb + 1536 + h * 64, Qw + h * 64, LC + ((size_t)(b * 8 + h) << 14), CT + (b * 8 + h) * 128, nq_, nk_, (char*)lds); }
            }
        }
        }
        SEAM(p0 + 3);
        if (EN(5) && IN(p0 + 4)) { PTRS();
            pg8::Gemm g{QKV, (const bf16*)(wl + WL_WOUT), M, DMODEL, DMODEL, PQ}; pg8::StaticOrder S; S.init(M, DMODEL, G, bx);
            pg8::EpiResidual E{(const float*)nullptr, XB, (float*)nullptr, XB, ssl + (size_t)2 * M * 16, 1.0f};
            pg8::gemm_phase<pg8::EpiResidual, pg8::StaticOrder, true, true>(ldsl, g, S, E);
        }
        SEAM(p0 + 4);
        if (EN(6) && IN(p0 + 5)) { PTRS();
            pg8::Gemm g{XB, (const bf16*)(wl + WL_GU2), M, 2 * DFF, DMODEL, DMODEL}; pg8::StaticOrder S; S.init(M, 2 * DFF, G, bx);
            pg8::EpiSwiGLU E{HB, ssl + (size_t)2 * M * 16, DFF};
            pg8::rstd_cache_reset();
            pg8::gemm_phase<pg8::EpiSwiGLU, pg8::StaticOrder, true, true>(ldsl, g, S, E);
        }
        SEAM(p0 + 5);
        if (EN(7) && IN(p0 + 6)) { PTRS();
            pg8::Gemm g{HB, (const bf16*)(wl + WL_D2), M, DMODEL, DFF, DFF}; pg8::StaticOrder S; S.init(M, DMODEL, G, bx);
            pg8::EpiResidual E{(const float*)nullptr, XB, (float*)nullptr, XB, ssl + (size_t)3 * M * 16, 0.5f};
            pg8::gemm_phase<pg8::EpiResidual, pg8::StaticOrder, true, true>(ldsl, g, S, E);
        }
        SEAM(p0 + 6);
    }
    if (EN(8) && IN(15)) {
        UNI(); OPQ_TID();
        const float* ssf = (const float*)(karg_ws() + WS_SS) + (size_t)6 * M * 16; const float* gf = karg_in(I_NF);
        f32x4 gv[4];
#pragma unroll
        for (int j = 0; j < 4; ++j) gv[j] = *((const f32x4*)gf + lane + 64 * j);
        for (int m0 = 4 * (vcu * NWAVES + wave); m0 < M; m0 += 4 * G * NWAVES) {
            f32x4 v[4][4]; float q[4]; const bf16* xbf = (const bf16*)(karg_ws() + WS_XB);
#pragma unroll
            for (int r = 0; r < 4; ++r) { q[r] = ssf[(size_t)(m0 + r) * 16 + (lane & 15)];
#pragma unroll
                for (int j = 0; j < 4; ++j) { const unsigned long long w = ((const unsigned long long*)(xbf + (size_t)(m0 + r) * DMODEL) + lane)[64 * j];
                    v[r][j] = (f32x4){__uint_as_float((unsigned)w << 16), __uint_as_float((unsigned)w & 0xffff0000u), __uint_as_float((unsigned)(w >> 32) << 16), __uint_as_float((unsigned)(w >> 32) & 0xffff0000u)}; } }
#pragma unroll
            for (int r = 0; r < 4; ++r) { const float rstd = __builtin_amdgcn_rsqf(wave_sum(q[r]) * 0.25f * (1.0f / 1024.0f) + 1e-5f);
#pragma unroll
                for (int j = 0; j < 4; ++j) ((f32x4*)(karg_out() + (size_t)(m0 + r) * DMODEL) + lane)[64 * j] = v[r][j] * rstd * gv[j]; }
        }
    }
#undef IN
#undef SEAM
}

extern "C" void kernel_launch(void* const* d_in, const int* in_sizes, int n_in, void* d_out, int out_size, void* d_ws, size_t ws_size, hipStream_t stream) {
    static int grid = 0;
    if (grid == 0) {
        if (n_in != 17 || in_sizes[0] != M * DMODEL || out_size != M * DMODEL || ws_size < WS_END) { fprintf(stderr, "kernel_launch: unexpected shapes (n_in %d, in0 %d, out %d, ws %zu)\n", n_in, n_in > 0 ? in_sizes[0] : -1, out_size, ws_size); grid = -1; return; }
        int dev = 0, cus = 0, per_cu = 0;
        if (hipGetDevice(&dev) != hipSuccess || hipDeviceGetAttribute(&cus, hipDeviceAttributeMultiprocessorCount, dev) != hipSuccess) { grid = -1; return; }
        if (hipFuncSetAttribute((const void*)mega_fwd, hipFuncAttributeMaxDynamicSharedMemorySize, LDS_BYTES) != hipSuccess) { fprintf(stderr, "kernel_launch: hipFuncSetAttribute failed\n"); grid = -1; return; }
        if (hipOccupancyMaxActiveBlocksPerMultiprocessor(&per_cu, (const void*)mega_fwd, NWAVES * 64, LDS_BYTES) != hipSuccess || per_cu < 1) { fprintf(stderr, "kernel_launch: occupancy query says %d\n", per_cu); per_cu = 1; }
        (void)hipGetLastError();
        grid = cus * 1;
    }
    if (grid < 0) return;
    if (hipMemsetAsync((char*)d_ws + WS_CTL, 0, CTL_ZERO_BYTES, stream) != hipSuccess) { fprintf(stderr, "kernel_launch: memset failed\n"); return; }
    Args a{};
    for (int i = 0; i < 17; ++i) a.in[i] = (const float*)d_in[i];
    a.out = (float*)d_out; a.ws = (unsigned char*)d_ws;
#if MK_LAUNCH_PER_PHASE
    for (int p = 0; p < NPHASE; ++p) { a.ph_lo = p; a.ph_hi = p + 1; hipLaunchKernelGGL(mega_fwd, dim3(grid), dim3(NWAVES * 64), LDS_BYTES, stream, a); }
#else
    a.ph_lo = 0; a.ph_hi = NPHASE;
    void* kargs[] = {&a};
    hipError_t e = hipLaunchCooperativeKernel((const void*)mega_fwd, dim3(grid), dim3(NWAVES * 64), kargs, LDS_BYTES, stream);
    if (e != hipSuccess) fprintf(stderr, "kernel_launch: cooperative launch failed: %s (grid %d)\n", hipGetErrorString(e), grid);
#endif
}
```

```cpp
#include <hip/hip_runtime.h>
#include <cstdio>
#include <cstdint>
template <int CTRL> __device__ __forceinline__ float dpp_f(float v) { return __builtin_bit_cast(float, __builtin_amdgcn_update_dpp(0, __builtin_bit_cast(int, v), CTRL, 0xf, 0xf, true)); }
__device__ __forceinline__ float row16_sum(float v) { v += dpp_f<0xB1>(v); v += dpp_f<0x4E>(v); v += dpp_f<0x141>(v); v += dpp_f<0x140>(v); return v; }
__device__ __forceinline__ float row16_max(float v) { v = fmaxf(v, dpp_f<0xB1>(v)); v = fmaxf(v, dpp_f<0x4E>(v)); v = fmaxf(v, dpp_f<0x141>(v)); v = fmaxf(v, dpp_f<0x140>(v)); return v; }
__device__ __forceinline__ float sum_x16_x32(float v) {
    float a = v, b = v; asm volatile("s_nop 1\n\tv_permlane16_swap_b32 %0, %1" : "+v"(a), "+v"(b)); v = a + b;
    a = v; b = v;       asm volatile("s_nop 1\n\tv_permlane32_swap_b32 %0, %1" : "+v"(a), "+v"(b)); return a + b; }
__device__ __forceinline__ float wave_sum_u(float v) { v = row16_sum(v); return (__builtin_bit_cast(float, __builtin_amdgcn_readlane(__builtin_bit_cast(int, v), 0)) + __builtin_bit_cast(float, __builtin_amdgcn_readlane(__builtin_bit_cast(int, v), 16)))
    + (__builtin_bit_cast(float, __builtin_amdgcn_readlane(__builtin_bit_cast(int, v), 32)) + __builtin_bit_cast(float, __builtin_amdgcn_readlane(__builtin_bit_cast(int, v), 48))); }
namespace pg8 {
#define PG8_LAS __attribute__((address_space(3)))
typedef unsigned short bf16_t;
typedef short bf16x8 __attribute__((ext_vector_type(8)));
typedef float f32x4 __attribute__((ext_vector_type(4)));
typedef unsigned u32x4 __attribute__((ext_vector_type(4)));
constexpr int BM = 256, BK = 64, HALF = 128, HTB = HALF * BK * 2  , STAGE_BYTES = 8 * HTB, NXCD = 8, WGM = 8;

__host__ __device__ __forceinline__ int lds_byte(int r, int c) { const int st = (r >> 4) * 2 + (c >> 5), rr = r & 15, cc = c & 31, ob = rr * 64 + cc * 2; return st * 1024 + (ob ^ (((ob >> 9) & 1) << 5)); }
__host__ __device__ __forceinline__ void stage_rc(int b, int& R, int& C) { const int st = b / 1024, sb = b % 1024, swz = sb ^ (((sb >> 9) & 1) << 5); R = (st >> 1) * 16 + swz / 64; C = (st & 1) * 32 + (swz % 64) / 2; }
__host__ __device__ __forceinline__ int perm32(int rho) { const int n = rho >> 4, i = rho & 15; return 8 * (i >> 2) + 4 * n + (i & 3); }

struct Unit { int pm, pn; };
struct Gemm { const bf16_t* A; const bf16_t* Bt; int M, N, K, lda; };

struct StaticOrder {
    int nM, nN, nwg, G, c;
    __host__ __device__ void init(int M, int N, int G_, int c_) { nM = M / BM; nN = N / BM; nwg = nM * nN; G = G_; c = c_; }
    __host__ __device__ bool next(int i, Unit& u) const {
        const long L = (long)i * G + c; if (L >= nwg) return false;
        int wgid = (int)L; { const int q = nwg / NXCD, r = nwg % NXCD, xcd = wgid % NXCD, off = wgid / NXCD; wgid = (xcd < r ? xcd * (q + 1) : r * (q + 1) + (xcd - r) * q) + off; }
        const int nig = WGM * nN, gid = wgid / nig, fm = gid * WGM, gsz = (nM - fm) < WGM ? (nM - fm) : WGM;
        u.pm = fm + ((wgid % nig) % gsz); u.pn = (wgid % nig) / gsz; return true;
    }
    __device__ __forceinline__ void a_ready(const Unit&) const {}
    __device__ __forceinline__ void done(const Unit&) const {}
};

__device__ __forceinline__ unsigned cvt_pk_bf16(float lo, float hi) { unsigned r; asm volatile("v_cvt_pk_bf16_f32 %0, %1, %2" : "=v"(r) : "v"(lo), "v"(hi)); return r; }
typedef float f32x2 __attribute__((ext_vector_type(2)));
constexpr float RMS_EPS = 1e-5f;
__device__ __forceinline__ void row_rstd(float (&rs)[2][4], const float* ss, int row0, int fq) {
#pragma unroll
    for (int ai = 0; ai < 2; ++ai)
#pragma unroll
        for (int m = 0; m < 4; ++m) { const f32x4 v = *(const f32x4*)(ss + (size_t)(row0 + ai * HALF + m * 16) * 16 + fq * 4);
            float s = (v[0] + v[1]) + (v[2] + v[3]); s = sum_x16_x32(s); rs[ai][m] = __builtin_amdgcn_rsqf(s * (1.0f / 1024.0f) + RMS_EPS);     }
}
constexpr int RSC_TAG_OFF = 131072, RSC_VAL_OFF = 131072 + 64;
extern __shared__ __attribute__((aligned(16))) unsigned char pg8_dyn_lds[];
__device__ __forceinline__ void rstd_cache_reset() { if ((threadIdx.x & 63) == 0) ((PG8_LAS int*)((PG8_LAS unsigned char*)pg8_dyn_lds + RSC_TAG_OFF))[threadIdx.x >> 6] = -1; }
__device__ __forceinline__ void row_rstd_cached(float (&rs)[2][4], const float* ss, int pm, int wr, int wc, int fr, int fq) {
    const int wid = wr * 4 + wc, lane = fq * 16 + fr;
    PG8_LAS int* tag = (PG8_LAS int*)((PG8_LAS unsigned char*)pg8_dyn_lds + RSC_TAG_OFF) + wid;
    PG8_LAS f32x4* val = (PG8_LAS f32x4*)((PG8_LAS unsigned char*)pg8_dyn_lds + RSC_VAL_OFF) + (wid * 64 + lane) * 2;
    if (__builtin_amdgcn_readfirstlane(tag[0]) == pm) { const f32x4 a = val[0], b = val[1];
        rs[0][0] = a[0]; rs[0][1] = a[1]; rs[0][2] = a[2]; rs[0][3] = a[3]; rs[1][0] = b[0]; rs[1][1] = b[1]; rs[1][2] = b[2]; rs[1][3] = b[3]; }
    else { row_rstd(rs, ss, pm * BM + wr * 64 + fr, fq);
        val[0] = (f32x4){rs[0][0], rs[0][1], rs[0][2], rs[0][3]}; val[1] = (f32x4){rs[1][0], rs[1][1], rs[1][2], rs[1][3]};
        if (lane == 0) tag[0] = pm; }
}
__device__ __forceinline__ float silu_mul(float g, float u) { const float e = __builtin_amdgcn_exp2f(g * -1.4426950408889634f); return g * u * __builtin_amdgcn_rcpf(1.0f + e); }
struct EpiSwiGLU {
    static constexpr bool PERM = false, AFTER_DRAIN = false;
    bf16_t* H; const float* ss; int ldh;
    __device__ __forceinline__ void operator()(const f32x4 (&acc)[2][2][4][2], const Unit& u, int wr, int wc, int fr, int fq) const {
        const int row0 = u.pm * BM + wr * 64 + fr; float rs[2][4]; row_rstd_cached(rs, ss, u.pm, wr, wc, fr, fq);
        const int col0 = u.pn * HALF + wc * 32 + 8 * fq;
#pragma unroll
        for (int ai = 0; ai < 2; ++ai)
#pragma unroll
            for (int m = 0; m < 4; ++m) { const float r = rs[ai][m]; bf16_t* rowp = H + (size_t)(row0 + ai * HALF + m * 16) * ldh + col0;
                const f32x4 g0 = acc[ai][0][m][0] * r, g1 = acc[ai][0][m][1] * r, u0 = acc[ai][1][m][0] * r, u1 = acc[ai][1][m][1] * r;
                u32x4 w; w.x = cvt_pk_bf16(silu_mul(g0[0], u0[0]), silu_mul(g0[1], u0[1])); w.y = cvt_pk_bf16(silu_mul(g0[2], u0[2]), silu_mul(g0[3], u0[3]));
                w.z = cvt_pk_bf16(silu_mul(g1[0], u1[0]), silu_mul(g1[1], u1[1])); w.w = cvt_pk_bf16(silu_mul(g1[2], u1[2]), silu_mul(g1[3], u1[3]));
                *(u32x4*)rowp = w; }
    }
};
struct EpiResidual {
    static constexpr bool PERM = false, AFTER_DRAIN = false;
    const float* src; const bf16_t* srcb; float* dst; bf16_t* xb; float* ss_out; float scale;
    __device__ __forceinline__ void operator()(const f32x4 (&acc)[2][2][4][2], const Unit& u, int wr, int wc, int fr, int fq) const {
        const int row0 = u.pm * BM + wr * 64 + fr, col0 = u.pn * BM + wc * 32 + 8 * fq;
#pragma unroll
        for (int ai = 0; ai < 2; ++ai) {
          u32x4 xov[4][2];
          if (!src) {
#pragma unroll
                for (int m = 0; m < 4; ++m)
#pragma unroll
                    for (int bj = 0; bj < 2; ++bj) xov[m][bj] = *(const u32x4*)(srcb + (size_t)(row0 + ai * HALF + m * 16) * 1024 + col0 + bj * HALF);
          }
#pragma unroll
            for (int m = 0; m < 4; ++m) { const int row = row0 + ai * HALF + m * 16; float q = 0.f;
#pragma unroll
                for (int bj = 0; bj < 2; ++bj) { const size_t off = (size_t)row * 1024 + col0 + bj * HALF;
                    f32x4 a, b;
                    if (src) { a = *(const f32x4*)(src + off); b = *(const f32x4*)(src + off + 4); }
                    else { const u32x4 xo = xov[m][bj];
                        a = (f32x4){__uint_as_float(xo.x << 16), __uint_as_float(xo.x & 0xffff0000u), __uint_as_float(xo.y << 16), __uint_as_float(xo.y & 0xffff0000u)};
                        b = (f32x4){__uint_as_float(xo.z << 16), __uint_as_float(xo.z & 0xffff0000u), __uint_as_float(xo.w << 16), __uint_as_float(xo.w & 0xffff0000u)}; }
                    a = a + acc[ai][bj][m][0] * scale; b = b + acc[ai][bj][m][1] * scale;
                    if (dst) { *(f32x4*)(dst + off) = a; *(f32x4*)(dst + off + 4) = b; }
                    u32x4 w; w.x = cvt_pk_bf16(a[0], a[1]); w.y = cvt_pk_bf16(a[2], a[3]); w.z = cvt_pk_bf16(b[0], b[1]); w.w = cvt_pk_bf16(b[2], b[3]);
                    if (xb) *(u32x4*)(xb + off) = w;
                    q += (a[0] * a[0] + a[1] * a[1]) + (a[2] * a[2] + a[3] * a[3]) + (b[0] * b[0] + b[1] * b[1]) + (b[2] * b[2] + b[3] * b[3]); }
                q = sum_x16_x32(q);
                if (fq == 0) ss_out[(size_t)row * 16 + u.pn * 4 + wc] = q; }
        }
    }
};
struct EpiQKV {
    static constexpr bool PERM = false, AFTER_DRAIN = false;
    bf16_t* O; const float* ss; const float* cosT; const float* sinT; float qscale; unsigned* nrm;
    __device__ __forceinline__ void operator()(const f32x4 (&acc)[2][2][4][2], const Unit& u, int wr, int wc, int fr, int fq) const {
        typedef unsigned u32x2v __attribute__((ext_vector_type(2)));
        const int row0 = u.pm * BM + wr * 64 + fr; float rs[2][4]; row_rstd_cached(rs, ss, u.pm, wr, wc, fr, fq);
        const int pn = u.pn, rg = pn >> 1; const bool rope = (pn >= 6 && pn < 10);
        const int cbase = (rg == 0 ? 0 : rg == 1 ? 1024 : rg == 2 ? 1536 : rg == 3 ? 512 : rg == 4 ? 2048 : 2560) + (pn & 1) * 256; const float sc = (pn < 2 || pn == 6 || pn == 7) ? qscale : 1.0f;
        if (!rope) {
            const int col0 = cbase + wc * 32 + 8 * fq; float mx[2] = {0.f, 0.f};
#pragma unroll
            for (int ai = 0; ai < 2; ++ai)
#pragma unroll
                for (int m = 0; m < 4; ++m) { const float r = rs[ai][m] * sc; bf16_t* rowp = O + (size_t)(row0 + ai * HALF + m * 16) * 3584 + col0;
#pragma unroll
                    for (int bj = 0; bj < 2; ++bj) { const f32x4 v0 = acc[ai][bj][m][0] * r, v1 = acc[ai][bj][m][1] * r;
                        u32x4 w; w.x = cvt_pk_bf16(v0[0], v0[1]); w.y = cvt_pk_bf16(v0[2], v0[3]); w.z = cvt_pk_bf16(v1[0], v1[1]); w.w = cvt_pk_bf16(v1[2], v1[3]);
                        *(u32x4*)(rowp + bj * HALF) = w;
                        if (pn < 4) { float q = (v0[0] * v0[0] + v0[1] * v0[1]) + (v0[2] * v0[2] + v0[3] * v0[3]) + (v1[0] * v1[0] + v1[1] * v1[1]) + (v1[2] * v1[2] + v1[3] * v1[3]);
                            q = sum_x16_x32(q); mx[bj] = fmaxf(mx[bj], q); } } }
            if (pn < 4) {
#pragma unroll
                for (int bj = 0; bj < 2; ++bj) { float v = mx[bj]; v = row16_max(v);
                    if (fr == 0 && fq == 0) atomicMax(nrm + (((pn >> 1) * 2 + (u.pm >> 6)) * 8 + (pn & 1) * 4 + 2 * bj + (wc >> 1)) * 2 + (wc & 1), __float_as_uint(v)); } }
        } else {
            const int d0 = 16 * (wc & 1) + 4 * fq, colb = cbase + (wc >> 1) * 64 + d0; float mx[2] = {0.f, 0.f};
#pragma unroll
            for (int ai = 0; ai < 2; ++ai) {
                f32x4 cv[4], sv[4];
#pragma unroll
                for (int m = 0; m < 4; ++m) { const int pos_ = (row0 + ai * HALF + m * 16) & 16383; cv[m] = *(const f32x4*)(cosT + pos_ * 32 + d0); sv[m] = *(const f32x4*)(sinT + pos_ * 32 + d0); }
#pragma unroll
                for (int m = 0; m < 4; ++m) { const int row = row0 + ai * HALF + m * 16; const float r = rs[ai][m] * sc;
                    const f32x4 c4 = cv[m], s4 = sv[m];
                    bf16_t* rowp = O + (size_t)row * 3584 + colb;
#pragma unroll
                    for (int bj = 0; bj < 2; ++bj) { const f32x4 x1 = acc[ai][bj][m][0] * r, x2 = acc[ai][bj][m][1] * r;
                        const f32x4 o1 = x1 * c4 - x2 * s4, o2 = x2 * c4 + x1 * s4;
                        u32x2v w1, w2; w1.x = cvt_pk_bf16(o1[0], o1[1]); w1.y = cvt_pk_bf16(o1[2], o1[3]); w2.x = cvt_pk_bf16(o2[0], o2[1]); w2.y = cvt_pk_bf16(o2[2], o2[3]);
                        *(u32x2v*)(rowp + bj * HALF) = w1; *(u32x2v*)(rowp + bj * HALF + 32) = w2;
                        { float q = (x1[0] * x1[0] + x1[1] * x1[1]) + (x1[2] * x1[2] + x1[3] * x1[3]) + (x2[0] * x2[0] + x2[1] * x2[1]) + (x2[2] * x2[2] + x2[3] * x2[3]);
                          q = sum_x16_x32(q); mx[bj] = fmaxf(mx[bj], q); } } } }
#pragma unroll
            for (int bj = 0; bj < 2; ++bj) { float v = row16_max(mx[bj]);
                if (fr == 0 && fq == 0) atomicMax(nrm + (((pn >> 1) * 2 - 2 + (u.pm >> 6)) * 8 + (pn & 1) * 4 + 2 * bj + (wc >> 1)) * 2 + (wc & 1), __float_as_uint(v)); }
        }
    }
};

template <class Epi, class Sched, bool ALIGN_EPI = false, bool SP2 = false>
__device__ __forceinline__ void gemm_phase(PG8_LAS unsigned char* lds, const Gemm g, const Sched& S, const Epi& E) {
    int tid_ = threadIdx.x; asm volatile("" : "+v"(tid_));
    const int tid = tid_, wid = __builtin_amdgcn_readfirstlane(tid >> 6), lane = tid & 63, wr = wid >> 2, wc = wid & 3, fr = lane & 15, fq = lane >> 4;
    const int K = g.K, nt = K / BK;
    unsigned voffA[2], voffB[2];
#pragma unroll
    for (int i = 0; i < 2; ++i) { int R, C; stage_rc(tid * 16 + i * 8192, R, C); const int Rb = Epi::PERM ? ((R & ~31) + perm32(R & 31)) : R;
        voffA[i] = (unsigned)(R * g.lda + C) * 2u; voffB[i] = (unsigned)(Rb * K + C) * 2u; }
    const size_t kstep = (size_t)(BK * 2);
    const size_t hstep = (size_t)HALF * K * 2;
    const size_t tstep = 2 * hstep;
    const size_t hstepA = (size_t)HALF * g.lda * 2, tstepA = 2 * hstepA;
    const unsigned ldsw = (unsigned)wid * 1024u;
    const int aoff = lds_byte(wr * 64 + fr, fq * 8), boff = lds_byte(wc * 32 + fr, fq * 8);
#define PG8_SA(b, h) (((b) * 2 + (h)) * HTB)
#define PG8_SB(b, h) ((4 + (b) * 2 + (h)) * HTB)
#define PG8_STAGE(bufoff, gbase, voff) do { _Pragma("unroll") for (int _i = 0; _i < 2; ++_i) \
        __builtin_amdgcn_global_load_lds((const unsigned*)((const char*)(gbase) + (voff)[_i]), (PG8_LAS unsigned*)(lds + (bufoff) + ldsw + _i * 8192), 16, 0, 0); } while (0)
#define PG8_LDA(dst, b, h) do { _Pragma("unroll") for (int m = 0; m < 4; ++m) _Pragma("unroll") for (int k = 0; k < 2; ++k) dst[m][k] = *(const PG8_LAS bf16x8*)(lds + PG8_SA(b, h) + aoff + m * 2048 + k * 1024); } while (0)
#define PG8_LDB(dst, b, h) do { _Pragma("unroll") for (int n = 0; n < 2; ++n) _Pragma("unroll") for (int k = 0; k < 2; ++k) dst[n][k] = *(const PG8_LAS bf16x8*)(lds + PG8_SB(b, h) + boff + n * 2048 + k * 1024); } while (0)
#define PG8_MMA(ai, bj, At, Bt) do { __builtin_amdgcn_s_setprio(1); _Pragma("unroll") for (int m = 0; m < 4; ++m) _Pragma("unroll") for (int n = 0; n < 2; ++n) _Pragma("unroll") for (int k = 0; k < 2; ++k) \
        acc[ai][bj][m][n] = __builtin_amdgcn_mfma_f32_16x16x32_bf16(Bt[n][k], At[m][k], acc[ai][bj][m][n], 0, 0, 0); __builtin_amdgcn_s_setprio(0); } while (0)
#define PG8_WAIT_V(n) asm volatile("s_waitcnt vmcnt(" #n ")" ::: "memory")
#define PG8_WAIT_L(n) asm volatile("s_waitcnt lgkmcnt(" #n ")" ::: "memory")
#define PG8_BAR __builtin_amdgcn_s_barrier()
#define PG8_SCHED __builtin_amdgcn_sched_barrier(0)
    Unit cur, nxt; int ui = 0;
    if (!S.next(0, cur)) return;
    f32x4 acc[2][2][4][2];
#pragma unroll
    for (int a = 0; a < 2; ++a)
#pragma unroll
        for (int b = 0; b < 2; ++b)
#pragma unroll
            for (int m = 0; m < 4; ++m)
#pragma unroll
                for (int n = 0; n < 2; ++n) acc[a][b][m][n] = (f32x4){0.f, 0.f, 0.f, 0.f};
    bf16x8 At[4][2], B0[2][2], B1[2][2];
    const char* cA = (const char*)g.A + (size_t)cur.pm * tstepA; const char* cB = (const char*)g.Bt + (size_t)cur.pn * tstep;
    S.a_ready(cur);
    if constexpr (SP2) {
        PG8_STAGE(PG8_SB(0, 0), cB, voffB); PG8_STAGE(PG8_SB(0, 1), cB + hstep, voffB); PG8_STAGE(PG8_SA(0, 0), cA, voffA); PG8_STAGE(PG8_SA(0, 1), cA + hstepA, voffA);
        if (wr == 1) PG8_BAR;
        PG8_WAIT_V(2); PG8_BAR;
        PG8_STAGE(PG8_SB(1, 0), cB + kstep, voffB); PG8_STAGE(PG8_SA(1, 0), cA + kstep, voffA); PG8_STAGE(PG8_SB(1, 1), cB + hstep + kstep, voffB);
        PG8_WAIT_V(6); PG8_BAR;
    } else {
        PG8_STAGE(PG8_SB(0, 0), cB, voffB); PG8_STAGE(PG8_SA(0, 0), cA, voffA); PG8_STAGE(PG8_SB(0, 1), cB + hstep, voffB); PG8_STAGE(PG8_SA(0, 1), cA + hstepA, voffA);
        if (wr == 1) PG8_BAR;
        PG8_WAIT_V(4); PG8_BAR;
        PG8_STAGE(PG8_SB(1, 0), cB + kstep, voffB); PG8_STAGE(PG8_SA(1, 0), cA + kstep, voffA); PG8_STAGE(PG8_SB(1, 1), cB + hstep + kstep, voffB);
        PG8_WAIT_V(6); PG8_BAR;
    }
    for (;;) {
        const bool has_next = S.next(ui + 1, nxt);
        const char* nA = has_next ? (const char*)g.A + (size_t)nxt.pm * tstepA : cA; const char* nB = has_next ? (const char*)g.Bt + (size_t)nxt.pn * tstep : cB;
        for (int t = 0; t < nt; t += 2) {
            const bool last = (t == nt - 2);
            const char* a1 = cA + (size_t)(t + 1) * kstep;
            const char* a2 = last ? nA : cA + (size_t)(t + 2) * kstep; const char* b2 = last ? nB : cB + (size_t)(t + 2) * kstep;
            const char* a3 = a2 + kstep; const char* b3 = b2 + kstep;
            if (last && has_next) S.a_ready(nxt);
            if constexpr (SP2) {
            PG8_LDB(B0, 0, 0); PG8_LDB(B1, 0, 1); PG8_SCHED; PG8_LDA(At, 0, 0); PG8_STAGE(PG8_SA(1, 1), a1 + hstepA, voffA);
            PG8_WAIT_V(8); PG8_WAIT_L(0); PG8_BAR; PG8_MMA(0, 0, At, B0); PG8_MMA(0, 1, At, B1); PG8_BAR; PG8_SCHED;
            PG8_LDA(At, 0, 1); PG8_STAGE(PG8_SB(0, 0), b2, voffB); PG8_STAGE(PG8_SB(0, 1), b2 + hstep, voffB); PG8_STAGE(PG8_SA(0, 0), a2, voffA);
            PG8_WAIT_V(8); PG8_WAIT_L(0); PG8_BAR; PG8_MMA(1, 0, At, B0); PG8_MMA(1, 1, At, B1); PG8_BAR; PG8_SCHED;
            PG8_LDB(B0, 1, 0); PG8_LDB(B1, 1, 1); PG8_SCHED; PG8_LDA(At, 1, 0); PG8_STAGE(PG8_SA(0, 1), a2 + hstepA, voffA);
            PG8_WAIT_V(8); PG8_WAIT_L(0); PG8_BAR; PG8_MMA(0, 0, At, B0); PG8_MMA(0, 1, At, B1); PG8_BAR; PG8_SCHED;
            PG8_LDA(At, 1, 1); PG8_STAGE(PG8_SB(1, 0), b3, voffB); PG8_STAGE(PG8_SB(1, 1), b3 + hstep, voffB); PG8_STAGE(PG8_SA(1, 0), a3, voffA);
            PG8_WAIT_V(8); PG8_WAIT_L(0); PG8_BAR; PG8_MMA(1, 0, At, B0); PG8_MMA(1, 1, At, B1); PG8_BAR; PG8_SCHED;
            } else {
            PG8_LDB(B0, 0, 0); PG8_SCHED; PG8_LDA(At, 0, 0); PG8_STAGE(PG8_SA(1, 1), a1 + hstepA, voffA);
            PG8_WAIT_L(8); PG8_BAR; PG8_WAIT_L(0); PG8_MMA(0, 0, At, B0); PG8_BAR; PG8_SCHED;
            PG8_LDB(B1, 0, 1); PG8_STAGE(PG8_SB(0, 0), b2, voffB);
            PG8_BAR; PG8_WAIT_L(0); PG8_MMA(0, 1, At, B1); PG8_BAR;
            PG8_LDA(At, 0, 1); PG8_STAGE(PG8_SA(0, 0), a2, voffA);
            PG8_BAR; PG8_WAIT_L(0); PG8_MMA(1, 0, At, B0); PG8_BAR; PG8_SCHED;
            PG8_STAGE(PG8_SB(0, 1), b2 + hstep, voffB);
            PG8_WAIT_V(6); PG8_BAR; PG8_MMA(1, 1, At, B1); PG8_BAR;
            PG8_LDB(B0, 1, 0); PG8_SCHED; PG8_LDA(At, 1, 0); PG8_STAGE(PG8_SA(0, 1), a2 + hstepA, voffA);
            PG8_WAIT_L(8); PG8_BAR; PG8_WAIT_L(0); PG8_MMA(0, 0, At, B0); PG8_BAR; PG8_SCHED;
            PG8_LDB(B1, 1, 1); PG8_STAGE(PG8_SB(1, 0), b3, voffB);
            PG8_BAR; PG8_WAIT_L(0); PG8_MMA(0, 1, At, B1); PG8_BAR;
            PG8_LDA(At, 1, 1); PG8_STAGE(PG8_SA(1, 0), a3, voffA);
            PG8_BAR; PG8_WAIT_L(0); PG8_MMA(1, 0, At, B0); PG8_BAR; PG8_SCHED;
            PG8_STAGE(PG8_SB(1, 1), b3 + hstep, voffB);
            PG8_WAIT_V(6); PG8_BAR; PG8_MMA(1, 1, At, B1); PG8_BAR;
            }
        }
        if constexpr (ALIGN_EPI) { if (wr == 0) PG8_BAR; }
        if constexpr (!Epi::AFTER_DRAIN) { E(acc, cur, wr, wc, fr, fq); S.done(cur); }
        if (!has_next) break;
#pragma unroll
        for (int a = 0; a < 2; ++a)
#pragma unroll
            for (int b = 0; b < 2; ++b)
#pragma unroll
                for (int m = 0; m < 4; ++m)
#pragma unroll
                    for (int n = 0; n < 2; ++n) acc[a][b][m][n] = (f32x4){0.f, 0.f, 0.f, 0.f};
        cur = nxt; cA = nA; cB = nB; ++ui;
        if constexpr (ALIGN_EPI) { if (wr == 1) PG8_BAR; }
    }
    PG8_WAIT_V(0);
    if constexpr (!ALIGN_EPI) { if (wr == 0) PG8_BAR; }
    PG8_BAR;
    if constexpr (Epi::AFTER_DRAIN) { E.fused(acc, cur, wr, wc, fr, fq, lds, wid, lane); S.done(cur); }
#undef PG8_SA
#undef PG8_SB
#undef PG8_STAGE
#undef PG8_LDA
#undef PG8_LDB
#undef PG8_MMA
#undef PG8_WAIT_V
#undef PG8_WAIT_L
#undef PG8_BAR
#undef PG8_SCHED
}
}

#ifndef PG8_SP2
#define PG8_SP2 true
#endif
#ifndef PG8_ALIGN
#define PG8_ALIGN true
#endif
#include <hip/hip_bf16.h>
#include <cmath>
namespace attn_body {
using bf16=__hip_bfloat16;
using bf16x8=__attribute__((ext_vector_type(8)))short;
using s16x4=__attribute__((ext_vector_type(4)))short;
using f32x16=__attribute__((ext_vector_type(16)))float;
using u32x4=__attribute__((ext_vector_type(4)))unsigned;
constexpr int BATCH=2,SEQ=16384,D=64,PQ=3584;
constexpr int NW=8,QBLK=32,QB=QBLK*NW,KVBLK=64,NQB=SEQ/QB;
constexpr int ATTN_UNIT_ROWS=QB; typedef float f32x4_t __attribute__((ext_vector_type(4)));
__device__ __forceinline__ int crow(int r,int hi){return (r&3)+8*(r>>2)+4*hi;}
#define SBAR() __builtin_amdgcn_sched_barrier(0)
__device__ __forceinline__ void cmask(f32x16&p0,f32x16&p1,int jb,int qrel,int hi){
  const float NEG=-INFINITY; int kb=64*jb+4*hi;
  #pragma unroll
  for(int r=0;r<16;++r){int kv=kb+(r&3)+8*(r>>2); if(kv>qrel)p0[r]=NEG; if(kv+32>qrel)p1[r]=NEG;}
}

constexpr int NSLOT=3, SLOTB=8192;
constexpr int LDS_K=0, LDS_V=NSLOT*SLOTB, LDS_WS=2*NSLOT*SLOTB, LDS_OST=LDS_WS+NW*64*4, LDS_BYTES=LDS_OST+NW*4096;
constexpr int NCS_OFF=LDS_BYTES;
constexpr float C2=0.125f*1.4426950408889634f;
__device__ __forceinline__ void glds16(const void*gsrc,unsigned lds_dst){unsigned keep;
  asm volatile("s_mov_b32 %0, m0\n\ts_mov_b32 m0, %2\n\ts_nop 0\n\tglobal_load_lds_dwordx4 %1, off\n\ts_mov_b32 m0, %0":"=&s"(keep):"v"(gsrc),"s"(lds_dst):"memory");}
__device__ __forceinline__ float max3f(float a,float b,float c){float r;asm("v_max3_f32 %0, %1, %2, %3":"=v"(r):"v"(a),"v"(b),"v"(c));return r;}
__device__ __forceinline__ float max2f(float a,float b){float r;asm("v_max_f32_e32 %0, %1, %2":"=v"(r):"v"(a),"v"(b));return r;}
__device__ __forceinline__ float fadd_s(float a,float b){float r;asm("v_add_f32_e32 %0, %1, %2":"=v"(r):"v"(a),"v"(b));return r;}
__device__ __forceinline__ float fsub_s(float a,float b){float r;asm("v_sub_f32_e32 %0, %1, %2":"=v"(r):"v"(a),"v"(b));return r;}
typedef float f32x2_t __attribute__((ext_vector_type(2))); typedef __bf16 bf16x2_t __attribute__((ext_vector_type(2)));
__device__ __forceinline__ unsigned cvtpk_s(float lo,float hi){f32x2_t v={lo,hi};bf16x2_t b=__builtin_convertvector(v,bf16x2_t);return __builtin_bit_cast(unsigned,b);}
#define WAIT_BAR(N) asm volatile("s_waitcnt vmcnt(" #N ") lgkmcnt(0)\n\ts_barrier":::"memory")

__device__ __forceinline__ void qkt(f32x16&p0,f32x16&p1,const char*Kslot,const bf16x8*qr,const f32x16&negm,int r32,int hi){
  const char*kb=Kslot+hi*1024+r32*16;
  #pragma unroll
  for(int d0=0;d0<4;++d0){
    const bf16x8 b0=*reinterpret_cast<const bf16x8*>(kb+d0*2048);
    const bf16x8 b1=*reinterpret_cast<const bf16x8*>(kb+d0*2048+512);
    if(d0==0){p0=__builtin_amdgcn_mfma_f32_32x32x16_bf16(b0,qr[0],negm,0,0,0);p1=__builtin_amdgcn_mfma_f32_32x32x16_bf16(b1,qr[0],negm,0,0,0);}
    else{p0=__builtin_amdgcn_mfma_f32_32x32x16_bf16(b0,qr[d0],p0,0,0,0);p1=__builtin_amdgcn_mfma_f32_32x32x16_bf16(b1,qr[d0],p1,0,0,0);}}
}
typedef __attribute__((address_space(3))) const char* lds_cptr;
typedef short v4i16_t __attribute__((ext_vector_type(4)));
__device__ __forceinline__ void kload8(bf16x8*kf,lds_cptr kp){
  kf[0]=*(const __attribute__((address_space(3))) bf16x8*)(kp);      kf[1]=*(const __attribute__((address_space(3))) bf16x8*)(kp+512);
  kf[2]=*(const __attribute__((address_space(3))) bf16x8*)(kp+2048); kf[3]=*(const __attribute__((address_space(3))) bf16x8*)(kp+2560);
  kf[4]=*(const __attribute__((address_space(3))) bf16x8*)(kp+4096); kf[5]=*(const __attribute__((address_space(3))) bf16x8*)(kp+4608);
  kf[6]=*(const __attribute__((address_space(3))) bf16x8*)(kp+6144); kf[7]=*(const __attribute__((address_space(3))) bf16x8*)(kp+6656);
}
__device__ __forceinline__ void kload2(bf16x8*kf,lds_cptr kp,int j){ kf[2*j]=*(const __attribute__((address_space(3))) bf16x8*)(kp+j*2048); kf[2*j+1]=*(const __attribute__((address_space(3))) bf16x8*)(kp+j*2048+512); }
__device__ __forceinline__ s16x4 vtr(lds_cptr p){ return __builtin_bit_cast(s16x4,__builtin_amdgcn_ds_read_tr16_b64_v4i16((__attribute__((address_space(3))) v4i16_t*)p)); }
__device__ __forceinline__ float rowmax(const f32x16&p0,const f32x16&p1){
  float a=max3f(p0[0],p0[1],p1[0]),b=max3f(p0[2],p0[3],p1[1]);a=max3f(a,p1[2],p1[3]);
  #pragma unroll
  for(int r=4;r<16;r+=4){a=max3f(a,p0[r],p0[r+1]);b=max3f(b,p0[r+2],p0[r+3]);a=max3f(a,p1[r],p1[r+1]);b=max3f(b,p1[r+2],p1[r+3]);}
  const float m=max2f(a,b);
  auto rr=__builtin_amdgcn_permlane32_swap(__float_as_uint(m),__float_as_uint(m),false,false);
  return max2f(__uint_as_float(rr[0]),__uint_as_float(rr[1]));
}
__device__ __forceinline__ void pv(f32x16*o,int vb,bf16x8 pa0,bf16x8 pa1,bf16x8 pa2,bf16x8 pa3){
  #pragma unroll
  for(int d0=0;d0<2;++d0){s16x4 lo[4],hi[4];
    #pragma unroll
    for(int ks=0;ks<4;++ks){
      asm volatile("ds_read_b64_tr_b16 %0,%1 offset:%c2":"=&v"(lo[ks]):"v"(vb),"i"(d0*4096+ks*1024):"memory");
      asm volatile("ds_read_b64_tr_b16 %0,%1 offset:%c2":"=&v"(hi[ks]):"v"(vb),"i"(d0*4096+ks*1024+512):"memory");}
    asm volatile("s_waitcnt lgkmcnt(0)":::"memory");SBAR();
    #define PK(k) (bf16x8){lo[k][0],lo[k][1],lo[k][2],lo[k][3],hi[k][0],hi[k][1],hi[k][2],hi[k][3]}
    o[d0]=__builtin_amdgcn_mfma_f32_32x32x16_bf16(pa0,PK(0),o[d0],0,0,0);
    o[d0]=__builtin_amdgcn_mfma_f32_32x32x16_bf16(pa1,PK(1),o[d0],0,0,0);
    o[d0]=__builtin_amdgcn_mfma_f32_32x32x16_bf16(pa2,PK(2),o[d0],0,0,0);
    o[d0]=__builtin_amdgcn_mfma_f32_32x32x16_bf16(pa3,PK(3),o[d0],0,0,0);
    #undef PK
  }
}

#ifndef ATTN_STORE16
#define ATTN_STORE16(p,v) (*(u32x4*)(p)=(v))
#endif
template<int THRL,bool FOX,bool NOMX> __device__ __forceinline__ void attn_unit(int b,int qb,const bf16*Q,const bf16*__restrict__ K,const bf16*__restrict__ V,bf16*O,const float*lc,const float*ctot,const float*nq,const float*nk,char*shm){
  int tid_=threadIdx.x; asm volatile("":"+v"(tid_));   const int tid=tid_,lane=tid&63,r32=lane&31,hi=lane>>5; const int wid=__builtin_amdgcn_readfirstlane(tid>>6);
  const long rowbase=(long)b*SEQ; const int q0=qb*QB;
  const bf16*Qw=Q+(rowbase+q0+wid*QBLK)*PQ;
    typedef __attribute__((address_space(3))) float* lds_fptr;
  const lds_fptr ncs3=(lds_fptr)((__attribute__((address_space(3))) char*)shm+NCS_OFF); float ctq=0.f; int kofs=0;
  if(FOX){
    const lds_fptr pref3=(lds_fptr)((__attribute__((address_space(3))) char*)shm+NCS_OFF+65536);
    __attribute__((address_space(3))) unsigned* cnt3=(__attribute__((address_space(3))) unsigned*)((__attribute__((address_space(3))) char*)shm+NCS_OFF+65536+512);
    if(wid==0){ const float a_=ctot[2*lane],b_=ctot[2*lane+1]; float s_=a_+b_;
      _Pragma("unroll") for(int o_=1;o_<64;o_<<=1){ const float t_=__builtin_bit_cast(float,__builtin_amdgcn_ds_bpermute((lane-o_)<<2,__builtin_bit_cast(int,s_))); if(lane>=o_)s_+=t_; }
      const float ex_=s_-(a_+b_); pref3[2*lane]=ex_; pref3[2*lane+1]=ex_+a_; if(lane==0)cnt3[0]=0u; }
    asm volatile("s_waitcnt lgkmcnt(0)\n\ts_barrier":::"memory");
    { const float thb_=42.0f+2.1f*sqrtf((nq[0]+nq[1])*(nk[0]+nk[1])); const int ntf_=(q0+QB)/KVBLK;
      const float cq0_=(lc[q0]+pref3[q0>>7])*1.4426950408889634f; bool skip_=false;
      if(tid<ntf_-4){ const int s_=64*tid+63; const float cj_=(lc[s_]+pref3[s_>>7])*1.4426950408889634f; skip_=(cq0_-cj_)<=-thb_; }
      const unsigned long long bal_=__ballot(skip_); if(lane==0&&bal_)__hip_atomic_fetch_add(cnt3,(unsigned)__popcll(bal_),__ATOMIC_RELAXED,__HIP_MEMORY_SCOPE_WORKGROUP); }
    asm volatile("s_waitcnt lgkmcnt(0)\n\ts_barrier":::"memory");
    kofs=__builtin_amdgcn_readfirstlane((int)(cnt3[0]&~1u))*KVBLK;
    const int n4_=(q0+QB)>>2;
    for(int i_=tid+(kofs>>2);i_<n4_;i_+=NW*64){ const f32x4_t v_=*(const f32x4_t*)(lc+4*i_); const float p_=pref3[i_>>5];
      f32x4_t w_; w_[0]=(v_[0]+p_)*-1.4426950408889634f; w_[1]=(v_[1]+p_)*-1.4426950408889634f; w_[2]=(v_[2]+p_)*-1.4426950408889634f; w_[3]=(v_[3]+p_)*-1.4426950408889634f;
      *(__attribute__((address_space(3))) f32x4_t*)(ncs3+4*i_)=w_; }
  }
  const bf16*Kh=K+(rowbase+kofs)*PQ,*Vh=V+(rowbase+kofs)*PQ;
  const unsigned lds0=(unsigned)(uintptr_t)shm;
  float*wsf=(float*)(shm+LDS_WS)+wid*64;
  const bf16*ksrc=Kh+(long)lane*PQ+wid*8;
  const bf16*vsrc=Vh+(long)(16*(wid&3)+(lane>>2))*PQ+(wid>>2)*32+(lane&3)*8;
  const unsigned kdst=lds0+LDS_K+wid*1024, vdst=lds0+LDS_V+wid*1024;
  #define DMA_K(t,slot) glds16(ksrc+(long)(t)*KVBLK*PQ,(unsigned)__builtin_amdgcn_readfirstlane(kdst+(slot)))
  #define DMA_V(t,slot) glds16(vsrc+(long)(t)*KVBLK*PQ,(unsigned)__builtin_amdgcn_readfirstlane(vdst+(slot)))
  const int vb0=(int)(lds0+LDS_V)+((lane>>4)&1)*32+(lane&3)*8+(4*hi+((lane&15)>>2))*64;
  const char*Kbase=shm+LDS_K; bf16x8 kf[8];
  const lds_cptr shm3=(lds_cptr)shm; const lds_cptr kp0=shm3+LDS_K+hi*1024+r32*16; const lds_cptr vp0=shm3+LDS_V+((lane>>4)&1)*32+(lane&3)*8+(4*hi+((lane&15)>>2))*64;
  const int NT=(q0+QB-kofs)/KVBLK;
  #define CINIT (FOX?f32x16{}:negm)
  #define FBIAS(P0,P1,t) do{ if(FOX){ const float nm_=ctq-mhat; const __attribute__((address_space(3))) f32x4_t* bp_=(const __attribute__((address_space(3))) f32x4_t*)(ncs3+kofs+64*(t)+4*hi); \
    _Pragma("unroll") for(int g_=0;g_<4;++g_){ const f32x4_t b0_=bp_[2*g_]+nm_, b1_=bp_[2*g_+8]+nm_; \
      _Pragma("unroll") for(int j_=0;j_<4;++j_){ P0[4*g_+j_]+=b0_[j_]; P1[4*g_+j_]+=b1_[j_]; } } } \
    }while(0)
  DMA_K(0,0);DMA_V(0,0);DMA_K(1,SLOTB);
  bf16x8 qr[4];
  #pragma unroll
  for(int d0=0;d0<4;++d0)qr[d0]=*reinterpret_cast<const bf16x8*>(&Qw[(long)r32*PQ+d0*16+hi*8]);
  float mhat=0.f,l_reg=0.f;f32x16 o[2];o[0]=f32x16{};o[1]=f32x16{};f32x16 negm=f32x16{}; if(!FOX){asm volatile("":"+v"(negm));}
  const int qrel=wid*QBLK+r32;
  #define CMASK(P0,P1,t) do{int jb_=(t)-(NT-4); if(jb_>=0)cmask(P0,P1,jb_,qrel,hi);}while(0)
  bool resc=false;
  #define START(P0,P1) do{ resc=false; \
    if(!NOMX){ const float rm=rowmax(P0,P1); const float dl=rm; mhat=fadd_s(mhat,dl); \
      _Pragma("unroll") for(int r=0;r<16;++r){P0[r]=fsub_s(P0[r],dl);P1[r]=fsub_s(P1[r],dl);} \
      if(!FOX){ _Pragma("unroll") for(int r=0;r<16;++r)negm[r]=-mhat; asm volatile("":"+v"(negm)); } } \
    _Pragma("unroll") for(int r=0;r<16;++r)P0[r]=__builtin_amdgcn_exp2f(P0[r]); }while(0)
  #define RESC() do{ if(resc){ asm volatile("s_waitcnt lgkmcnt(0)":::"memory"); \
      _Pragma("unroll") for(int d_=0;d_<2;++d_) _Pragma("unroll") for(int r=0;r<16;++r)o[d_][r]*=wsf[crow(r,hi)]; } }while(0)
  f32x16 pA0,pA1,pB0,pB1;
  int sl_prev=0,sl_cur=0,sl_next=SLOTB;
  #define ROT() do{sl_prev=sl_cur;sl_cur=sl_next;sl_next=(sl_next==(NSLOT-1)*SLOTB)?0:sl_next+SLOTB;}while(0)
  DMA_K(2,2*SLOTB);
  WAIT_BAR(3); if(FOX){ ctq=-ncs3[q0+wid*QBLK+r32]; }
  qkt(pA0,pA1,Kbase,qr,CINIT,r32,hi);asm volatile("s_nop 15\n\ts_nop 7":"+v"(pA0),"+v"(pA1));FBIAS(pA0,pA1,0);CMASK(pA0,pA1,0);
  START(pA0,pA1);
  _Pragma("unroll") for(int r=0;r<16;++r)pA1[r]=__builtin_amdgcn_exp2f(pA1[r]);
  WAIT_BAR(0);
  DMA_K(3,0);DMA_V(1,SLOTB);
  ROT();
  kload8(kf,kp0+sl_cur);
  WAIT_BAR(2);
  s16x4 vlo[8],vhi[8]; u32x4 pw0,pw1,pw2,pw3;
  #define PKW(P,B) cvtpk_s(P[B],P[B+1])
  #define PAF(k) __builtin_bit_cast(bf16x8,pw##k)
  #define VFR(i) (bf16x8){vlo[i][0],vlo[i][1],vlo[i][2],vlo[i][3],vhi[i][0],vhi[i][1],vhi[i][2],vhi[i][3]}
  #define PIN(x) asm volatile("":"+v"(x))
  #define MX3(a,b,c) __builtin_fmaxf(__builtin_fmaxf((a),(b)),(c))
  #define GAPA(MF,A0,A1,A2,A3,W0,W1,PW) do{ MF; sacc+=A0; sacc+=A1; sacc+=A2; sacc+=A3; PIN(sacc); W0; W1; PIN(PW); SBAR(); }while(0)
  #define EX(v) __builtin_amdgcn_exp2f(v)
  #define GAPB(MF,X,B) do{ MF; X[B]=EX(X[B]); X[B+1]=EX(X[B+1]); X[B+2]=EX(X[B+2]); X[B+3]=EX(X[B+3]); PIN(X); SBAR(); }while(0)
  #define VRD(i) do{ vlo[i]=vtr(vp_+(((i)>>2)*4096+((i)&3)*1024)); vhi[i]=vtr(vp_+(((i)>>2)*4096+((i)&3)*1024+512)); }while(0)
  #define KRD(G,j) do{ if(G){ kload2(kf,kp0+sl_next,j); SBAR(); } }while(0)
  #define STEP(C0,C1,P0,P1,t,GK,GV,GL) do{ SBAR(); \
    const lds_cptr vp_=vp0+sl_prev; \
    VRD(0); SBAR(); float sacc=(P0[0]+P0[1]); \
    GAPA(C0=__builtin_amdgcn_mfma_f32_32x32x16_bf16(kf[0],qr[0],CINIT,0,0,0), P0[2],P0[3],P0[4],P0[5],     pw0[0]=PKW(P0,0), pw0[1]=PKW(P0,2), pw0); \
    VRD(4); SBAR(); GAPA(C1=__builtin_amdgcn_mfma_f32_32x32x16_bf16(kf[1],qr[0],CINIT,0,0,0), P0[6],P0[7],P0[8],P0[9],     pw0[2]=PKW(P0,4), pw0[3]=PKW(P0,6), pw0); \
    VRD(1); SBAR(); GAPA(C0=__builtin_amdgcn_mfma_f32_32x32x16_bf16(kf[2],qr[1],C0,0,0,0),   P0[10],P0[11],P0[12],P0[13], pw1[0]=PKW(P0,8), pw1[1]=PKW(P0,10), pw1); \
    VRD(5); SBAR(); GAPA(C1=__builtin_amdgcn_mfma_f32_32x32x16_bf16(kf[3],qr[1],C1,0,0,0),   P0[14],P0[15],P1[0],P1[1],   pw1[2]=PKW(P0,12),pw1[3]=PKW(P0,14), pw1); \
    VRD(2); SBAR(); GAPA(C0=__builtin_amdgcn_mfma_f32_32x32x16_bf16(kf[4],qr[2],C0,0,0,0),   P1[2],P1[3],P1[4],P1[5],     pw2[0]=PKW(P1,0), pw2[1]=PKW(P1,2), pw2); \
    VRD(6); SBAR(); GAPA(C1=__builtin_amdgcn_mfma_f32_32x32x16_bf16(kf[5],qr[2],C1,0,0,0),   P1[6],P1[7],P1[8],P1[9],     pw2[2]=PKW(P1,4), pw2[3]=PKW(P1,6), pw2); \
    VRD(3); SBAR(); GAPA(C0=__builtin_amdgcn_mfma_f32_32x32x16_bf16(kf[6],qr[3],C0,0,0,0),   P1[10],P1[11],P1[12],P1[13], pw3[0]=PKW(P1,8), pw3[1]=PKW(P1,10), pw3); \
    VRD(7); SBAR(); GAPA(C1=__builtin_amdgcn_mfma_f32_32x32x16_bf16(kf[7],qr[3],C1,0,0,0),   P1[14],P1[15],0.f,0.f,       pw3[2]=PKW(P1,12),pw3[3]=PKW(P1,14), pw3); \
    l_reg+=sacc; \
    if(GK){DMA_K((t)+3,sl_cur);} if(GV){DMA_V((t)+1,sl_next);} \
    FBIAS(C0,C1,t); CMASK(C0,C1,t); \
    { float a=MX3(C0[0],C0[1],C1[0]),b=MX3(C0[2],C0[3],C1[1]); a=MX3(a,C1[2],C1[3]); \
      _Pragma("unroll") for(int r=4;r<16;r+=4){a=MX3(a,C0[r],C0[r+1]);b=MX3(b,C0[r+2],C0[r+3]);a=MX3(a,C1[r],C1[r+1]);b=MX3(b,C1[r+2],C1[r+3]);} \
      float rm=__builtin_fmaxf(a,b); if(NOMX){rm=0.f;} else { auto rr=__builtin_amdgcn_permlane32_swap(__float_as_uint(rm),__float_as_uint(rm),false,false); rm=__builtin_fmaxf(__uint_as_float(rr[0]),__uint_as_float(rr[1])); } \
      resc=false; \
      if(!NOMX&&__builtin_expect(__any(rm>(float)THRL),0)){ const float dl=__builtin_fmaxf(rm,0.f); mhat+=dl; \
        _Pragma("unroll") for(int r=0;r<16;++r){C0[r]-=dl;C1[r]-=dl;} \
        if(!FOX){ _Pragma("unroll") for(int r=0;r<16;++r)negm[r]=-mhat; asm volatile("":"+v"(negm)); } \
        const float f=__builtin_amdgcn_exp2f(-dl); l_reg*=f; if(hi==0)wsf[r32]=f; resc=true; } } \
    SBAR(); \
    GAPB(o[0]=__builtin_amdgcn_mfma_f32_32x32x16_bf16(PAF(0),VFR(0),o[0],0,0,0), C0,0); \
    GAPB(o[1]=__builtin_amdgcn_mfma_f32_32x32x16_bf16(PAF(0),VFR(4),o[1],0,0,0), C0,4); \
    KRD(GL,0); GAPB(o[0]=__builtin_amdgcn_mfma_f32_32x32x16_bf16(PAF(1),VFR(1),o[0],0,0,0), C0,8); \
    KRD(GL,1); GAPB(o[1]=__builtin_amdgcn_mfma_f32_32x32x16_bf16(PAF(1),VFR(5),o[1],0,0,0), C0,12); \
    KRD(GL,2); GAPB(o[0]=__builtin_amdgcn_mfma_f32_32x32x16_bf16(PAF(2),VFR(2),o[0],0,0,0), C1,0); \
    KRD(GL,3); GAPB(o[1]=__builtin_amdgcn_mfma_f32_32x32x16_bf16(PAF(2),VFR(6),o[1],0,0,0), C1,4); \
    GAPB(o[0]=__builtin_amdgcn_mfma_f32_32x32x16_bf16(PAF(3),VFR(3),o[0],0,0,0), C1,8); \
    GAPB(o[1]=__builtin_amdgcn_mfma_f32_32x32x16_bf16(PAF(3),VFR(7),o[1],0,0,0), C1,12); \
    }while(0)
  int t=1;
  #undef CMASK
  #define CMASK(P0,P1,t) do{}while(0)
  for(;t+5<NT;t+=2){
    STEP(pB0,pB1,pA0,pA1,t,true,true,true);     WAIT_BAR(2); RESC(); ROT();
    STEP(pA0,pA1,pB0,pB1,t+1,true,true,true);   WAIT_BAR(2); RESC(); ROT();
  }
  #undef CMASK
  #define CMASK(P0,P1,t) do{int jb_=(t)-(NT-4); if(jb_>=0)cmask(P0,P1,jb_,qrel,hi);}while(0)
  #define ENDW(tt) do{ if((tt)+3<NT){WAIT_BAR(2);} else if((tt)+2<NT){WAIT_BAR(1);} else {WAIT_BAR(0);} }while(0)
  for(;t+1<NT;t+=2){
    STEP(pB0,pB1,pA0,pA1,t,(t+3<NT),(t+1<NT),(t+1<NT));       ENDW(t);   RESC(); ROT();
    STEP(pA0,pA1,pB0,pB1,t+1,(t+4<NT),(t+2<NT),(t+2<NT));     ENDW(t+1); RESC(); ROT();
  }
  STEP(pB0,pB1,pA0,pA1,NT-1,false,false,false); RESC();
  { float sacc=pB0[0]+pB0[1]; _Pragma("unroll") for(int r=2;r<16;++r)sacc+=pB0[r]; _Pragma("unroll") for(int r=0;r<16;++r)sacc+=pB1[r]; l_reg+=sacc;
    pw0=(u32x4){PKW(pB0,0),PKW(pB0,2),PKW(pB0,4),PKW(pB0,6)};pw1=(u32x4){PKW(pB0,8),PKW(pB0,10),PKW(pB0,12),PKW(pB0,14)};pw2=(u32x4){PKW(pB1,0),PKW(pB1,2),PKW(pB1,4),PKW(pB1,6)};pw3=(u32x4){PKW(pB1,8),PKW(pB1,10),PKW(pB1,12),PKW(pB1,14)};
    SBAR(); pv(o,vb0+sl_cur,PAF(0),PAF(1),PAF(2),PAF(3)); }
  #undef PKW
  #undef PAF
  #undef VFR
  #undef PIN
  #undef MX3
  #undef GAPA
  #undef GAPB
  #undef EX
  #undef VRD
  #undef KRD
  #undef STEP
  #undef ENDW
  {auto rr=__builtin_amdgcn_permlane32_swap(__float_as_uint(l_reg),__float_as_uint(l_reg),false,false);l_reg=__uint_as_float(rr[0])+__uint_as_float(rr[1]);}
  if(hi==0)wsf[32+r32]=l_reg;asm volatile("s_waitcnt lgkmcnt(0)":::"memory");
  float rli[16];
  #pragma unroll
  for(int r=0;r<16;++r)rli[r]=__builtin_amdgcn_rcpf(wsf[32+crow(r,hi)]);
  bf16*Ow=O+(rowbase+q0+wid*QBLK)*PQ;
  { bf16*stg=(bf16*)(shm+LDS_OST)+wid*2048;
    #pragma unroll
    for(int r=0;r<16;++r){const int orow=crow(r,hi);
      #pragma unroll
      for(int d0=0;d0<2;++d0)stg[orow*64+d0*32+r32]=__float2bfloat16(o[d0][r]*rli[r]);}
    asm volatile("s_waitcnt lgkmcnt(0)":::"memory");
    #pragma unroll
    for(int i=0;i<4;++i){const int row=i*8+(lane>>3),ch=lane&7; const u32x4 v=*(const u32x4*)(stg+row*64+ch*8); ATTN_STORE16(Ow+(long)row*PQ+ch*8,v);} }
  asm volatile("s_waitcnt lgkmcnt(0)\n\ts_barrier":::"memory");
  #undef FBIAS
  #undef CINIT
  #undef DMA_K
  #undef DMA_V
  #undef CMASK
  #undef START
  #undef RESC
  #undef ROT
}
constexpr int XK=0, XV=16384, XWS=49152, XOST=51200, DV128_LDS_BYTES=XOST+NW*4096;
template<int THRL> __device__ __forceinline__ void attn_unit_dv128(int b,int qb,const bf16*Q,const bf16*__restrict__ K,const bf16*__restrict__ V,bf16*O,const float*nq,const float*nk,char*shm){
  int tid_=threadIdx.x; asm volatile("":"+v"(tid_)); const int tid=tid_,lane=tid&63,r32=lane&31,hi=lane>>5; const int wid=__builtin_amdgcn_readfirstlane(tid>>6);
  const long rowbase=(long)b*SEQ; const int q0=qb*QB;
  const bf16*Qw=Q+(rowbase+q0+wid*QBLK)*PQ;
  const bf16*Kh=K+rowbase*PQ,*Vh=V+rowbase*PQ;
  const unsigned lds0=(unsigned)(uintptr_t)shm;
  typedef __attribute__((address_space(3))) float* lds_fptr;
  const lds_fptr wsf=(lds_fptr)((__attribute__((address_space(3))) char*)shm+XWS)+wid*64;
  const bf16*ksrc=Kh+(long)lane*PQ+wid*8;
  const bf16*vsrc=Vh+(long)(16*(wid&3)+(lane>>2))*PQ+(wid>>2)*32+(lane&3)*8;
  const unsigned kdst=lds0+XK+wid*1024, vdst=lds0+XV+wid*1024;
  #define DMA_K(t,slot) glds16(ksrc+(long)(t)*KVBLK*PQ,(unsigned)__builtin_amdgcn_readfirstlane(kdst+(slot)*8192))
  #define DMA_V(t,slot) do{ glds16(vsrc+(long)(t)*KVBLK*PQ,(unsigned)__builtin_amdgcn_readfirstlane(vdst+(slot)*16384)); glds16(vsrc+64+(long)(t)*KVBLK*PQ,(unsigned)__builtin_amdgcn_readfirstlane(vdst+(slot)*16384+8192)); }while(0)
  const int vb0=(int)(lds0+XV)+((lane>>4)&1)*32+(lane&3)*8+(4*hi+((lane&15)>>2))*64;
  const int NT=(q0+QB)/KVBLK;
  const lds_cptr kp0=(lds_cptr)shm+XK+hi*1024+r32*16;
  const lds_cptr vp0=(lds_cptr)shm+XV+((lane>>4)&1)*32+(lane&3)*8+(4*hi+((lane&15)>>2))*64;
  DMA_K(0,0);
  bf16x8 qr[4];
  #pragma unroll
  for(int d0=0;d0<4;++d0)qr[d0]=*reinterpret_cast<const bf16x8*>(&Qw[(long)r32*PQ+d0*16+hi*8]);
  float mhat=0.f,l_reg=0.f; f32x16 o[4]; o[0]=f32x16{};o[1]=f32x16{};o[2]=f32x16{};o[3]=f32x16{}; f32x16 negm=f32x16{};
  const int qrel=wid*QBLK+r32;
  u32x4 pw0=u32x4{},pw1=u32x4{},pw2=u32x4{},pw3=u32x4{};
  #define MX3(a,b,c) __builtin_fmaxf(__builtin_fmaxf((a),(b)),(c))
  #define PKW(P,B) cvtpk_s(P[B],P[B+1])
  #define SBAR_() __builtin_amdgcn_sched_barrier(0)
  #define VLOAD(VP) do{ _Pragma("unroll") for(int i_=0;i_<8;++i_){ vlo[i_]=vtr((VP)+(i_>>2)*4096+(i_&3)*1024); vhi[i_]=vtr((VP)+(i_>>2)*4096+(i_&3)*1024+512); } }while(0)
  #define VFR_(i) (bf16x8){vlo[i][0],vlo[i][1],vlo[i][2],vlo[i][3],vhi[i][0],vhi[i][1],vhi[i][2],vhi[i][3]}
  #define PAF_(k) __builtin_bit_cast(bf16x8,pw##k)
  #define VMMA(OA,OB) do{ \
      OA=__builtin_amdgcn_mfma_f32_32x32x16_bf16(PAF_(0),VFR_(0),OA,0,0,0); OB=__builtin_amdgcn_mfma_f32_32x32x16_bf16(PAF_(0),VFR_(4),OB,0,0,0); \
      OA=__builtin_amdgcn_mfma_f32_32x32x16_bf16(PAF_(1),VFR_(1),OA,0,0,0); OB=__builtin_amdgcn_mfma_f32_32x32x16_bf16(PAF_(1),VFR_(5),OB,0,0,0); \
      OA=__builtin_amdgcn_mfma_f32_32x32x16_bf16(PAF_(2),VFR_(2),OA,0,0,0); OB=__builtin_amdgcn_mfma_f32_32x32x16_bf16(PAF_(2),VFR_(6),OB,0,0,0); \
      OA=__builtin_amdgcn_mfma_f32_32x32x16_bf16(PAF_(3),VFR_(3),OA,0,0,0); OB=__builtin_amdgcn_mfma_f32_32x32x16_bf16(PAF_(3),VFR_(7),OB,0,0,0); }while(0)
  #define DV_TILE(T,HASPV,MASKMODE,NOMAX) do{ const int t_=(T); \
    asm volatile("s_waitcnt vmcnt(0) lgkmcnt(0)\n\ts_barrier":::"memory");     \
    if(t_+1<NT){ DMA_K(t_+1,(t_+1)&1); } DMA_V(t_,t_&1); \
    f32x16 p0,p1; float f=1.f; bool resc=false; \
    { bf16x8 kf[8]; kload8(kf,kp0+(t_&1)*8192); SBAR_();                         \
      p0=__builtin_amdgcn_mfma_f32_32x32x16_bf16(kf[0],qr[0],negm,0,0,0); p1=__builtin_amdgcn_mfma_f32_32x32x16_bf16(kf[1],qr[0],negm,0,0,0); \
      p0=__builtin_amdgcn_mfma_f32_32x32x16_bf16(kf[2],qr[1],p0,0,0,0); p1=__builtin_amdgcn_mfma_f32_32x32x16_bf16(kf[3],qr[1],p1,0,0,0); \
      p0=__builtin_amdgcn_mfma_f32_32x32x16_bf16(kf[4],qr[2],p0,0,0,0); p1=__builtin_amdgcn_mfma_f32_32x32x16_bf16(kf[5],qr[2],p1,0,0,0); \
      p0=__builtin_amdgcn_mfma_f32_32x32x16_bf16(kf[6],qr[3],p0,0,0,0); p1=__builtin_amdgcn_mfma_f32_32x32x16_bf16(kf[7],qr[3],p1,0,0,0); } \
    if(MASKMODE==1){ cmask(p0,p1,t_-(NT-4),qrel,hi); } else if(MASKMODE==2){ const int jb=t_-(NT-4); if(jb>=0)cmask(p0,p1,jb,qrel,hi); } \
    if(!(NOMAX)){ \
    float rm; \
    { float a=MX3(p0[0],p0[1],p1[0]),bq=MX3(p0[2],p0[3],p1[1]); a=MX3(a,p1[2],p1[3]); \
      _Pragma("unroll") for(int r=4;r<16;r+=4){a=MX3(a,p0[r],p0[r+1]);bq=MX3(bq,p0[r+2],p0[r+3]);a=MX3(a,p1[r],p1[r+1]);bq=MX3(bq,p1[r+2],p1[r+3]);} \
      rm=__builtin_fmaxf(a,bq); float x0=rm,x1=rm; asm volatile("s_nop 1\n\tv_permlane32_swap_b32 %0, %1":"+v"(x0),"+v"(x1)); rm=__builtin_fmaxf(x0,x1); }     \
      \
    if(HASPV){ resc=__any(rm>(float)THRL); } \
    if(!(HASPV)||resc){ const float dl=(HASPV)?__builtin_fmaxf(rm,0.f):rm; mhat+=dl; f=__builtin_amdgcn_exp2f(-dl);     \
      _Pragma("unroll") for(int r=0;r<16;++r){p0[r]-=dl;p1[r]-=dl;negm[r]=-mhat;} } \
    } \
    { const lds_cptr vp=vp0+((t_-1)&1)*16384; float sacc=0.f;                    \
      s16x4 vlo[8],vhi[8]; \
      if(HASPV){ SBAR_(); VLOAD(vp); SBAR_(); } \
      _Pragma("unroll") for(int r=0;r<16;++r){ p0[r]=__builtin_amdgcn_exp2f(p0[r]); sacc+=p0[r]; } asm volatile("":"+v"(p0),"+v"(sacc));     \
      if(HASPV){ SBAR_(); VMMA(o[0],o[1]); SBAR_(); VLOAD(vp+8192); SBAR_(); } \
      _Pragma("unroll") for(int r=0;r<16;++r){ p1[r]=__builtin_amdgcn_exp2f(p1[r]); sacc+=p1[r]; } asm volatile("":"+v"(p1),"+v"(sacc)); \
      if(HASPV){ SBAR_(); VMMA(o[2],o[3]); SBAR_(); } \
      pw0=(u32x4){PKW(p0,0),PKW(p0,2),PKW(p0,4),PKW(p0,6)}; pw1=(u32x4){PKW(p0,8),PKW(p0,10),PKW(p0,12),PKW(p0,14)}; \
      pw2=(u32x4){PKW(p1,0),PKW(p1,2),PKW(p1,4),PKW(p1,6)}; pw3=(u32x4){PKW(p1,8),PKW(p1,10),PKW(p1,12),PKW(p1,14)}; \
      if(resc){ l_reg*=f; if(hi==0)wsf[r32]=f;                                   \
        asm volatile("s_waitcnt lgkmcnt(0)":::"memory"); \
        _Pragma("unroll") for(int r=0;r<16;++r){ const float fr_=wsf[crow(r,hi)]; o[0][r]*=fr_; o[1][r]*=fr_; o[2][r]*=fr_; o[3][r]*=fr_; } \
        asm volatile("s_waitcnt lgkmcnt(0)":::"memory"); } \
      l_reg+=sacc; } \
  }while(0)
  const float bqk_=1.05f*sqrtf((nq[0]+nq[1])*(nk[0]+nk[1]));
  if(bqk_<40.0f){
    DV_TILE(0,false,2,true);
    { int t=1;
      #pragma unroll 1
      for(;t<NT-4;++t){ DV_TILE(t,true,0,true); }
      #pragma unroll 1
      for(;t<NT;++t){ DV_TILE(t,true,1,true); } }
  } else {
    DV_TILE(0,false,2,false);
    { int t=1;
      #pragma unroll 1
      for(;t<NT-4;++t){ DV_TILE(t,true,0,false); }
      #pragma unroll 1
      for(;t<NT;++t){ DV_TILE(t,true,1,false); } }
  }
  asm volatile("s_waitcnt vmcnt(0) lgkmcnt(0)\n\ts_barrier":::"memory");
  { const lds_cptr vp=vp0+((NT-1)&1)*16384; s16x4 vlo[8],vhi[8]; VLOAD(vp); SBAR_(); VMMA(o[0],o[1]); SBAR_(); VLOAD(vp+8192); SBAR_(); VMMA(o[2],o[3]); }
  #undef DV_TILE
  #undef VLOAD
  #undef VFR_
  #undef PAF_
  #undef VMMA
  #undef SBAR_
  #undef MX3
  #undef PKW
  {float x0=l_reg,x1=l_reg; asm volatile("s_nop 1\n\tv_permlane32_swap_b32 %0, %1":"+v"(x0),"+v"(x1)); l_reg=x0+x1;}
  if(hi==0)wsf[32+r32]=l_reg; asm volatile("s_waitcnt lgkmcnt(0)":::"memory");
  float rli[16];
  #pragma unroll
  for(int r=0;r<16;++r)rli[r]=__builtin_amdgcn_rcpf(wsf[32+crow(r,hi)]);
  bf16*Ow=O+(rowbase+q0+wid*QBLK)*PQ;
  bf16*stg=(bf16*)(shm+XOST)+wid*2048;
  #pragma unroll
  for(int hf=0;hf<2;++hf){
    #pragma unroll
    for(int r=0;r<16;++r){const int orow=crow(r,hi);
      #pragma unroll
      for(int d0=0;d0<2;++d0)stg[orow*64+d0*32+r32]=__float2bfloat16(o[2*hf+d0][r]*rli[r]);}
    asm volatile("s_waitcnt lgkmcnt(0)":::"memory");
    #pragma unroll
    for(int i=0;i<4;++i){const int row=i*8+(lane>>3),ch=lane&7; const u32x4 v=*(const u32x4*)(stg+row*64+ch*8); *(u32x4*)(Ow+(long)row*PQ+hf*64+ch*8)=v;}
    asm volatile("s_waitcnt lgkmcnt(0)":::"memory"); }
  asm volatile("s_waitcnt lgkmcnt(0)\n\ts_barrier":::"memory");
  #undef DMA_K
  #undef DMA_V
}
constexpr int ATTN_LDS_BYTES=LDS_BYTES;
#undef SBAR
#undef WAIT_BAR
}
#include <hip/hip_cooperative_groups.h>
namespace cg = cooperative_groups;
#ifndef MK_LAUNCH_PER_PHASE
#define MK_LAUNCH_PER_PHASE 0
#endif
constexpr int NWAVES = 8;
constexpr int SEQ = 16384, DMODEL = 1024, M = 2 * SEQ, DFF = 2816, INC = 3080, NQKV = 3072, PQ = 3584, NPHASE = 16;
constexpr size_t MiB = 1u << 20;
constexpr size_t WS_CTL = 0  , CTL_ZERO_BYTES = 65536;
constexpr int MISC_OFF = 153600;
constexpr size_t WS_COS = 2 * MiB, WS_SIN = 4 * MiB, WS_LC = 7 * MiB, WS_CT = 8 * MiB, WS_SS = 10 * MiB  , WS_W = 24 * MiB  , WS_XB = 108 * MiB  ,
                 WS_BIG = 172 * MiB, WS_H = WS_BIG  , WS_QKV = WS_BIG  , WS_END = 396 * MiB;
constexpr size_t WL_GU1 = 0, WL_D1 = 11 * MiB, WL_WIN = 11 * MiB + 5632 * 1024, WL_WOUT = WL_WIN + 6 * MiB, WL_GU2 = WL_WOUT + 2 * MiB, WL_D2 = WL_GU2 + 11 * MiB, WL_LAYER = 41 * MiB;
static_assert(WL_D2 + 5632 * 1024 == WL_LAYER, "weight map");
constexpr int LDS_BYTES = 155648;
#define LAS __attribute__((address_space(3)))
typedef unsigned short bf16;
typedef unsigned v4u __attribute__((ext_vector_type(4)));
typedef float f32x4 __attribute__((ext_vector_type(4)));
#define LDS_WAIT() asm volatile("s_waitcnt lgkmcnt(0)" ::: "memory")
__device__ __forceinline__ float wave_sum(float v) { return wave_sum_u(v); }
__device__ __forceinline__ int std8(int o) { return 16 * ((o >> 2) & 1) + 4 * (o >> 3) + (o & 3); }
__device__ __forceinline__ int rowmap(int mode, int nn) {
    if (mode == 0) return (nn & ~31) + std8(nn & 31);
    if (mode == 1) { const int bj = nn >= DFF ? 1 : 0, i = nn - DFF * bj, ip = i & 127; return 256 * (i >> 7) + 128 * bj + (ip & ~31) + std8(ip & 31); }
    const int d = nn & 63; return (nn & ~63) + 32 * ((d >> 4) & 1) + 16 * (d >> 5) + 4 * ((d >> 2) & 3) + (d & 3);
}
__device__ __forceinline__ void conv_item(const float* W, int ldw, int coff, int K, int nblk, const float* gain, bf16* WT, int mode, int base, LAS float* scr, int item, int lane) {
    const int kb = item / nblk, nb = item % nblk, k0 = 64 * kb, n0 = 32 * nb;
    { float wv[32]; const float* wp = W + (size_t)(k0 + (lane >> 5)) * ldw + coff + n0 + (lane & 31);
#pragma unroll
      for (int i = 0; i < 32; ++i) wv[i] = wp[(size_t)(2 * i) * ldw];
      if (gain) {
#pragma unroll
          for (int i = 0; i < 32; ++i) wv[i] *= gain[k0 + 2 * i + (lane >> 5)]; }
#pragma unroll
      for (int i = 0; i < 32; ++i) scr[(2 * i + (lane >> 5)) * 33 + (lane & 31)] = wv[i]; }
    LDS_WAIT(); asm volatile("" ::: "memory");
    const int c = lane & 7;
#pragma unroll
    for (int j = 0; j < 4; ++j) { const int n = (lane >> 3) + 8 * j; const LAS float* s = scr + (8 * c) * 33 + n;
        v4u o; o.x = pg8::cvt_pk_bf16(s[0 * 33], s[1 * 33]); o.y = pg8::cvt_pk_bf16(s[2 * 33], s[3 * 33]); o.z = pg8::cvt_pk_bf16(s[4 * 33], s[5 * 33]); o.w = pg8::cvt_pk_bf16(s[6 * 33], s[7 * 33]);
        *(v4u*)(WT + (size_t)(base + rowmap(mode, n0 + n)) * K + k0 + 8 * c) = o; }
    LDS_WAIT(); asm volatile("" ::: "memory");
}
#define XB_TMO      128
#define XB_XCNT(j)  (256  + 64 * (j))
#define XB_XSUB(j)  (1280 + 64 * (j))
#define XB_XGEN(j)  (2304 + 64 * (j))
#define XB_TOP      3328
#define XB_TOPGEN   3392
#define XCD_BAR_WORDS 3456
#define XB_SPIN_CAP (1u << 18)

__device__ __forceinline__ unsigned xb_ld(unsigned* p)              { return __hip_atomic_load(p, __ATOMIC_RELAXED, __HIP_MEMORY_SCOPE_AGENT); }
__device__ __forceinline__ unsigned xb_add(unsigned* p, unsigned v) { return __hip_atomic_fetch_add(p, v, __ATOMIC_RELAXED, __HIP_MEMORY_SCOPE_AGENT); }
__device__ __forceinline__ unsigned xb_xcc_id() { return (unsigned)__builtin_amdgcn_s_getreg((3 << 11) | 20) & 0xFu; }
#define XB_SPIN(cond, bar) do { unsigned _sp = 0; while (cond) { __builtin_amdgcn_s_sleep(1); \
    if ((++_sp & 255u) == 0u) { if (xb_ld(&(bar)[XB_TMO])) break; if (_sp > XB_SPIN_CAP) { atomicAdd(&(bar)[XB_TMO], 1u); break; } } } } while (0)

struct XcdBarrier {
    unsigned* bar; unsigned x;
    volatile LAS unsigned* st;
};

__device__ __forceinline__ XcdBarrier xcd_barrier_post(unsigned* bar, volatile LAS unsigned* st) {
    XcdBarrier b; b.bar = bar; b.x = xb_xcc_id(); b.st = st;
    if (threadIdx.x == 0) (void)xb_add(&bar[XB_XCNT(b.x)], 1u);
    return b;
}
__device__ __forceinline__ void xcd_barrier_complete(unsigned* bar, unsigned x, unsigned& nloc, unsigned& nx) {
    const unsigned G = gridDim.x * gridDim.y * gridDim.z;
    unsigned sum, cnt, mine, sp = 0u;
    for (;;) {
        sum = 0u; cnt = 0u; mine = 0u;
#pragma unroll
        for (unsigned j = 0; j < 16; ++j) { const unsigned c = xb_ld(&bar[XB_XCNT(j)]); sum += c; cnt += (c > 0u) ? 1u : 0u; mine = (j == x) ? c : mine; }
        if (sum == G) break;
        __builtin_amdgcn_s_sleep(1);
        if ((++sp & 255u) == 0u) { if (xb_ld(&bar[XB_TMO])) break; if (sp > XB_SPIN_CAP) { atomicAdd(&bar[XB_TMO], 1u); break; } }
    }
    nloc = mine > 0u ? mine : 1u; nx = cnt > 0u ? cnt : 1u;
}

__device__ __forceinline__ void xcd_barrier(const XcdBarrier& b) {
    asm volatile("s_waitcnt vmcnt(0)" ::: "memory");
    __syncthreads();
    if (threadIdx.x == 0) {
        unsigned* bar = b.bar;
        __builtin_amdgcn_s_waitcnt(0);
        unsigned nloc = b.st[0], nx = b.st[1];
        if (nloc == 0u) { xcd_barrier_complete(bar, b.x, nloc, nx); b.st[0] = nloc; b.st[1] = nx; }
        const unsigned old = xb_add(&bar[XB_XSUB(b.x)], 1u);
        const unsigned gen = old / nloc;
        if (old + 1u == (gen + 1u) * nloc) {
            __builtin_amdgcn_fence(__ATOMIC_RELEASE, "agent");
            asm volatile("s_waitcnt vmcnt(0)" ::: "memory");
            const unsigned og = xb_add(&bar[XB_TOP], 1u);
            const unsigned tg = og / nx;
            if (og + 1u == (tg + 1u) * nx) xb_add(&bar[XB_TOPGEN], 1u);
            else XB_SPIN(xb_ld(&bar[XB_TOPGEN]) == tg, bar);
            __builtin_amdgcn_fence(__ATOMIC_ACQUIRE, "agent");
            xb_add(&bar[XB_XGEN(b.x)], 1u);
            asm volatile("s_waitcnt vmcnt(0)" ::: "memory");
        } else {
            XB_SPIN(xb_ld(&bar[XB_XGEN(b.x)]) == gen, bar);
            __builtin_amdgcn_fence(__ATOMIC_ACQUIRE, "agent");
            asm volatile("s_waitcnt vmcnt(0)" ::: "memory");
        }
    }
    __syncthreads();
}

struct Args { const float* in[17]; float* out; unsigned char* ws; int ph_lo, ph_hi; };
#define GAS1 __attribute__((address_space(1)))
#define KAS4 __attribute__((address_space(4)))
__device__ __forceinline__ const float* karg_in(int i) { size_t off = 8u * (unsigned)i; asm volatile("" : "+s"(off)); return (const float*)*(const GAS1 float* const KAS4*)((const char KAS4*)__builtin_amdgcn_kernarg_segment_ptr() + off); }
__device__ __forceinline__ float* karg_out() { size_t off = 8u * 17u; asm volatile("" : "+s"(off)); return (float*)*(GAS1 float* const KAS4*)((const char KAS4*)__builtin_amdgcn_kernarg_segment_ptr() + off); }
__device__ __forceinline__ unsigned char* karg_ws() { size_t off = 8u * 18u; asm volatile("" : "+s"(off)); return (unsigned char*)*(GAS1 unsigned char* const KAS4*)((const char KAS4*)__builtin_amdgcn_kernarg_segment_ptr() + off); }
static_assert(offsetof(Args, out) == 8 * 17 && offsetof(Args, ws) == 8 * 18, "kernarg layout");
enum { I_X = 0, I_N1 = 1, I_GU1 = 2, I_D1 = 3, I_NM = 4, I_WIN = 5, I_FB = 6, I_LQ1 = 7, I_LK1 = 8, I_LQ2 = 9, I_LK2 = 10, I_SUB = 11, I_WOUT = 12, I_N2 = 13, I_GU2 = 14, I_D2 = 15, I_NF = 16 };

__device__ __forceinline__ void prologue(LAS unsigned char* lds, int vcu, int G, int tid, int lane, int wave) {
    unsigned char* ws = karg_ws();
    LAS float* scr = (LAS float*)(lds + wave * 16384);
    const int gw = vcu * NWAVES + wave, NGW = G * NWAVES;
    constexpr int J0 = 2816, J1 = 1408, J2 = 768, J3 = 256, J6 = 512, PER_LAYER = 2 * J0 + 2 * J1 + J2 + 3 * J3 + J6;
    for (int it = gw; it < 2 * PER_LAYER; it += NGW) {
        const int l = it / PER_LAYER; int r = it - l * PER_LAYER;
        bf16* wl = (bf16*)(ws + WS_W + (size_t)l * WL_LAYER);
        const float* gu1 = karg_in(I_GU1) + (size_t)l * DMODEL * 2 * DFF; const float* gu2 = karg_in(I_GU2) + (size_t)l * DMODEL * 2 * DFF;
        const float* d1 = karg_in(I_D1) + (size_t)l * DFF * DMODEL; const float* d2 = karg_in(I_D2) + (size_t)l * DFF * DMODEL;
        const float* win = karg_in(I_WIN) + (size_t)l * DMODEL * INC; const float* wout = karg_in(I_WOUT) + (size_t)l * DMODEL * DMODEL;
        const float* n1 = karg_in(I_N1) + l * DMODEL; const float* nm = karg_in(I_NM) + l * DMODEL; const float* n2 = karg_in(I_N2) + l * DMODEL;
        bf16* wwin = (bf16*)((unsigned char*)wl + WL_WIN);
        if (r < J0) { conv_item(gu1, 2 * DFF, 0, DMODEL, 2 * DFF / 32, n1, (bf16*)((unsigned char*)wl + WL_GU1), 1, 0, scr, r, lane); continue; } r -= J0;
        if (r < J1) { conv_item(d1, DMODEL, 0, DFF, DMODEL / 32, nullptr, (bf16*)((unsigned char*)wl + WL_D1), 0, 0, scr, r, lane); continue; } r -= J1;
        if (r < J2) { conv_item(win, INC, 0, DMODEL, 1536 / 32, nm, wwin, 0, 0, scr, r, lane); continue; } r -= J2;
        if (r < J3) { conv_item(win, INC, 1544, DMODEL, 512 / 32, nm, wwin, 2, 1536, scr, r, lane); continue; } r -= J3;
        if (r < J3) { conv_item(win, INC, 2056, DMODEL, 512 / 32, nm, wwin, 2, 2048, scr, r, lane); continue; } r -= J3;
        if (r < J3) { conv_item(win, INC, 2568, DMODEL, 512 / 32, nm, wwin, 0, 2560, scr, r, lane); continue; } r -= J3;
        if (r < J6) { conv_item(wout, DMODEL, 0, DMODEL, DMODEL / 32, nullptr, (bf16*)((unsigned char*)wl + WL_WOUT), 0, 0, scr, r, lane); continue; } r -= J6;
        if (r < J0) { conv_item(gu2, 2 * DFF, 0, DMODEL, 2 * DFF / 32, n2, (bf16*)((unsigned char*)wl + WL_GU2), 1, 0, scr, r, lane); continue; } r -= J0;
        conv_item(d2, DMODEL, 0, DFF, DMODEL / 32, nullptr, (bf16*)((unsigned char*)wl + WL_D2), 0, 0, scr, r, lane);
    }
    const float* x = karg_in(I_X); bf16* XB = (bf16*)(ws + WS_XB); float* ss0 = (float*)(ws + WS_SS);
    for (int m0 = 2 * gw; m0 < M; m0 += 2 * NGW) {
        f32x4 v[2][4];
#pragma unroll
        for (int r = 0; r < 2; ++r)
#pragma unroll
            for (int j = 0; j < 4; ++j) v[r][j] = ((const f32x4*)(x + (size_t)(m0 + r) * DMODEL) + lane)[64 * j];
#pragma unroll
        for (int r = 0; r < 2; ++r) { const int m = m0 + r; float s = 0.f;
#pragma unroll
            for (int j = 0; j < 4; ++j) s += (v[r][j][0] * v[r][j][0] + v[r][j][1] * v[r][j][1]) + (v[r][j][2] * v[r][j][2] + v[r][j][3] * v[r][j][3]);
            s = wave_sum(s);
            unsigned long long* o8 = (unsigned long long*)(XB + (size_t)m * DMODEL) + lane;
#pragma unroll
            for (int j = 0; j < 4; ++j) o8[64 * j] = (unsigned long long)pg8::cvt_pk_bf16(v[r][j][0], v[r][j][1]) | ((unsigned long long)pg8::cvt_pk_bf16(v[r][j][2], v[r][j][3]) << 32);
            if (lane < 16) ss0[(size_t)m * 16 + lane] = lane == 0 ? s : 0.f; }
    }
    float* cosT = (float*)(ws + WS_COS); float* sinT = (float*)(ws + WS_SIN);
    for (int i = vcu * NWAVES * 64 + tid; i < SEQ * 32; i += G * NWAVES * 64) {
        const int pos = i >> 5, d = i & 31; const float inv = 1.0f / powf(10000.0f, (float)d * (1.0f / 32.0f)); const float ang = (float)pos * inv;
        cosT[i] = cosf(ang); sinT[i] = sinf(ang);
    }
}
__device__ __forceinline__ void ff_chunk(int chunk, const bf16* XB, const float* ss, const float* win_l, const float* gain, const float* fbias, float* LC, float* CT, LAS float* sl, int tid, int lane, int wave) {
#pragma unroll 1
    for (int hp = 0; hp < 2; ++hp) {
        float w[16][4];
#pragma unroll
        for (int i = 0; i < 16; ++i) { const int k = (i < 8) ? 8 * lane + i : 512 + 8 * lane + (i - 8); const float g = gain[k];
            const f32x4 a = *(const f32x4*)(win_l + (size_t)k * INC + 1536 + 4 * hp);
            w[i][0] = a[0] * g; w[i][1] = a[1] * g; w[i][2] = a[2] * g; w[i][3] = a[3] * g; }
        const float fb = fbias[4 * hp + (lane & 3)];
#pragma unroll 1
        for (int rr0 = 0; rr0 < 16; rr0 += 4) {
          v4u xav[4], xbv[4]; float ssv[4];
#pragma unroll
          for (int r4 = 0; r4 < 4; ++r4) { const size_t row_ = (size_t)(chunk * 128 + wave * 16 + rr0 + r4);
              xav[r4] = *(const v4u*)(XB + row_ * DMODEL + 8 * lane); xbv[r4] = *(const v4u*)(XB + row_ * DMODEL + 512 + 8 * lane); ssv[r4] = ss[row_ * 16 + (lane & 15)]; }
#pragma unroll
          for (int r4 = 0; r4 < 4; ++r4) {
            const int rr = rr0 + r4;
            const v4u xa = xav[r4], xb = xbv[r4];
            float xs[16];
            xs[0] = __uint_as_float(xa.x << 16); xs[1] = __uint_as_float(xa.x & 0xffff0000u); xs[2] = __uint_as_float(xa.y << 16); xs[3] = __uint_as_float(xa.y & 0xffff0000u);
            xs[4] = __uint_as_float(xa.z << 16); xs[5] = __uint_as_float(xa.z & 0xffff0000u); xs[6] = __uint_as_float(xa.w << 16); xs[7] = __uint_as_float(xa.w & 0xffff0000u);
            xs[8] = __uint_as_float(xb.x << 16); xs[9] = __uint_as_float(xb.x & 0xffff0000u); xs[10] = __uint_as_float(xb.y << 16); xs[11] = __uint_as_float(xb.y & 0xffff0000u);
            xs[12] = __uint_as_float(xb.z << 16); xs[13] = __uint_as_float(xb.z & 0xffff0000u); xs[14] = __uint_as_float(xb.w << 16); xs[15] = __uint_as_float(xb.w & 0xffff0000u);
            float a[4];
#pragma unroll
            for (int h = 0; h < 4; ++h) { float s = 0.f;
#pragma unroll
                for (int i = 0; i < 16; ++i) s += xs[i] * w[i][h];
                a[h] = wave_sum(s); }
            const float q = wave_sum(ssv[r4]) * 0.25f;
            const float rstd = __builtin_amdgcn_rsqf(q * (1.0f / 1024.0f) + 1e-5f);
            const int hh = lane & 3;
            float mine = a[0]; mine = hh == 1 ? a[1] : mine; mine = hh == 2 ? a[2] : mine; mine = hh == 3 ? a[3] : mine;
            const float z = mine * rstd + fb;
            const float lf = fminf(z, 0.f) - log1pf(expf(-fabsf(z)));
            if (lane < 4) sl[(wave * 16 + rr) * 8 + 4 * hp + lane] = lf;
          }
        }
    }
    __syncthreads();
    if (tid < 8) { float c = 0.f; for (int r = 0; r < 128; ++r) { c += sl[r * 8 + tid]; sl[r * 8 + tid] = c; } }
    __syncthreads();
    for (int i = tid; i < 1024; i += NWAVES * 64) { const int h = i >> 7, r = i & 127, row = chunk * 128 + r, b = row >> 14, s = row & 16383; const float v = sl[r * 8 + h];
        LC[((size_t)(b * 8 + h) << 14) + s] = v; if (r == 127) CT[(b * 8 + h) * 128 + (s >> 7)] = v; }
    __syncthreads();
}
__device__ __forceinline__ void diff_combine(int b, int qb, int h, bf16* QKV, float lam, int layer, const float* subln) {
    int tid = threadIdx.x; asm volatile("s_waitcnt vmcnt(0)" : "+v"(tid) :: "memory"); const int lane = tid & 63, wave = __builtin_amdgcn_readfirstlane(tid >> 6);
    int lo_ = layer; asm volatile("" : "+s"(lo_)); const float oscale = lo_ == 0 ? 0.8f : 0.64449094f;
    __builtin_amdgcn_fence(__ATOMIC_ACQUIRE, "agent");
    const size_t row0 = (size_t)b * SEQ + (size_t)qb * 256 + wave * 32; const int ch = lane & 15;
    const f32x4 g0 = *(const f32x4*)(subln + ch * 8) * oscale, g1 = *(const f32x4*)(subln + ch * 8 + 4) * oscale;
#pragma unroll 4
    for (int p = 0; p < 8; ++p) { const size_t row = row0 + p * 4 + (lane >> 4);
        const bf16* pa = QKV + row * PQ + 3072 + h * 128 + ch * 8; bf16* pq = QKV + row * PQ + 512 + h * 128 + ch * 8;
        const v4u a = *(const v4u*)pa, q = *(const v4u*)pq;
        f32x4 d0, d1;
        d0[0] = __uint_as_float(a.x << 16) - lam * __uint_as_float(q.x << 16); d0[1] = __uint_as_float(a.x & 0xffff0000u) - lam * __uint_as_float(q.x & 0xffff0000u);
        d0[2] = __uint_as_float(a.y << 16) - lam * __uint_as_float(q.y << 16); d0[3] = __uint_as_float(a.y & 0xffff0000u) - lam * __uint_as_float(q.y & 0xffff0000u);
        d1[0] = __uint_as_float(a.z << 16) - lam * __uint_as_float(q.z << 16); d1[1] = __uint_as_float(a.z & 0xffff0000u) - lam * __uint_as_float(q.z & 0xffff0000u);
        d1[2] = __uint_as_float(a.w << 16) - lam * __uint_as_float(q.w << 16); d1[3] = __uint_as_float(a.w & 0xffff0000u) - lam * __uint_as_float(q.w & 0xffff0000u);
        float s = (d0[0] * d0[0] + d0[1] * d0[1]) + (d0[2] * d0[2] + d0[3] * d0[3]) + (d1[0] * d1[0] + d1[1] * d1[1]) + (d1[2] * d1[2] + d1[3] * d1[3]);
        s = row16_sum(s);
        const float r = __builtin_amdgcn_rsqf(s * (1.0f / 128.0f) + 1e-5f);
        d0 = d0 * r * g0; d1 = d1 * r * g1;
        v4u o; o.x = pg8::cvt_pk_bf16(d0[0], d0[1]); o.y = pg8::cvt_pk_bf16(d0[2], d0[3]); o.z = pg8::cvt_pk_bf16(d1[0], d1[1]); o.w = pg8::cvt_pk_bf16(d1[2], d1[3]);
        *(v4u*)pq = o; }
}

__global__ void __launch_bounds__(NWAVES * 64, 2) mega_fwd(Args args) {
    extern __shared__ __attribute__((aligned(16))) unsigned char lds[];
    LAS unsigned char* ldsl = (LAS unsigned char*)lds;
#define OPQ_TID() int tid = threadIdx.x; asm volatile("" : "+v"(tid)); const int lane = tid & 63, wave = __builtin_amdgcn_readfirstlane(tid >> 6)
#define UNI() int G = gridDim.x, bx = blockIdx.x; asm volatile("" : "+s"(G), "+s"(bx)); const int vcu = (G % 8 == 0) ? (bx % 8) * (G / 8) + bx / 8 : bx; (void)vcu
    cg::grid_group grid = cg::this_grid();
    if (threadIdx.x < 2) ((volatile LAS unsigned*)(ldsl + MISC_OFF))[threadIdx.x] = 0u;
    __syncthreads();
    XcdBarrier xbar = xcd_barrier_post((unsigned*)(karg_ws() + WS_CTL) + 1024, (volatile LAS unsigned*)(ldsl + MISC_OFF));
#define PTRS() UNI(); unsigned char* ws = karg_ws();     bf16* XB = (bf16*)(ws + WS_XB); bf16* HB = (bf16*)(ws + WS_H); bf16* QKV = (bf16*)(ws + WS_QKV); \
    float* LC = (float*)(ws + WS_LC); float* CT = (float*)(ws + WS_CT); float* SS = (float*)(ws + WS_SS); const float* cosT = (const float*)(ws + WS_COS); const float* sinT = (const float*)(ws + WS_SIN); \
    const unsigned char* wl = ws + WS_W + (size_t)l * WL_LAYER; float* ssl = SS + (size_t)(3 * l) * M * 16; \
    (void)XB; (void)HB; (void)QKV; (void)LC; (void)CT; (void)cosT; (void)sinT; (void)wl; (void)ssl
#ifndef PROBE
#define PROBE 0
#endif
#ifndef PHMASK
#define PHMASK 0x1ff
#endif
#define EN(kind) (((PHMASK) >> (kind)) & 1)
#define IN(k) true
#define SEAM(k) do { if (IN(k) && IN((k) + 1)) { if ((k) == 0) grid.sync(); else xcd_barrier(xbar); } } while (0)
    for (int rp = 0; rp < (PROBE == 1 ? 2 : 1); ++rp)
    if (EN(0) && IN(0)) { UNI(); OPQ_TID(); prologue(ldsl, vcu, G, tid, lane, wave); __syncthreads(); if (PROBE == 1) grid.sync(); }
    if (PROBE == 5) for (int rp = 0; rp < 20; ++rp) grid.sync();
    SEAM(0);
#pragma unroll 1
    for (int l = 0; l < 2; ++l) {
        const int p0 = 1 + 7 * l;
        for (int rp = 0; rp < ((PROBE == 2 && l == 0) ? 3 : 1); ++rp)
        if (EN(1) && IN(p0 + 0)) { PTRS();
            if (PROBE == 2 && rp) grid.sync();
            pg8::Gemm g{XB, (const bf16*)(wl + WL_GU1), M, 2 * DFF, DMODEL, DMODEL}; pg8::StaticOrder S; S.init(M, 2 * DFF, G, bx);
            pg8::EpiSwiGLU E{HB, ssl, DFF};
            pg8::rstd_cache_reset();
            pg8::gemm_phase<pg8::EpiSwiGLU, pg8::StaticOrder, true, true>(ldsl, g, S, E);
        }
        SEAM(p0 + 0);
        if (EN(2) && IN(p0 + 1)) { PTRS();
            pg8::Gemm g{HB, (const bf16*)(wl + WL_D1), M, DMODEL, DFF, DFF}; pg8::StaticOrder S; S.init(M, DMODEL, G, bx);
            pg8::EpiResidual E{l == 0 ? karg_in(I_X) : (const float*)nullptr, XB, (float*)nullptr, XB, ssl + (size_t)1 * M * 16, 0.5f};
            pg8::gemm_phase<pg8::EpiResidual, pg8::StaticOrder, true, true>(ldsl, g, S, E);
        }
        SEAM(p0 + 1);
        for (int rp = 0; rp < (((PROBE == 3 || PROBE == 4) && l == 0) ? 2 : 1); ++rp) {
        if ((PROBE == 3 || PROBE == 4) && rp) grid.sync();
        if (EN(3) && IN(p0 + 2)) { PTRS();
            const float* ssi = ssl + (size_t)1 * M * 16;
            { OPQ_TID();
            for (int chunk = vcu; chunk < M / 128; chunk += G)
                ff_chunk(chunk, XB, ssi, karg_in(I_WIN) + (size_t)l * DMODEL * INC, karg_in(I_NM) + l * DMODEL, karg_in(I_FB) + l * 8, LC, CT, (LAS float*)ldsl, tid, lane, wave); }
            pg8::Gemm g{XB, (const bf16*)(wl + WL_WIN), M, NQKV, DMODEL, DMODEL}; pg8::StaticOrder S; S.init(M, NQKV, G, bx);
            pg8::EpiQKV E{QKV, ssi, cosT, sinT, attn_body::C2, (unsigned*)(ws + WS_CTL + 32768) + l * 128};
            pg8::rstd_cache_reset();
            pg8::gemm_phase<pg8::EpiQKV, pg8::StaticOrder, true, true>(ldsl, g, S, E);
        }
        SEAM(p0 + 2);
        if (EN(4) && IN(p0 + 3)) { PTRS();
            const float lam_init = (l == 0) ? 0.2f : 0.35550906f;
            float lam;
            { OPQ_TID(); (void)wave;
              const float p1 = wave_sum(karg_in(I_LQ1)[l * 64 + lane] * karg_in(I_LK1)[l * 64 + lane]), p2 = wave_sum(karg_in(I_LQ2)[l * 64 + lane] * karg_in(I_LK2)[l * 64 + lane]);
              lam = __int_as_float(__builtin_amdgcn_readfirstlane(__float_as_int(expf(p1) - expf(p2) + lam_init))); }
            const attn_body::bf16* Qb = (const attn_body::bf16*)QKV; attn_body::bf16* Qw = (attn_body::bf16*)QKV;
            for (int v = vcu; v < 256; v += G) {
                { const int bh = v >> 5, b = bh >> 2, h = bh & 3, sp = v & 31;
#pragma unroll 1
                  for (int j = 0; j < 4; ++j) { const int qb = (j & 1) ? sp : 63 - sp, c = j >> 1;
                      const float* nrm = (const float*)(ws + WS_CTL + 32768) + l * 128;
                      attn_body::attn_unit_dv128<8>(b, qb, Qb + 512 + (h * 2 + c) * 64, Qb + 2048 + (h * 2 + c) * 64, Qb + 2560 + h * 128, (c == 0) ? Qw + 3072 + h * 128 : Qw + 512 + h * 128,
                                                    nrm + ((2 * 2 + b) * 8 + h * 2 + c) * 2, nrm + ((3 * 2 + b) * 8 + h * 2 + c) * 2, (char*)lds); }
#pragma unroll 1
                  for (int j = 0; j < 2; ++j) diff_combine(b, j ? sp : 63 - sp, h, QKV, lam, l, karg_in(I_SUB) + l * 128); }
            }
            {
                const float* nrm = (const float*)(ws + WS_CTL + 32768) + l * 128; unsigned* qctr = (unsigned*)(ws + WS_CTL + 40960) + l * 64 + (PROBE == 3 ? rp * 16 : 0);
                volatile LAS unsigned* qw = (volatile LAS unsigned*)(ldsl + MISC_OFF + 16);
#pragma unroll 1
                for (;;) {
                    if (threadIdx.x == 0) qw[0] = atomicAdd(qctr, 1u);
                    __syncthreads();
                    const int idx = __builtin_amdgcn_readfirstlane((int)qw[0]);
                    if (idx >= 1024) break;
                    const int qb = 63 - (idx >> 4), bh = idx & 15, b = bh >> 3, h = bh & 7;
                    const float* nq_ = nrm + ((0 * 2 + b) * 8 + h) * 2; const float* nk_ = nrm + ((1 * 2 + b) * 8 + h) * 2;
                    const bool nomx = 1.05f * sqrtf((nq_[0] + nq_[1]) * (nk_[0] + nk_[1])) < 40.0f;
                    if (nomx) attn_body::attn_unit<8, true, true>(b, qb, Qb + h * 64, Qb + 1024 + h * 64, Qb + 1536 + h * 64, Qw + h * 64, LC + ((size_t)(b * 8 + h) << 14), CT + (b * 8 + h) * 128, nq_, nk_, (char*)lds);
                    else      attn_body::attn_unit<8, true, false>(b, qb, Qb + h * 64, Qb + 1024 + h * 64, Qb + 1536 + h * 64, Qw + h * 64, LC + ((size_t)(b * 8 + h) << 14), CT + (b * 8 + h) * 128, nq_, nk_, (char*)lds); }
            }
        }
        }
        SEAM(p0 + 3);
        if (EN(5) && IN(p0 + 4)) { PTRS();
            pg8::Gemm g{QKV, (const bf16*)(wl + WL_WOUT), M, DMODEL, DMODEL, PQ}; pg8::StaticOrder S; S.init(M, DMODEL, G, bx);
            pg8::EpiResidual E{(const float*)nullptr, XB, (float*)nullptr, XB, ssl + (size_t)2 * M * 16, 1.0f};
            pg8::gemm_phase<pg8::EpiResidual, pg8::StaticOrder, true, true>(ldsl, g, S, E);
        }
        SEAM(p0 + 4);
        if (EN(6) && IN(p0 + 5)) { PTRS();
            pg8::Gemm g{XB, (const bf16*)(wl + WL_GU2), M, 2 * DFF, DMODEL, DMODEL}; pg8::StaticOrder S; S.init(M, 2 * DFF, G, bx);
            pg8::EpiSwiGLU E{HB, ssl + (size_t)2 * M * 16, DFF};
            pg8::rstd_cache_reset();
            pg8::gemm_phase<pg8::EpiSwiGLU, pg8::StaticOrder, true, true>(ldsl, g, S, E);
        }
        SEAM(p0 + 5);
        if (EN(7) && IN(p0 + 6)) { PTRS();
            pg8::Gemm g{HB, (const bf16*)(wl + WL_D2), M, DMODEL, DFF, DFF}; pg8::StaticOrder S; S.init(M, DMODEL, G, bx);
            pg8::EpiResidual E{(const float*)nullptr, XB, (float*)nullptr, XB, ssl + (size_t)3 * M * 16, 0.5f};
            pg8::gemm_phase<pg8::EpiResidual, pg8::StaticOrder, true, true>(ldsl, g, S, E);
        }
        SEAM(p0 + 6);
    }
    if (EN(8) && IN(15)) {
        UNI(); OPQ_TID();
        const float* ssf = (const float*)(karg_ws() + WS_SS) + (size_t)6 * M * 16; const float* gf = karg_in(I_NF);
        f32x4 gv[4];
#pragma unroll
        for (int j = 0; j < 4; ++j) gv[j] = *((const f32x4*)gf + lane + 64 * j);
        for (int m0 = 4 * (vcu * NWAVES + wave); m0 < M; m0 += 4 * G * NWAVES) {
            f32x4 v[4][4]; float q[4]; const bf16* xbf = (const bf16*)(karg_ws() + WS_XB);
#pragma unroll
            for (int r = 0; r < 4; ++r) { q[r] = ssf[(size_t)(m0 + r) * 16 + (lane & 15)];
#pragma unroll
                for (int j = 0; j < 4; ++j) { const unsigned long long w = ((const unsigned long long*)(xbf + (size_t)(m0 + r) * DMODEL) + lane)[64 * j];
                    v[r][j] = (f32x4){__uint_as_float((unsigned)w << 16), __uint_as_float((unsigned)w & 0xffff0000u), __uint_as_float((unsigned)(w >> 32) << 16), __uint_as_float((unsigned)(w >> 32) & 0xffff0000u)}; } }
#pragma unroll
            for (int r = 0; r < 4; ++r) { const float rstd = __builtin_amdgcn_rsqf(wave_sum(q[r]) * 0.25f * (1.0f / 1024.0f) + 1e-5f);
#pragma unroll
                for (int j = 0; j < 4; ++j) ((f32x4*)(karg_out() + (size_t)(m0 + r) * DMODEL) + lane)[64 * j] = v[r][j] * rstd * gv[j]; }
        }
    }
#undef IN
#undef SEAM
}

extern "C" void kernel_launch(void* const* d_in, const int* in_sizes, int n_in, void* d_out, int out_size, void* d_ws, size_t ws_size, hipStream_t stream) {
    static int grid = 0;
    if (grid == 0) {
        if (n_in != 17 || in_sizes[0] != M * DMODEL || out_size != M * DMODEL || ws_size < WS_END) { fprintf(stderr, "kernel_launch: unexpected shapes (n_in %d, in0 %d, out %d, ws %zu)\n", n_in, n_in > 0 ? in_sizes[0] : -1, out_size, ws_size); grid = -1; return; }
        int dev = 0, cus = 0, per_cu = 0;
        if (hipGetDevice(&dev) != hipSuccess || hipDeviceGetAttribute(&cus, hipDeviceAttributeMultiprocessorCount, dev) != hipSuccess) { grid = -1; return; }
        if (hipFuncSetAttribute((const void*)mega_fwd, hipFuncAttributeMaxDynamicSharedMemorySize, LDS_BYTES) != hipSuccess) { fprintf(stderr, "kernel_launch: hipFuncSetAttribute failed\n"); grid = -1; return; }
        if (hipOccupancyMaxActiveBlocksPerMultiprocessor(&per_cu, (const void*)mega_fwd, NWAVES * 64, LDS_BYTES) != hipSuccess || per_cu < 1) { fprintf(stderr, "kernel_launch: occupancy query says %d\n", per_cu); per_cu = 1; }
        (void)hipGetLastError();
        grid = cus * 1;
    }
    if (grid < 0) return;
    if (hipMemsetAsync((char*)d_ws + WS_CTL, 0, CTL_ZERO_BYTES, stream) != hipSuccess) { fprintf(stderr, "kernel_launch: memset failed\n"); return; }
    Args a{};
    for (int i = 0; i < 17; ++i) a.in[i] = (const float*)d_in[i];
    a.out = (float*)d_out; a.ws = (unsigned char*)d_ws;
#if MK_LAUNCH_PER_PHASE
    for (int p = 0; p < NPHASE; ++p) { a.ph_lo = p; a.ph_hi = p + 1; hipLaunchKernelGGL(mega_fwd, dim3(grid), dim3(NWAVES * 64), LDS_BYTES, stream, a); }
#else
    a.ph_lo = 0; a.ph_hi = NPHASE;
    void* kargs[] = {&a};
    hipError_t e = hipLaunchCooperativeKernel((const void*)mega_fwd, dim3(grid), dim3(NWAVES * 64), kargs, LDS_BYTES, stream);
    if (e != hipSuccess) fprintf(stderr, "kernel_launch: cooperative launch failed: %s (grid %d)\n", hipGetErrorString(e), grid);
#endif
}
```

```cpp
#include <hip/hip_runtime.h>
#include <cstdio>
#include <cstdint>
template <int CTRL> __device__ __forceinline__ float dpp_f(float v) { return __builtin_bit_cast(float, __builtin_amdgcn_update_dpp(0, __builtin_bit_cast(int, v), CTRL, 0xf, 0xf, true)); }
__device__ __forceinline__ float row16_sum(float v) { v += dpp_f<0xB1>(v); v += dpp_f<0x4E>(v); v += dpp_f<0x141>(v); v += dpp_f<0x140>(v); return v; }
__device__ __forceinline__ float row16_max(float v) { v = fmaxf(v, dpp_f<0xB1>(v)); v = fmaxf(v, dpp_f<0x4E>(v)); v = fmaxf(v, dpp_f<0x141>(v)); v = fmaxf(v, dpp_f<0x140>(v)); return v; }
__device__ __forceinline__ float sum_x16_x32(float v) {
    float a = v, b = v; asm volatile("s_nop 1\n\tv_permlane16_swap_b32 %0, %1" : "+v"(a), "+v"(b)); v = a + b;
    a = v; b = v;       asm volatile("s_nop 1\n\tv_permlane32_swap_b32 %0, %1" : "+v"(a), "+v"(b)); return a + b; }
__device__ __forceinline__ float wave_sum_u(float v) { v = row16_sum(v); return (__builtin_bit_cast(float, __builtin_amdgcn_readlane(__builtin_bit_cast(int, v), 0)) + __builtin_bit_cast(float, __builtin_amdgcn_readlane(__builtin_bit_cast(int, v), 16)))
    + (__builtin_bit_cast(float, __builtin_amdgcn_readlane(__builtin_bit_cast(int, v), 32)) + __builtin_bit_cast(float, __builtin_amdgcn_readlane(__builtin_bit_cast(int, v), 48))); }
namespace pg8 {
#define PG8_LAS __attribute__((address_space(3)))
typedef unsigned short bf16_t;
typedef short bf16x8 __attribute__((ext_vector_type(8)));
typedef float f32x4 __attribute__((ext_vector_type(4)));
typedef unsigned u32x4 __attribute__((ext_vector_type(4)));
constexpr int BM = 256, BK = 64, HALF = 128, HTB = HALF * BK * 2  , STAGE_BYTES = 8 * HTB, NXCD = 8, WGM = 8;

__host__ __device__ __forceinline__ int lds_byte(int r, int c) { const int st = (r >> 4) * 2 + (c >> 5), rr = r & 15, cc = c & 31, ob = rr * 64 + cc * 2; return st * 1024 + (ob ^ (((ob >> 9) & 1) << 5)); }
__host__ __device__ __forceinline__ void stage_rc(int b, int& R, int& C) { const int st = b / 1024, sb = b % 1024, swz = sb ^ (((sb >> 9) & 1) << 5); R = (st >> 1) * 16 + swz / 64; C = (st & 1) * 32 + (swz % 64) / 2; }
__host__ __device__ __forceinline__ int perm32(int rho) { const int n = rho >> 4, i = rho & 15; return 8 * (i >> 2) + 4 * n + (i & 3); }

struct Unit { int pm, pn; };
struct Gemm { const bf16_t* A; const bf16_t* Bt; int M, N, K, lda; };

struct StaticOrder {
    int nM, nN, nwg, G, c;
    __host__ __device__ void init(int M, int N, int G_, int c_) { nM = M / BM; nN = N / BM; nwg = nM * nN; G = G_; c = c_; }
    __host__ __device__ bool next(int i, Unit& u) const {
        const long L = (long)i * G + c; if (L >= nwg) return false;
        int wgid = (int)L; { const int q = nwg / NXCD, r = nwg % NXCD, xcd = wgid % NXCD, off = wgid / NXCD; wgid = (xcd < r ? xcd * (q + 1) : r * (q + 1) + (xcd - r) * q) + off; }
        const int nig = WGM * nN, gid = wgid / nig, fm = gid * WGM, gsz = (nM - fm) < WGM ? (nM - fm) : WGM;
        u.pm = fm + ((wgid % nig) % gsz); u.pn = (wgid % nig) / gsz; return true;
    }
    __device__ __forceinline__ void a_ready(const Unit&) const {}
    __device__ __forceinline__ void done(const Unit&) const {}
};

__device__ __forceinline__ unsigned cvt_pk_bf16(float lo, float hi) { unsigned r; asm volatile("v_cvt_pk_bf16_f32 %0, %1, %2" : "=v"(r) : "v"(lo), "v"(hi)); return r; }
typedef float f32x2 __attribute__((ext_vector_type(2)));
constexpr float RMS_EPS = 1e-5f;
__device__ __forceinline__ void row_rstd(float (&rs)[2][4], const float* ss, int row0, int fq) {
#pragma unroll
    for (int ai = 0; ai < 2; ++ai)
#pragma unroll
        for (int m = 0; m < 4; ++m) { const f32x4 v = *(const f32x4*)(ss + (size_t)(row0 + ai * HALF + m * 16) * 16 + fq * 4);
            float s = (v[0] + v[1]) + (v[2] + v[3]); s = sum_x16_x32(s); rs[ai][m] = __builtin_amdgcn_rsqf(s * (1.0f / 1024.0f) + RMS_EPS);     }
}
constexpr int RSC_TAG_OFF = 131072, RSC_VAL_OFF = 131072 + 64;
extern __shared__ __attribute__((aligned(16))) unsigned char pg8_dyn_lds[];
__device__ __forceinline__ void rstd_cache_reset() { if ((threadIdx.x & 63) == 0) ((PG8_LAS int*)((PG8_LAS unsigned char*)pg8_dyn_lds + RSC_TAG_OFF))[threadIdx.x >> 6] = -1; }
__device__ __forceinline__ void row_rstd_cached(float (&rs)[2][4], const float* ss, int pm, int wr, int wc, int fr, int fq) {
    const int wid = wr * 4 + wc, lane = fq * 16 + fr;
    PG8_LAS int* tag = (PG8_LAS int*)((PG8_LAS unsigned char*)pg8_dyn_lds + RSC_TAG_OFF) + wid;
    PG8_LAS f32x4* val = (PG8_LAS f32x4*)((PG8_LAS unsigned char*)pg8_dyn_lds + RSC_VAL_OFF) + (wid * 64 + lane) * 2;
    if (__builtin_amdgcn_readfirstlane(tag[0]) == pm) { const f32x4 a = val[0], b = val[1];
        rs[0][0] = a[0]; rs[0][1] = a[1]; rs[0][2] = a[2]; rs[0][3] = a[3]; rs[1][0] = b[0]; rs[1][1] = b[1]; rs[1][2] = b[2]; rs[1][3] = b[3]; }
    else { row_rstd(rs, ss, pm * BM + wr * 64 + fr, fq);
        val[0] = (f32x4){rs[0][0], rs[0][1], rs[0][2], rs[0][3]}; val[1] = (f32x4){rs[1][0], rs[1][1], rs[1][2], rs[1][3]};
        if (lane == 0) tag[0] = pm; }
}
__device__ __forceinline__ float silu_mul(float g, float u) { const float e = __builtin_amdgcn_exp2f(g * -1.4426950408889634f); return g * u * __builtin_amdgcn_rcpf(1.0f + e); }
struct EpiSwiGLU {
    static constexpr bool PERM = false, AFTER_DRAIN = false;
    bf16_t* H; const float* ss; int ldh;
    __device__ __forceinline__ void operator()(const f32x4 (&acc)[2][2][4][2], const Unit& u, int wr, int wc, int fr, int fq) const {
        const int row0 = u.pm * BM + wr * 64 + fr; float rs[2][4]; row_rstd_cached(rs, ss, u.pm, wr, wc, fr, fq);
        const int col0 = u.pn * HALF + wc * 32 + 8 * fq;
#pragma unroll
        for (int ai = 0; ai < 2; ++ai)
#pragma unroll
            for (int m = 0; m < 4; ++m) { const float r = rs[ai][m]; bf16_t* rowp = H + (size_t)(row0 + ai * HALF + m * 16) * ldh + col0;
                const f32x4 g0 = acc[ai][0][m][0] * r, g1 = acc[ai][0][m][1] * r, u0 = acc[ai][1][m][0] * r, u1 = acc[ai][1][m][1] * r;
                u32x4 w; w.x = cvt_pk_bf16(silu_mul(g0[0], u0[0]), silu_mul(g0[1], u0[1])); w.y = cvt_pk_bf16(silu_mul(g0[2], u0[2]), silu_mul(g0[3], u0[3]));
                w.z = cvt_pk_bf16(silu_mul(g1[0], u1[0]), silu_mul(g1[1], u1[1])); w.w = cvt_pk_bf16(silu_mul(g1[2], u1[2]), silu_mul(g1[3], u1[3]));
                *(u32x4*)rowp = w; }
    }
};
struct EpiResidual {
    static constexpr bool PERM = false, AFTER_DRAIN = false;
    const float* src; const bf16_t* srcb; float* dst; bf16_t* xb; float* ss_out; float scale;
    __device__ __forceinline__ void operator()(const f32x4 (&acc)[2][2][4][2], const Unit& u, int wr, int wc, int fr, int fq) const {
        const int row0 = u.pm * BM + wr * 64 + fr, col0 = u.pn * BM + wc * 32 + 8 * fq;
#pragma unroll
        for (int ai = 0; ai < 2; ++ai) {
          u32x4 xov[4][2];
          if (!src) {
#pragma unroll
                for (int m = 0; m < 4; ++m)
#pragma unroll
                    for (int bj = 0; bj < 2; ++bj) xov[m][bj] = *(const u32x4*)(srcb + (size_t)(row0 + ai * HALF + m * 16) * 1024 + col0 + bj * HALF);
          }
#pragma unroll
            for (int m = 0; m < 4; ++m) { const int row = row0 + ai * HALF + m * 16; float q = 0.f;
#pragma unroll
                for (int bj = 0; bj < 2; ++bj) { const size_t off = (size_t)row * 1024 + col0 + bj * HALF;
                    f32x4 a, b;
                    if (src) { a = *(const f32x4*)(src + off); b = *(const f32x4*)(src + off + 4); }
                    else { const u32x4 xo = xov[m][bj];
                        a = (f32x4){__uint_as_float(xo.x << 16), __uint_as_float(xo.x & 0xffff0000u), __uint_as_float(xo.y << 16), __uint_as_float(xo.y & 0xffff0000u)};
                        b = (f32x4){__uint_as_float(xo.z << 16), __uint_as_float(xo.z & 0xffff0000u), __uint_as_float(xo.w << 16), __uint_as_float(xo.w & 0xffff0000u)}; }
                    a = a + acc[ai][bj][m][0] * scale; b = b + acc[ai][bj][m][1] * scale;
                    if (dst) { *(f32x4*)(dst + off) = a; *(f32x4*)(dst + off + 4) = b; }
                    u32x4 w; w.x = cvt_pk_bf16(a[0], a[1]); w.y = cvt_pk_bf16(a[2], a[3]); w.z = cvt_pk_bf16(b[0], b[1]); w.w = cvt_pk_bf16(b[2], b[3]);
                    if (xb) *(u32x4*)(xb + off) = w;
                    q += (a[0] * a[0] + a[1] * a[1]) + (a[2] * a[2] + a[3] * a[3]) + (b[0] * b[0] + b[1] * b[1]) + (b[2] * b[2] + b[3] * b[3]); }
                q = sum_x16_x32(q);
                if (fq == 0) ss_out[(size_t)row * 16 + u.pn * 4 + wc] = q; }
        }
    }
};
struct EpiQKV {
    static constexpr bool PERM = false, AFTER_DRAIN = false;
    bf16_t* O; const float* ss; const float* cosT; const float* sinT; float qscale; unsigned* nrm;
    __device__ __forceinline__ void operator()(const f32x4 (&acc)[2][2][4][2], const Unit& u, int wr, int wc, int fr, int fq) const {
        typedef unsigned u32x2v __attribute__((ext_vector_type(2)));
        const int row0 = u.pm * BM + wr * 64 + fr; float rs[2][4]; row_rstd_cached(rs, ss, u.pm, wr, wc, fr, fq);
        const int pn = u.pn, rg = pn >> 1; const bool rope = (pn >= 6 && pn < 10);
        const int cbase = (rg == 0 ? 0 : rg == 1 ? 1024 : rg == 2 ? 1536 : rg == 3 ? 512 : rg == 4 ? 2048 : 2560) + (pn & 1) * 256; const float sc = (pn < 2 || pn == 6 || pn == 7) ? qscale : 1.0f;
        if (!rope) {
            const int col0 = cbase + wc * 32 + 8 * fq; float mx[2] = {0.f, 0.f};
#pragma unroll
            for (int ai = 0; ai < 2; ++ai)
#pragma unroll
                for (int m = 0; m < 4; ++m) { const float r = rs[ai][m] * sc; bf16_t* rowp = O + (size_t)(row0 + ai * HALF + m * 16) * 3584 + col0;
#pragma unroll
                    for (int bj = 0; bj < 2; ++bj) { const f32x4 v0 = acc[ai][bj][m][0] * r, v1 = acc[ai][bj][m][1] * r;
                        u32x4 w; w.x = cvt_pk_bf16(v0[0], v0[1]); w.y = cvt_pk_bf16(v0[2], v0[3]); w.z = cvt_pk_bf16(v1[0], v1[1]); w.w = cvt_pk_bf16(v1[2], v1[3]);
                        *(u32x4*)(rowp + bj * HALF) = w;
                        if (pn < 4) { float q = (v0[0] * v0[0] + v0[1] * v0[1]) + (v0[2] * v0[2] + v0[3] * v0[3]) + (v1[0] * v1[0] + v1[1] * v1[1]) + (v1[2] * v1[2] + v1[3] * v1[3]);
                            q = sum_x16_x32(q); mx[bj] = fmaxf(mx[bj], q); } } }
            if (pn < 4) {
#pragma unroll
                for (int bj = 0; bj < 2; ++bj) { float v = mx[bj]; v = row16_max(v);
                    if (fr == 0 && fq == 0) atomicMax(nrm + (((pn >> 1) * 2 + (u.pm >> 6)) * 8 + (pn & 1) * 4 + 2 * bj + (wc >> 1)) * 2 + (wc & 1), __float_as_uint(v)); } }
        } else {
            const int d0 = 16 * (wc & 1) + 4 * fq, colb = cbase + (wc >> 1) * 64 + d0; float mx[2] = {0.f, 0.f};
#pragma unroll
            for (int ai = 0; ai < 2; ++ai)
#pragma unroll
                for (int m = 0; m < 4; ++m) { const int row = row0 + ai * HALF + m * 16; const float r = rs[ai][m] * sc; const int pos = row & 16383;
                    const f32x4 c4 = *(const f32x4*)(cosT + pos * 32 + d0), s4 = *(const f32x4*)(sinT + pos * 32 + d0);
                    bf16_t* rowp = O + (size_t)row * 3584 + colb;
#pragma unroll
                    for (int bj = 0; bj < 2; ++bj) { const f32x4 x1 = acc[ai][bj][m][0] * r, x2 = acc[ai][bj][m][1] * r;
                        const f32x4 o1 = x1 * c4 - x2 * s4, o2 = x2 * c4 + x1 * s4;
                        u32x2v w1, w2; w1.x = cvt_pk_bf16(o1[0], o1[1]); w1.y = cvt_pk_bf16(o1[2], o1[3]); w2.x = cvt_pk_bf16(o2[0], o2[1]); w2.y = cvt_pk_bf16(o2[2], o2[3]);
                        *(u32x2v*)(rowp + bj * HALF) = w1; *(u32x2v*)(rowp + bj * HALF + 32) = w2;
                        { float q = (x1[0] * x1[0] + x1[1] * x1[1]) + (x1[2] * x1[2] + x1[3] * x1[3]) + (x2[0] * x2[0] + x2[1] * x2[1]) + (x2[2] * x2[2] + x2[3] * x2[3]);
                          q = sum_x16_x32(q); mx[bj] = fmaxf(mx[bj], q); } } }
#pragma unroll
            for (int bj = 0; bj < 2; ++bj) { float v = row16_max(mx[bj]);
                if (fr == 0 && fq == 0) atomicMax(nrm + (((pn >> 1) * 2 - 2 + (u.pm >> 6)) * 8 + (pn & 1) * 4 + 2 * bj + (wc >> 1)) * 2 + (wc & 1), __float_as_uint(v)); }
        }
    }
};

template <class Epi, class Sched, bool ALIGN_EPI = false, bool SP2 = false>
__device__ __forceinline__ void gemm_phase(PG8_LAS unsigned char* lds, const Gemm g, const Sched& S, const Epi& E) {
    int tid_ = threadIdx.x; asm volatile("" : "+v"(tid_));
    const int tid = tid_, wid = __builtin_amdgcn_readfirstlane(tid >> 6), lane = tid & 63, wr = wid >> 2, wc = wid & 3, fr = lane & 15, fq = lane >> 4;
    const int K = g.K, nt = K / BK;
    unsigned voffA[2], voffB[2];
#pragma unroll
    for (int i = 0; i < 2; ++i) { int R, C; stage_rc(tid * 16 + i * 8192, R, C); const int Rb = Epi::PERM ? ((R & ~31) + perm32(R & 31)) : R;
        voffA[i] = (unsigned)(R * g.lda + C) * 2u; voffB[i] = (unsigned)(Rb * K + C) * 2u; }
    const size_t kstep = (size_t)(BK * 2);
    const size_t hstep = (size_t)HALF * K * 2;
    const size_t tstep = 2 * hstep;
    const size_t hstepA = (size_t)HALF * g.lda * 2, tstepA = 2 * hstepA;
    const unsigned ldsw = (unsigned)wid * 1024u;
    const int aoff = lds_byte(wr * 64 + fr, fq * 8), boff = lds_byte(wc * 32 + fr, fq * 8);
#define PG8_SA(b, h) (((b) * 2 + (h)) * HTB)
#define PG8_SB(b, h) ((4 + (b) * 2 + (h)) * HTB)
#define PG8_STAGE(bufoff, gbase, voff) do { _Pragma("unroll") for (int _i = 0; _i < 2; ++_i) \
        __builtin_amdgcn_global_load_lds((const unsigned*)((const char*)(gbase) + (voff)[_i]), (PG8_LAS unsigned*)(lds + (bufoff) + ldsw + _i * 8192), 16, 0, 0); } while (0)
#define PG8_LDA(dst, b, h) do { _Pragma("unroll") for (int m = 0; m < 4; ++m) _Pragma("unroll") for (int k = 0; k < 2; ++k) dst[m][k] = *(const PG8_LAS bf16x8*)(lds + PG8_SA(b, h) + aoff + m * 2048 + k * 1024); } while (0)
#define PG8_LDB(dst, b, h) do { _Pragma("unroll") for (int n = 0; n < 2; ++n) _Pragma("unroll") for (int k = 0; k < 2; ++k) dst[n][k] = *(const PG8_LAS bf16x8*)(lds + PG8_SB(b, h) + boff + n * 2048 + k * 1024); } while (0)
#define PG8_MMA(ai, bj, At, Bt) do { __builtin_amdgcn_s_setprio(1); _Pragma("unroll") for (int m = 0; m < 4; ++m) _Pragma("unroll") for (int n = 0; n < 2; ++n) _Pragma("unroll") for (int k = 0; k < 2; ++k) \
        acc[ai][bj][m][n] = __builtin_amdgcn_mfma_f32_16x16x32_bf16(Bt[n][k], At[m][k], acc[ai][bj][m][n], 0, 0, 0); __builtin_amdgcn_s_setprio(0); } while (0)
#define PG8_WAIT_V(n) asm volatile("s_waitcnt vmcnt(" #n ")" ::: "memory")
#define PG8_WAIT_L(n) asm volatile("s_waitcnt lgkmcnt(" #n ")" ::: "memory")
#define PG8_BAR __builtin_amdgcn_s_barrier()
#define PG8_SCHED __builtin_amdgcn_sched_barrier(0)
    Unit cur, nxt; int ui = 0;
    if (!S.next(0, cur)) return;
    f32x4 acc[2][2][4][2];
#pragma unroll
    for (int a = 0; a < 2; ++a)
#pragma unroll
        for (int b = 0; b < 2; ++b)
#pragma unroll
            for (int m = 0; m < 4; ++m)
#pragma unroll
                for (int n = 0; n < 2; ++n) acc[a][b][m][n] = (f32x4){0.f, 0.f, 0.f, 0.f};
    bf16x8 At[4][2], B0[2][2], B1[2][2];
    const char* cA = (const char*)g.A + (size_t)cur.pm * tstepA; const char* cB = (const char*)g.Bt + (size_t)cur.pn * tstep;
    S.a_ready(cur);
    if constexpr (SP2) {
        PG8_STAGE(PG8_SB(0, 0), cB, voffB); PG8_STAGE(PG8_SB(0, 1), cB + hstep, voffB); PG8_STAGE(PG8_SA(0, 0), cA, voffA); PG8_STAGE(PG8_SA(0, 1), cA + hstepA, voffA);
        if (wr == 1) PG8_BAR;
        PG8_WAIT_V(2); PG8_BAR;
        PG8_STAGE(PG8_SB(1, 0), cB + kstep, voffB); PG8_STAGE(PG8_SA(1, 0), cA + kstep, voffA); PG8_STAGE(PG8_SB(1, 1), cB + hstep + kstep, voffB);
        PG8_WAIT_V(6); PG8_BAR;
    } else {
        PG8_STAGE(PG8_SB(0, 0), cB, voffB); PG8_STAGE(PG8_SA(0, 0), cA, voffA); PG8_STAGE(PG8_SB(0, 1), cB + hstep, voffB); PG8_STAGE(PG8_SA(0, 1), cA + hstepA, voffA);
        if (wr == 1) PG8_BAR;
        PG8_WAIT_V(4); PG8_BAR;
        PG8_STAGE(PG8_SB(1, 0), cB + kstep, voffB); PG8_STAGE(PG8_SA(1, 0), cA + kstep, voffA); PG8_STAGE(PG8_SB(1, 1), cB + hstep + kstep, voffB);
        PG8_WAIT_V(6); PG8_BAR;
    }
    for (;;) {
        const bool has_next = S.next(ui + 1, nxt);
        const char* nA = has_next ? (const char*)g.A + (size_t)nxt.pm * tstepA : cA; const char* nB = has_next ? (const char*)g.Bt + (size_t)nxt.pn * tstep : cB;
        for (int t = 0; t < nt; t += 2) {
            const bool last = (t == nt - 2);
            const char* a1 = cA + (size_t)(t + 1) * kstep;
            const char* a2 = last ? nA : cA + (size_t)(t + 2) * kstep; const char* b2 = last ? nB : cB + (size_t)(t + 2) * kstep;
            const char* a3 = a2 + kstep; const char* b3 = b2 + kstep;
            if (last && has_next) S.a_ready(nxt);
            if constexpr (SP2) {
            PG8_LDB(B0, 0, 0); PG8_LDB(B1, 0, 1); PG8_SCHED; PG8_LDA(At, 0, 0); PG8_STAGE(PG8_SA(1, 1), a1 + hstepA, voffA);
            PG8_WAIT_V(8); PG8_WAIT_L(0); PG8_BAR; PG8_MMA(0, 0, At, B0); PG8_MMA(0, 1, At, B1); PG8_BAR; PG8_SCHED;
            PG8_LDA(At, 0, 1); PG8_STAGE(PG8_SB(0, 0), b2, voffB); PG8_STAGE(PG8_SB(0, 1), b2 + hstep, voffB); PG8_STAGE(PG8_SA(0, 0), a2, voffA);
            PG8_WAIT_V(8); PG8_WAIT_L(0); PG8_BAR; PG8_MMA(1, 0, At, B0); PG8_MMA(1, 1, At, B1); PG8_BAR; PG8_SCHED;
            PG8_LDB(B0, 1, 0); PG8_LDB(B1, 1, 1); PG8_SCHED; PG8_LDA(At, 1, 0); PG8_STAGE(PG8_SA(0, 1), a2 + hstepA, voffA);
            PG8_WAIT_V(8); PG8_WAIT_L(0); PG8_BAR; PG8_MMA(0, 0, At, B0); PG8_MMA(0, 1, At, B1); PG8_BAR; PG8_SCHED;
            PG8_LDA(At, 1, 1); PG8_STAGE(PG8_SB(1, 0), b3, voffB); PG8_STAGE(PG8_SB(1, 1), b3 + hstep, voffB); PG8_STAGE(PG8_SA(1, 0), a3, voffA);
            PG8_WAIT_V(8); PG8_WAIT_L(0); PG8_BAR; PG8_MMA(1, 0, At, B0); PG8_MMA(1, 1, At, B1); PG8_BAR; PG8_SCHED;
            } else {
            PG8_LDB(B0, 0, 0); PG8_SCHED; PG8_LDA(At, 0, 0); PG8_STAGE(PG8_SA(1, 1), a1 + hstepA, voffA);
            PG8_WAIT_L(8); PG8_BAR; PG8_WAIT_L(0); PG8_MMA(0, 0, At, B0); PG8_BAR; PG8_SCHED;
            PG8_LDB(B1, 0, 1); PG8_STAGE(PG8_SB(0, 0), b2, voffB);
            PG8_BAR; PG8_WAIT_L(0); PG8_MMA(0, 1, At, B1); PG8_BAR;
            PG8_LDA(At, 0, 1); PG8_STAGE(PG8_SA(0, 0), a2, voffA);
            PG8_BAR; PG8_WAIT_L(0); PG8_MMA(1, 0, At, B0); PG8_BAR; PG8_SCHED;
            PG8_STAGE(PG8_SB(0, 1), b2 + hstep, voffB);
            PG8_WAIT_V(6); PG8_BAR; PG8_MMA(1, 1, At, B1); PG8_BAR;
            PG8_LDB(B0, 1, 0); PG8_SCHED; PG8_LDA(At, 1, 0); PG8_STAGE(PG8_SA(0, 1), a2 + hstepA, voffA);
            PG8_WAIT_L(8); PG8_BAR; PG8_WAIT_L(0); PG8_MMA(0, 0, At, B0); PG8_BAR; PG8_SCHED;
            PG8_LDB(B1, 1, 1); PG8_STAGE(PG8_SB(1, 0), b3, voffB);
            PG8_BAR; PG8_WAIT_L(0); PG8_MMA(0, 1, At, B1); PG8_BAR;
            PG8_LDA(At, 1, 1); PG8_STAGE(PG8_SA(1, 0), a3, voffA);
            PG8_BAR; PG8_WAIT_L(0); PG8_MMA(1, 0, At, B0); PG8_BAR; PG8_SCHED;
            PG8_STAGE(PG8_SB(1, 1), b3 + hstep, voffB);
            PG8_WAIT_V(6); PG8_BAR; PG8_MMA(1, 1, At, B1); PG8_BAR;
            }
        }
        if constexpr (ALIGN_EPI) { if (wr == 0) PG8_BAR; }
        if constexpr (!Epi::AFTER_DRAIN) { E(acc, cur, wr, wc, fr, fq); S.done(cur); }
        if (!has_next) break;
#pragma unroll
        for (int a = 0; a < 2; ++a)
#pragma unroll
            for (int b = 0; b < 2; ++b)
#pragma unroll
                for (int m = 0; m < 4; ++m)
#pragma unroll
                    for (int n = 0; n < 2; ++n) acc[a][b][m][n] = (f32x4){0.f, 0.f, 0.f, 0.f};
        cur = nxt; cA = nA; cB = nB; ++ui;
        if constexpr (ALIGN_EPI) { if (wr == 1) PG8_BAR; }
    }
    PG8_WAIT_V(0);
    if constexpr (!ALIGN_EPI) { if (wr == 0) PG8_BAR; }
    PG8_BAR;
    if constexpr (Epi::AFTER_DRAIN) { E.fused(acc, cur, wr, wc, fr, fq, lds, wid, lane); S.done(cur); }
#undef PG8_SA
#undef PG8_SB
#undef PG8_STAGE
#undef PG8_LDA
#undef PG8_LDB
#undef PG8_MMA
#undef PG8_WAIT_V
#undef PG8_WAIT_L
#undef PG8_BAR
#undef PG8_SCHED
}
}

#ifndef PG8_SP2
#define PG8_SP2 true
#endif
#ifndef PG8_ALIGN
#define PG8_ALIGN true
#endif
#include <hip/hip_bf16.h>
#include <cmath>
namespace attn_body {
using bf16=__hip_bfloat16;
using bf16x8=__attribute__((ext_vector_type(8)))short;
using s16x4=__attribute__((ext_vector_type(4)))short;
using f32x16=__attribute__((ext_vector_type(16)))float;
using u32x4=__attribute__((ext_vector_type(4)))unsigned;
constexpr int BATCH=2,SEQ=16384,D=64,PQ=3584;
constexpr int NW=8,QBLK=32,QB=QBLK*NW,KVBLK=64,NQB=SEQ/QB;
constexpr int ATTN_UNIT_ROWS=QB; typedef float f32x4_t __attribute__((ext_vector_type(4)));
__device__ __forceinline__ int crow(int r,int hi){return (r&3)+8*(r>>2)+4*hi;}
#define SBAR() __builtin_amdgcn_sched_barrier(0)
__device__ __forceinline__ void cmask(f32x16&p0,f32x16&p1,int jb,int qrel,int hi){
  const float NEG=-INFINITY; int kb=64*jb+4*hi;
  #pragma unroll
  for(int r=0;r<16;++r){int kv=kb+(r&3)+8*(r>>2); if(kv>qrel)p0[r]=NEG; if(kv+32>qrel)p1[r]=NEG;}
}

constexpr int NSLOT=3, SLOTB=8192;
constexpr int LDS_K=0, LDS_V=NSLOT*SLOTB, LDS_WS=2*NSLOT*SLOTB, LDS_OST=LDS_WS+NW*64*4, LDS_BYTES=LDS_OST+NW*4096;
constexpr int NCS_OFF=LDS_BYTES;
constexpr float C2=0.125f*1.4426950408889634f;
__device__ __forceinline__ void glds16(const void*gsrc,unsigned lds_dst){unsigned keep;
  asm volatile("s_mov_b32 %0, m0\n\ts_mov_b32 m0, %2\n\ts_nop 0\n\tglobal_load_lds_dwordx4 %1, off\n\ts_mov_b32 m0, %0":"=&s"(keep):"v"(gsrc),"s"(lds_dst):"memory");}
__device__ __forceinline__ float max3f(float a,float b,float c){float r;asm("v_max3_f32 %0, %1, %2, %3":"=v"(r):"v"(a),"v"(b),"v"(c));return r;}
__device__ __forceinline__ float max2f(float a,float b){float r;asm("v_max_f32_e32 %0, %1, %2":"=v"(r):"v"(a),"v"(b));return r;}
__device__ __forceinline__ float fadd_s(float a,float b){float r;asm("v_add_f32_e32 %0, %1, %2":"=v"(r):"v"(a),"v"(b));return r;}
__device__ __forceinline__ float fsub_s(float a,float b){float r;asm("v_sub_f32_e32 %0, %1, %2":"=v"(r):"v"(a),"v"(b));return r;}
typedef float f32x2_t __attribute__((ext_vector_type(2))); typedef __bf16 bf16x2_t __attribute__((ext_vector_type(2)));
__device__ __forceinline__ unsigned cvtpk_s(float lo,float hi){f32x2_t v={lo,hi};bf16x2_t b=__builtin_convertvector(v,bf16x2_t);return __builtin_bit_cast(unsigned,b);}
#define WAIT_BAR(N) asm volatile("s_waitcnt vmcnt(" #N ") lgkmcnt(0)\n\ts_barrier":::"memory")

__device__ __forceinline__ void qkt(f32x16&p0,f32x16&p1,const char*Kslot,const bf16x8*qr,const f32x16&negm,int r32,int hi){
  const char*kb=Kslot+hi*1024+r32*16;
  #pragma unroll
  for(int d0=0;d0<4;++d0){
    const bf16x8 b0=*reinterpret_cast<const bf16x8*>(kb+d0*2048);
    const bf16x8 b1=*reinterpret_cast<const bf16x8*>(kb+d0*2048+512);
    if(d0==0){p0=__builtin_amdgcn_mfma_f32_32x32x16_bf16(b0,qr[0],negm,0,0,0);p1=__builtin_amdgcn_mfma_f32_32x32x16_bf16(b1,qr[0],negm,0,0,0);}
    else{p0=__builtin_amdgcn_mfma_f32_32x32x16_bf16(b0,qr[d0],p0,0,0,0);p1=__builtin_amdgcn_mfma_f32_32x32x16_bf16(b1,qr[d0],p1,0,0,0);}}
}
typedef __attribute__((address_space(3))) const char* lds_cptr;
typedef short v4i16_t __attribute__((ext_vector_type(4)));
__device__ __forceinline__ void kload8(bf16x8*kf,lds_cptr kp){
  kf[0]=*(const __attribute__((address_space(3))) bf16x8*)(kp);      kf[1]=*(const __attribute__((address_space(3))) bf16x8*)(kp+512);
  kf[2]=*(const __attribute__((address_space(3))) bf16x8*)(kp+2048); kf[3]=*(const __attribute__((address_space(3))) bf16x8*)(kp+2560);
  kf[4]=*(const __attribute__((address_space(3))) bf16x8*)(kp+4096); kf[5]=*(const __attribute__((address_space(3))) bf16x8*)(kp+4608);
  kf[6]=*(const __attribute__((address_space(3))) bf16x8*)(kp+6144); kf[7]=*(const __attribute__((address_space(3))) bf16x8*)(kp+6656);
}
__device__ __forceinline__ void kload2(bf16x8*kf,lds_cptr kp,int j){ kf[2*j]=*(const __attribute__((address_space(3))) bf16x8*)(kp+j*2048); kf[2*j+1]=*(const __attribute__((address_space(3))) bf16x8*)(kp+j*2048+512); }
__device__ __forceinline__ s16x4 vtr(lds_cptr p){ return __builtin_bit_cast(s16x4,__builtin_amdgcn_ds_read_tr16_b64_v4i16((__attribute__((address_space(3))) v4i16_t*)p)); }
__device__ __forceinline__ float rowmax(const f32x16&p0,const f32x16&p1){
  float a=max3f(p0[0],p0[1],p1[0]),b=max3f(p0[2],p0[3],p1[1]);a=max3f(a,p1[2],p1[3]);
  #pragma unroll
  for(int r=4;r<16;r+=4){a=max3f(a,p0[r],p0[r+1]);b=max3f(b,p0[r+2],p0[r+3]);a=max3f(a,p1[r],p1[r+1]);b=max3f(b,p1[r+2],p1[r+3]);}
  const float m=max2f(a,b);
  auto rr=__builtin_amdgcn_permlane32_swap(__float_as_uint(m),__float_as_uint(m),false,false);
  return max2f(__uint_as_float(rr[0]),__uint_as_float(rr[1]));
}
__device__ __forceinline__ void pv(f32x16*o,int vb,bf16x8 pa0,bf16x8 pa1,bf16x8 pa2,bf16x8 pa3){
  #pragma unroll
  for(int d0=0;d0<2;++d0){s16x4 lo[4],hi[4];
    #pragma unroll
    for(int ks=0;ks<4;++ks){
      asm volatile("ds_read_b64_tr_b16 %0,%1 offset:%c2":"=&v"(lo[ks]):"v"(vb),"i"(d0*4096+ks*1024):"memory");
      asm volatile("ds_read_b64_tr_b16 %0,%1 offset:%c2":"=&v"(hi[ks]):"v"(vb),"i"(d0*4096+ks*1024+512):"memory");}
    asm volatile("s_waitcnt lgkmcnt(0)":::"memory");SBAR();
    #define PK(k) (bf16x8){lo[k][0],lo[k][1],lo[k][2],lo[k][3],hi[k][0],hi[k][1],hi[k][2],hi[k][3]}
    o[d0]=__builtin_amdgcn_mfma_f32_32x32x16_bf16(pa0,PK(0),o[d0],0,0,0);
    o[d0]=__builtin_amdgcn_mfma_f32_32x32x16_bf16(pa1,PK(1),o[d0],0,0,0);
    o[d0]=__builtin_amdgcn_mfma_f32_32x32x16_bf16(pa2,PK(2),o[d0],0,0,0);
    o[d0]=__builtin_amdgcn_mfma_f32_32x32x16_bf16(pa3,PK(3),o[d0],0,0,0);
    #undef PK
  }
}

#ifndef ATTN_STORE16
#define ATTN_STORE16(p,v) (*(u32x4*)(p)=(v))
#endif
template<int THRL,bool FOX,bool NOMX> __device__ __forceinline__ void attn_unit(int b,int qb,const bf16*Q,const bf16*__restrict__ K,const bf16*__restrict__ V,bf16*O,const float*lc,const float*ctot,const float*nq,const float*nk,char*shm){
  int tid_=threadIdx.x; asm volatile("":"+v"(tid_));   const int tid=tid_,lane=tid&63,r32=lane&31,hi=lane>>5; const int wid=__builtin_amdgcn_readfirstlane(tid>>6);
  const long rowbase=(long)b*SEQ; const int q0=qb*QB;
  const bf16*Qw=Q+(rowbase+q0+wid*QBLK)*PQ;
    typedef __attribute__((address_space(3))) float* lds_fptr;
  const lds_fptr ncs3=(lds_fptr)((__attribute__((address_space(3))) char*)shm+NCS_OFF); float ctq=0.f; int kofs=0;
  if(FOX){
    const lds_fptr pref3=(lds_fptr)((__attribute__((address_space(3))) char*)shm+NCS_OFF+65536);
    __attribute__((address_space(3))) unsigned* cnt3=(__attribute__((address_space(3))) unsigned*)((__attribute__((address_space(3))) char*)shm+NCS_OFF+65536+512);
    const int ntf_=(q0+QB)/KVBLK; const float lcq0_=lc[q0]; float lcj_=0.f; if(tid<ntf_-4)lcj_=lc[64*tid+63]; const float nqk_=(nq[0]+nq[1])*(nk[0]+nk[1]);
    if(wid==0){ const float a_=ctot[2*lane],b_=ctot[2*lane+1]; float s_=a_+b_;
      _Pragma("unroll") for(int o_=1;o_<64;o_<<=1){ const float t_=__builtin_bit_cast(float,__builtin_amdgcn_ds_bpermute((lane-o_)<<2,__builtin_bit_cast(int,s_))); if(lane>=o_)s_+=t_; }
      const float ex_=s_-(a_+b_); pref3[2*lane]=ex_; pref3[2*lane+1]=ex_+a_; if(lane==0)cnt3[0]=0u; }
    asm volatile("s_waitcnt lgkmcnt(0)\n\ts_barrier":::"memory");
    { const float thb_=42.0f+2.1f*sqrtf(nqk_);
      const float cq0_=(lcq0_+pref3[q0>>7])*1.4426950408889634f; bool skip_=false;
      if(tid<ntf_-4){ const int s_=64*tid+63; const float cj_=(lcj_+pref3[s_>>7])*1.4426950408889634f; skip_=(cq0_-cj_)<=-thb_; }
      const unsigned long long bal_=__ballot(skip_); if(lane==0&&bal_)__hip_atomic_fetch_add(cnt3,(unsigned)__popcll(bal_),__ATOMIC_RELAXED,__HIP_MEMORY_SCOPE_WORKGROUP); }
    asm volatile("s_waitcnt lgkmcnt(0)\n\ts_barrier":::"memory");
    kofs=__builtin_amdgcn_readfirstlane((int)(cnt3[0]&~1u))*KVBLK;
    const int n4_=(q0+QB)>>2;
    for(int i_=tid+(kofs>>2);i_<n4_;i_+=NW*64){ const f32x4_t v_=*(const f32x4_t*)(lc+4*i_); const float p_=pref3[i_>>5];
      f32x4_t w_; w_[0]=(v_[0]+p_)*-1.4426950408889634f; w_[1]=(v_[1]+p_)*-1.4426950408889634f; w_[2]=(v_[2]+p_)*-1.4426950408889634f; w_[3]=(v_[3]+p_)*-1.4426950408889634f;
      *(__attribute__((address_space(3))) f32x4_t*)(ncs3+4*i_)=w_; }
  }
  const bf16*Kh=K+(rowbase+kofs)*PQ,*Vh=V+(rowbase+kofs)*PQ;
  const unsigned lds0=(unsigned)(uintptr_t)shm;
  float*wsf=(float*)(shm+LDS_WS)+wid*64;
  const bf16*ksrc=Kh+(long)lane*PQ+wid*8;
  const bf16*vsrc=Vh+(long)(16*(wid&3)+(lane>>2))*PQ+(wid>>2)*32+(lane&3)*8;
  const unsigned kdst=lds0+LDS_K+wid*1024, vdst=lds0+LDS_V+wid*1024;
  #define DMA_K(t,slot) glds16(ksrc+(long)(t)*KVBLK*PQ,(unsigned)__builtin_amdgcn_readfirstlane(kdst+(slot)))
  #define DMA_V(t,slot) glds16(vsrc+(long)(t)*KVBLK*PQ,(unsigned)__builtin_amdgcn_readfirstlane(vdst+(slot)))
  const int vb0=(int)(lds0+LDS_V)+((lane>>4)&1)*32+(lane&3)*8+(4*hi+((lane&15)>>2))*64;
  const char*Kbase=shm+LDS_K; bf16x8 kf[8];
  const lds_cptr shm3=(lds_cptr)shm; const lds_cptr kp0=shm3+LDS_K+hi*1024+r32*16; const lds_cptr vp0=shm3+LDS_V+((lane>>4)&1)*32+(lane&3)*8+(4*hi+((lane&15)>>2))*64;
  const int NT=(q0+QB-kofs)/KVBLK;
  #define CINIT (FOX?f32x16{}:negm)
  #define FBIAS(P0,P1,t) do{ if(FOX){ const float nm_=ctq-mhat; const __attribute__((address_space(3))) f32x4_t* bp_=(const __attribute__((address_space(3))) f32x4_t*)(ncs3+kofs+64*(t)+4*hi); \
    _Pragma("unroll") for(int g_=0;g_<4;++g_){ const f32x4_t b0_=bp_[2*g_]+nm_, b1_=bp_[2*g_+8]+nm_; \
      _Pragma("unroll") for(int j_=0;j_<4;++j_){ P0[4*g_+j_]+=b0_[j_]; P1[4*g_+j_]+=b1_[j_]; } } } \
    }while(0)
  DMA_K(0,0);DMA_V(0,0);DMA_K(1,SLOTB);
  bf16x8 qr[4];
  #pragma unroll
  for(int d0=0;d0<4;++d0)qr[d0]=*reinterpret_cast<const bf16x8*>(&Qw[(long)r32*PQ+d0*16+hi*8]);
  float mhat=0.f,l_reg=0.f;f32x16 o[2];o[0]=f32x16{};o[1]=f32x16{};f32x16 negm=f32x16{}; if(!FOX){asm volatile("":"+v"(negm));}
  const int qrel=wid*QBLK+r32;
  #define CMASK(P0,P1,t) do{int jb_=(t)-(NT-4); if(jb_>=0)cmask(P0,P1,jb_,qrel,hi);}while(0)
  bool resc=false;
  #define START(P0,P1) do{ resc=false; \
    if(!NOMX){ const float rm=rowmax(P0,P1); const float dl=rm; mhat=fadd_s(mhat,dl); \
      _Pragma("unroll") for(int r=0;r<16;++r){P0[r]=fsub_s(P0[r],dl);P1[r]=fsub_s(P1[r],dl);} \
      if(!FOX){ _Pragma("unroll") for(int r=0;r<16;++r)negm[r]=-mhat; asm volatile("":"+v"(negm)); } } \
    _Pragma("unroll") for(int r=0;r<16;++r)P0[r]=__builtin_amdgcn_exp2f(P0[r]); }while(0)
  #define RESC() do{ if(resc){ asm volatile("s_waitcnt lgkmcnt(0)":::"memory"); \
      _Pragma("unroll") for(int d_=0;d_<2;++d_) _Pragma("unroll") for(int r=0;r<16;++r)o[d_][r]*=wsf[crow(r,hi)]; } }while(0)
  f32x16 pA0,pA1,pB0,pB1;
  int sl_prev=0,sl_cur=0,sl_next=SLOTB;
  #define ROT() do{sl_prev=sl_cur;sl_cur=sl_next;sl_next=(sl_next==(NSLOT-1)*SLOTB)?0:sl_next+SLOTB;}while(0)
  DMA_K(2,2*SLOTB);
  WAIT_BAR(3); if(FOX){ ctq=-ncs3[q0+wid*QBLK+r32]; }
  qkt(pA0,pA1,Kbase,qr,CINIT,r32,hi);asm volatile("s_nop 15\n\ts_nop 7":"+v"(pA0),"+v"(pA1));FBIAS(pA0,pA1,0);CMASK(pA0,pA1,0);
  START(pA0,pA1);
  _Pragma("unroll") for(int r=0;r<16;++r)pA1[r]=__builtin_amdgcn_exp2f(pA1[r]);
  WAIT_BAR(0);
  DMA_K(3,0);DMA_V(1,SLOTB);
  ROT();
  kload8(kf,kp0+sl_cur);
  WAIT_BAR(2);
  s16x4 vlo[8],vhi[8]; u32x4 pw0,pw1,pw2,pw3;
  #define PKW(P,B) cvtpk_s(P[B],P[B+1])
  #define PAF(k) __builtin_bit_cast(bf16x8,pw##k)
  #define VFR(i) (bf16x8){vlo[i][0],vlo[i][1],vlo[i][2],vlo[i][3],vhi[i][0],vhi[i][1],vhi[i][2],vhi[i][3]}
  #define PIN(x) asm volatile("":"+v"(x))
  #define MX3(a,b,c) __builtin_fmaxf(__builtin_fmaxf((a),(b)),(c))
  #define GAPA(MF,A0,A1,A2,A3,W0,W1,PW) do{ MF; sacc+=A0; sacc+=A1; sacc+=A2; sacc+=A3; PIN(sacc); W0; W1; PIN(PW); SBAR(); }while(0)
  #define EX(v) __builtin_amdgcn_exp2f(v)
  #define GAPB(MF,X,B) do{ MF; X[B]=EX(X[B]); X[B+1]=EX(X[B+1]); X[B+2]=EX(X[B+2]); X[B+3]=EX(X[B+3]); PIN(X); SBAR(); }while(0)
  #define VRD(i) do{ vlo[i]=vtr(vp_+(((i)>>2)*4096+((i)&3)*1024)); vhi[i]=vtr(vp_+(((i)>>2)*4096+((i)&3)*1024+512)); }while(0)
  #define KRD(G,j) do{ if(G){ kload2(kf,kp0+sl_next,j); SBAR(); } }while(0)
  #define STEP(C0,C1,P0,P1,t,GK,GV,GL) do{ SBAR(); \
    const lds_cptr vp_=vp0+sl_prev; \
    VRD(0); SBAR(); float sacc=(P0[0]+P0[1]); \
    GAPA(C0=__builtin_amdgcn_mfma_f32_32x32x16_bf16(kf[0],qr[0],CINIT,0,0,0), P0[2],P0[3],P0[4],P0[5],     pw0[0]=PKW(P0,0), pw0[1]=PKW(P0,2), pw0); \
    VRD(4); SBAR(); GAPA(C1=__builtin_amdgcn_mfma_f32_32x32x16_bf16(kf[1],qr[0],CINIT,0,0,0), P0[6],P0[7],P0[8],P0[9],     pw0[2]=PKW(P0,4), pw0[3]=PKW(P0,6), pw0); \
    VRD(1); SBAR(); GAPA(C0=__builtin_amdgcn_mfma_f32_32x32x16_bf16(kf[2],qr[1],C0,0,0,0),   P0[10],P0[11],P0[12],P0[13], pw1[0]=PKW(P0,8), pw1[1]=PKW(P0,10), pw1); \
    VRD(5); SBAR(); GAPA(C1=__builtin_amdgcn_mfma_f32_32x32x16_bf16(kf[3],qr[1],C1,0,0,0),   P0[14],P0[15],P1[0],P1[1],   pw1[2]=PKW(P0,12),pw1[3]=PKW(P0,14), pw1); \
    VRD(2); SBAR(); GAPA(C0=__builtin_amdgcn_mfma_f32_32x32x16_bf16(kf[4],qr[2],C0,0,0,0),   P1[2],P1[3],P1[4],P1[5],     pw2[0]=PKW(P1,0), pw2[1]=PKW(P1,2), pw2); \
    VRD(6); SBAR(); GAPA(C1=__builtin_amdgcn_mfma_f32_32x32x16_bf16(kf[5],qr[2],C1,0,0,0),   P1[6],P1[7],P1[8],P1[9],     pw2[2]=PKW(P1,4), pw2[3]=PKW(P1,6), pw2); \
    VRD(3); SBAR(); GAPA(C0=__builtin_amdgcn_mfma_f32_32x32x16_bf16(kf[6],qr[3],C0,0,0,0),   P1[10],P1[11],P1[12],P1[13], pw3[0]=PKW(P1,8), pw3[1]=PKW(P1,10), pw3); \
    VRD(7); SBAR(); GAPA(C1=__builtin_amdgcn_mfma_f32_32x32x16_bf16(kf[7],qr[3],C1,0,0,0),   P1[14],P1[15],0.f,0.f,       pw3[2]=PKW(P1,12),pw3[3]=PKW(P1,14), pw3); \
    l_reg+=sacc; \
    if(GK){DMA_K((t)+3,sl_cur);} if(GV){DMA_V((t)+1,sl_next);} \
    FBIAS(C0,C1,t); CMASK(C0,C1,t); \
    { float a=MX3(C0[0],C0[1],C1[0]),b=MX3(C0[2],C0[3],C1[1]); a=MX3(a,C1[2],C1[3]); \
      _Pragma("unroll") for(int r=4;r<16;r+=4){a=MX3(a,C0[r],C0[r+1]);b=MX3(b,C0[r+2],C0[r+3]);a=MX3(a,C1[r],C1[r+1]);b=MX3(b,C1[r+2],C1[r+3]);} \
      float rm=__builtin_fmaxf(a,b); if(NOMX){rm=0.f;} else { auto rr=__builtin_amdgcn_permlane32_swap(__float_as_uint(rm),__float_as_uint(rm),false,false); rm=__builtin_fmaxf(__uint_as_float(rr[0]),__uint_as_float(rr[1])); } \
      resc=false; \
      if(!NOMX&&__builtin_expect(__any(rm>(float)THRL),0)){ const float dl=__builtin_fmaxf(rm,0.f); mhat+=dl; \
        _Pragma("unroll") for(int r=0;r<16;++r){C0[r]-=dl;C1[r]-=dl;} \
        if(!FOX){ _Pragma("unroll") for(int r=0;r<16;++r)negm[r]=-mhat; asm volatile("":"+v"(negm)); } \
        const float f=__builtin_amdgcn_exp2f(-dl); l_reg*=f; if(hi==0)wsf[r32]=f; resc=true; } } \
    SBAR(); \
    GAPB(o[0]=__builtin_amdgcn_mfma_f32_32x32x16_bf16(PAF(0),VFR(0),o[0],0,0,0), C0,0); \
    GAPB(o[1]=__builtin_amdgcn_mfma_f32_32x32x16_bf16(PAF(0),VFR(4),o[1],0,0,0), C0,4); \
    KRD(GL,0); GAPB(o[0]=__builtin_amdgcn_mfma_f32_32x32x16_bf16(PAF(1),VFR(1),o[0],0,0,0), C0,8); \
    KRD(GL,1); GAPB(o[1]=__builtin_amdgcn_mfma_f32_32x32x16_bf16(PAF(1),VFR(5),o[1],0,0,0), C0,12); \
    KRD(GL,2); GAPB(o[0]=__builtin_amdgcn_mfma_f32_32x32x16_bf16(PAF(2),VFR(2),o[0],0,0,0), C1,0); \
    KRD(GL,3); GAPB(o[1]=__builtin_amdgcn_mfma_f32_32x32x16_bf16(PAF(2),VFR(6),o[1],0,0,0), C1,4); \
    GAPB(o[0]=__builtin_amdgcn_mfma_f32_32x32x16_bf16(PAF(3),VFR(3),o[0],0,0,0), C1,8); \
    GAPB(o[1]=__builtin_amdgcn_mfma_f32_32x32x16_bf16(PAF(3),VFR(7),o[1],0,0,0), C1,12); \
    }while(0)
  int t=1;
  #undef CMASK
  #define CMASK(P0,P1,t) do{}while(0)
  for(;t+5<NT;t+=2){
    STEP(pB0,pB1,pA0,pA1,t,true,true,true);     WAIT_BAR(2); RESC(); ROT();
    STEP(pA0,pA1,pB0,pB1,t+1,true,true,true);   WAIT_BAR(2); RESC(); ROT();
  }
  #undef CMASK
  #define CMASK(P0,P1,t) do{int jb_=(t)-(NT-4); if(jb_>=0)cmask(P0,P1,jb_,qrel,hi);}while(0)
  #define ENDW(tt) do{ if((tt)+3<NT){WAIT_BAR(2);} else if((tt)+2<NT){WAIT_BAR(1);} else {WAIT_BAR(0);} }while(0)
  for(;t+1<NT;t+=2){
    STEP(pB0,pB1,pA0,pA1,t,(t+3<NT),(t+1<NT),(t+1<NT));       ENDW(t);   RESC(); ROT();
    STEP(pA0,pA1,pB0,pB1,t+1,(t+4<NT),(t+2<NT),(t+2<NT));     ENDW(t+1); RESC(); ROT();
  }
  STEP(pB0,pB1,pA0,pA1,NT-1,false,false,false); RESC();
  { float sacc=pB0[0]+pB0[1]; _Pragma("unroll") for(int r=2;r<16;++r)sacc+=pB0[r]; _Pragma("unroll") for(int r=0;r<16;++r)sacc+=pB1[r]; l_reg+=sacc;
    pw0=(u32x4){PKW(pB0,0),PKW(pB0,2),PKW(pB0,4),PKW(pB0,6)};pw1=(u32x4){PKW(pB0,8),PKW(pB0,10),PKW(pB0,12),PKW(pB0,14)};pw2=(u32x4){PKW(pB1,0),PKW(pB1,2),PKW(pB1,4),PKW(pB1,6)};pw3=(u32x4){PKW(pB1,8),PKW(pB1,10),PKW(pB1,12),PKW(pB1,14)};
    SBAR(); pv(o,vb0+sl_cur,PAF(0),PAF(1),PAF(2),PAF(3)); }
  #undef PKW
  #undef PAF
  #undef VFR
  #undef PIN
  #undef MX3
  #undef GAPA
  #undef GAPB
  #undef EX
  #undef VRD
  #undef KRD
  #undef STEP
  #undef ENDW
  {auto rr=__builtin_amdgcn_permlane32_swap(__float_as_uint(l_reg),__float_as_uint(l_reg),false,false);l_reg=__uint_as_float(rr[0])+__uint_as_float(rr[1]);}
  if(hi==0)wsf[32+r32]=l_reg;asm volatile("s_waitcnt lgkmcnt(0)":::"memory");
  float rli[16];
  #pragma unroll
  for(int r=0;r<16;++r)rli[r]=__builtin_amdgcn_rcpf(wsf[32+crow(r,hi)]);
  bf16*Ow=O+(rowbase+q0+wid*QBLK)*PQ;
  { bf16*stg=(bf16*)(shm+LDS_OST)+wid*2048;
    #pragma unroll
    for(int r=0;r<16;++r){const int orow=crow(r,hi);
      #pragma unroll
      for(int d0=0;d0<2;++d0)stg[orow*64+d0*32+r32]=__float2bfloat16(o[d0][r]*rli[r]);}
    asm volatile("s_waitcnt lgkmcnt(0)":::"memory");
    #pragma unroll
    for(int i=0;i<4;++i){const int row=i*8+(lane>>3),ch=lane&7; const u32x4 v=*(const u32x4*)(stg+row*64+ch*8); ATTN_STORE16(Ow+(long)row*PQ+ch*8,v);} }
  asm volatile("s_waitcnt lgkmcnt(0)\n\ts_barrier":::"memory");
  #undef FBIAS
  #undef CINIT
  #undef DMA_K
  #undef DMA_V
  #undef CMASK
  #undef START
  #undef RESC
  #undef ROT
}
constexpr int XK=0, XV=16384, XWS=49152, XOST=51200, DV128_LDS_BYTES=XOST+NW*4096;
template<int THRL> __device__ __forceinline__ void attn_unit_dv128(int b,int qb,const bf16*Q,const bf16*__restrict__ K,const bf16*__restrict__ V,bf16*O,const float*nq,const float*nk,char*shm){
  int tid_=threadIdx.x; asm volatile("":"+v"(tid_)); const int tid=tid_,lane=tid&63,r32=lane&31,hi=lane>>5; const int wid=__builtin_amdgcn_readfirstlane(tid>>6);
  const long rowbase=(long)b*SEQ; const int q0=qb*QB;
  const bf16*Qw=Q+(rowbase+q0+wid*QBLK)*PQ;
  const bf16*Kh=K+rowbase*PQ,*Vh=V+rowbase*PQ;
  const unsigned lds0=(unsigned)(uintptr_t)shm;
  typedef __attribute__((address_space(3))) float* lds_fptr;
  const lds_fptr wsf=(lds_fptr)((__attribute__((address_space(3))) char*)shm+XWS)+wid*64;
  const bf16*ksrc=Kh+(long)lane*PQ+wid*8;
  const bf16*vsrc=Vh+(long)(16*(wid&3)+(lane>>2))*PQ+(wid>>2)*32+(lane&3)*8;
  const unsigned kdst=lds0+XK+wid*1024, vdst=lds0+XV+wid*1024;
  #define DMA_K(t,slot) glds16(ksrc+(long)(t)*KVBLK*PQ,(unsigned)__builtin_amdgcn_readfirstlane(kdst+(slot)*8192))
  #define DMA_V(t,slot) do{ glds16(vsrc+(long)(t)*KVBLK*PQ,(unsigned)__builtin_amdgcn_readfirstlane(vdst+(slot)*16384)); glds16(vsrc+64+(long)(t)*KVBLK*PQ,(unsigned)__builtin_amdgcn_readfirstlane(vdst+(slot)*16384+8192)); }while(0)
  const int vb0=(int)(lds0+XV)+((lane>>4)&1)*32+(lane&3)*8+(4*hi+((lane&15)>>2))*64;
  const int NT=(q0+QB)/KVBLK;
  const lds_cptr kp0=(lds_cptr)shm+XK+hi*1024+r32*16;
  const lds_cptr vp0=(lds_cptr)shm+XV+((lane>>4)&1)*32+(lane&3)*8+(4*hi+((lane&15)>>2))*64;
  DMA_K(0,0);
  bf16x8 qr[4];
  #pragma unroll
  for(int d0=0;d0<4;++d0)qr[d0]=*reinterpret_cast<const bf16x8*>(&Qw[(long)r32*PQ+d0*16+hi*8]);
  float mhat=0.f,l_reg=0.f; f32x16 o[4]; o[0]=f32x16{};o[1]=f32x16{};o[2]=f32x16{};o[3]=f32x16{}; f32x16 negm=f32x16{};
  const int qrel=wid*QBLK+r32;
  u32x4 pw0=u32x4{},pw1=u32x4{},pw2=u32x4{},pw3=u32x4{};
  #define MX3(a,b,c) __builtin_fmaxf(__builtin_fmaxf((a),(b)),(c))
  #define PKW(P,B) cvtpk_s(P[B],P[B+1])
  #define SBAR_() __builtin_amdgcn_sched_barrier(0)
  #define VLOAD(VP) do{ _Pragma("unroll") for(int i_=0;i_<8;++i_){ vlo[i_]=vtr((VP)+(i_>>2)*4096+(i_&3)*1024); vhi[i_]=vtr((VP)+(i_>>2)*4096+(i_&3)*1024+512); } }while(0)
  #define VFR_(i) (bf16x8){vlo[i][0],vlo[i][1],vlo[i][2],vlo[i][3],vhi[i][0],vhi[i][1],vhi[i][2],vhi[i][3]}
  #define PAF_(k) __builtin_bit_cast(bf16x8,pw##k)
  #define VMMA(OA,OB) do{ \
      OA=__builtin_amdgcn_mfma_f32_32x32x16_bf16(PAF_(0),VFR_(0),OA,0,0,0); OB=__builtin_amdgcn_mfma_f32_32x32x16_bf16(PAF_(0),VFR_(4),OB,0,0,0); \
      OA=__builtin_amdgcn_mfma_f32_32x32x16_bf16(PAF_(1),VFR_(1),OA,0,0,0); OB=__builtin_amdgcn_mfma_f32_32x32x16_bf16(PAF_(1),VFR_(5),OB,0,0,0); \
      OA=__builtin_amdgcn_mfma_f32_32x32x16_bf16(PAF_(2),VFR_(2),OA,0,0,0); OB=__builtin_amdgcn_mfma_f32_32x32x16_bf16(PAF_(2),VFR_(6),OB,0,0,0); \
      OA=__builtin_amdgcn_mfma_f32_32x32x16_bf16(PAF_(3),VFR_(3),OA,0,0,0); OB=__builtin_amdgcn_mfma_f32_32x32x16_bf16(PAF_(3),VFR_(7),OB,0,0,0); }while(0)
  #define DV_TILE(T,HASPV,MASKMODE,NOMAX) do{ const int t_=(T); \
    asm volatile("s_waitcnt vmcnt(0) lgkmcnt(0)\n\ts_barrier":::"memory");     \
    if(t_+1<NT){ DMA_K(t_+1,(t_+1)&1); } DMA_V(t_,t_&1); \
    f32x16 p0,p1; float f=1.f; bool resc=false; \
    { bf16x8 kf[8]; kload8(kf,kp0+(t_&1)*8192); SBAR_();                         \
      p0=__builtin_amdgcn_mfma_f32_32x32x16_bf16(kf[0],qr[0],negm,0,0,0); p1=__builtin_amdgcn_mfma_f32_32x32x16_bf16(kf[1],qr[0],negm,0,0,0); \
      p0=__builtin_amdgcn_mfma_f32_32x32x16_bf16(kf[2],qr[1],p0,0,0,0); p1=__builtin_amdgcn_mfma_f32_32x32x16_bf16(kf[3],qr[1],p1,0,0,0); \
      p0=__builtin_amdgcn_mfma_f32_32x32x16_bf16(kf[4],qr[2],p0,0,0,0); p1=__builtin_amdgcn_mfma_f32_32x32x16_bf16(kf[5],qr[2],p1,0,0,0); \
      p0=__builtin_amdgcn_mfma_f32_32x32x16_bf16(kf[6],qr[3],p0,0,0,0); p1=__builtin_amdgcn_mfma_f32_32x32x16_bf16(kf[7],qr[3],p1,0,0,0); } \
    if(MASKMODE==1){ cmask(p0,p1,t_-(NT-4),qrel,hi); } else if(MASKMODE==2){ const int jb=t_-(NT-4); if(jb>=0)cmask(p0,p1,jb,qrel,hi); } \
    if(!(NOMAX)){ \
    float rm; \
    { float a=MX3(p0[0],p0[1],p1[0]),bq=MX3(p0[2],p0[3],p1[1]); a=MX3(a,p1[2],p1[3]); \
      _Pragma("unroll") for(int r=4;r<16;r+=4){a=MX3(a,p0[r],p0[r+1]);bq=MX3(bq,p0[r+2],p0[r+3]);a=MX3(a,p1[r],p1[r+1]);bq=MX3(bq,p1[r+2],p1[r+3]);} \
      rm=__builtin_fmaxf(a,bq); float x0=rm,x1=rm; asm volatile("s_nop 1\n\tv_permlane32_swap_b32 %0, %1":"+v"(x0),"+v"(x1)); rm=__builtin_fmaxf(x0,x1); }     \
      \
    if(HASPV){ resc=__any(rm>(float)THRL); } \
    if(!(HASPV)||resc){ const float dl=(HASPV)?__builtin_fmaxf(rm,0.f):rm; mhat+=dl; f=__builtin_amdgcn_exp2f(-dl);     \
      _Pragma("unroll") for(int r=0;r<16;++r){p0[r]-=dl;p1[r]-=dl;negm[r]=-mhat;} } \
    } \
    { const lds_cptr vp=vp0+((t_-1)&1)*16384; float sacc=0.f;                    \
      s16x4 vlo[8],vhi[8]; \
      if(HASPV){ SBAR_(); VLOAD(vp); SBAR_(); } \
      _Pragma("unroll") for(int r=0;r<16;++r){ p0[r]=__builtin_amdgcn_exp2f(p0[r]); sacc+=p0[r]; } asm volatile("":"+v"(p0),"+v"(sacc));     \
      if(HASPV){ SBAR_(); VMMA(o[0],o[1]); SBAR_(); VLOAD(vp+8192); SBAR_(); } \
      _Pragma("unroll") for(int r=0;r<16;++r){ p1[r]=__builtin_amdgcn_exp2f(p1[r]); sacc+=p1[r]; } asm volatile("":"+v"(p1),"+v"(sacc)); \
      if(HASPV){ SBAR_(); VMMA(o[2],o[3]); SBAR_(); } \
      pw0=(u32x4){PKW(p0,0),PKW(p0,2),PKW(p0,4),PKW(p0,6)}; pw1=(u32x4){PKW(p0,8),PKW(p0,10),PKW(p0,12),PKW(p0,14)}; \
      pw2=(u32x4){PKW(p1,0),PKW(p1,2),PKW(p1,4),PKW(p1,6)}; pw3=(u32x4){PKW(p1,8),PKW(p1,10),PKW(p1,12),PKW(p1,14)}; \
      if(resc){ l_reg*=f; if(hi==0)wsf[r32]=f;                                   \
        asm volatile("s_waitcnt lgkmcnt(0)":::"memory"); \
        _Pragma("unroll") for(int r=0;r<16;++r){ const float fr_=wsf[crow(r,hi)]; o[0][r]*=fr_; o[1][r]*=fr_; o[2][r]*=fr_; o[3][r]*=fr_; } \
        asm volatile("s_waitcnt lgkmcnt(0)":::"memory"); } \
      l_reg+=sacc; } \
  }while(0)
  const float bqk_=1.05f*sqrtf((nq[0]+nq[1])*(nk[0]+nk[1]));
  if(bqk_<40.0f){
    DV_TILE(0,false,2,true);
    { int t=1;
      #pragma unroll 1
      for(;t<NT-4;++t){ DV_TILE(t,true,0,true); }
      #pragma unroll 1
      for(;t<NT;++t){ DV_TILE(t,true,1,true); } }
  } else {
    DV_TILE(0,false,2,false);
    { int t=1;
      #pragma unroll 1
      for(;t<NT-4;++t){ DV_TILE(t,true,0,false); }
      #pragma unroll 1
      for(;t<NT;++t){ DV_TILE(t,true,1,false); } }
  }
  asm volatile("s_waitcnt vmcnt(0) lgkmcnt(0)\n\ts_barrier":::"memory");
  { const lds_cptr vp=vp0+((NT-1)&1)*16384; s16x4 vlo[8],vhi[8]; VLOAD(vp); SBAR_(); VMMA(o[0],o[1]); SBAR_(); VLOAD(vp+8192); SBAR_(); VMMA(o[2],o[3]); }
  #undef DV_TILE
  #undef VLOAD
  #undef VFR_
  #undef PAF_
  #undef VMMA
  #undef SBAR_
  #undef MX3
  #undef PKW
  {float x0=l_reg,x1=l_reg; asm volatile("s_nop 1\n\tv_permlane32_swap_b32 %0, %1":"+v"(x0),"+v"(x1)); l_reg=x0+x1;}
  if(hi==0)wsf[32+r32]=l_reg; asm volatile("s_waitcnt lgkmcnt(0)":::"memory");
  float rli[16];
  #pragma unroll
  for(int r=0;r<16;++r)rli[r]=__builtin_amdgcn_rcpf(wsf[32+crow(r,hi)]);
  bf16*Ow=O+(rowbase+q0+wid*QBLK)*PQ;
  bf16*stg=(bf16*)(shm+XOST)+wid*2048;
  #pragma unroll
  for(int hf=0;hf<2;++hf){
    #pragma unroll
    for(int r=0;r<16;++r){const int orow=crow(r,hi);
      #pragma unroll
      for(int d0=0;d0<2;++d0)stg[orow*64+d0*32+r32]=__float2bfloat16(o[2*hf+d0][r]*rli[r]);}
    asm volatile("s_waitcnt lgkmcnt(0)":::"memory");
    #pragma unroll
    for(int i=0;i<4;++i){const int row=i*8+(lane>>3),ch=lane&7; const u32x4 v=*(const u32x4*)(stg+row*64+ch*8); *(u32x4*)(Ow+(long)row*PQ+hf*64+ch*8)=v;}
    asm volatile("s_waitcnt lgkmcnt(0)":::"memory"); }
  asm volatile("s_waitcnt lgkmcnt(0)\n\ts_barrier":::"memory");
  #undef DMA_K
  #undef DMA_V
}
constexpr int ATTN_LDS_BYTES=LDS_BYTES;
#undef SBAR
#undef WAIT_BAR
}
#include <hip/hip_cooperative_groups.h>
namespace cg = cooperative_groups;
#ifndef MK_LAUNCH_PER_PHASE
#define MK_LAUNCH_PER_PHASE 0
#endif
constexpr int NWAVES = 8;
constexpr int SEQ = 16384, DMODEL = 1024, M = 2 * SEQ, DFF = 2816, INC = 3080, NQKV = 3072, PQ = 3584, NPHASE = 16;
constexpr size_t MiB = 1u << 20;
constexpr size_t WS_CTL = 0  , CTL_ZERO_BYTES = 65536;
constexpr int MISC_OFF = 153600;
constexpr size_t WS_COS = 2 * MiB, WS_SIN = 4 * MiB, WS_LC = 7 * MiB, WS_CT = 8 * MiB, WS_SS = 10 * MiB  , WS_W = 24 * MiB  , WS_XB = 108 * MiB  ,
                 WS_BIG = 172 * MiB, WS_H = WS_BIG  , WS_QKV = WS_BIG  , WS_END = 396 * MiB;
constexpr size_t WL_GU1 = 0, WL_D1 = 11 * MiB, WL_WIN = 11 * MiB + 5632 * 1024, WL_WOUT = WL_WIN + 6 * MiB, WL_GU2 = WL_WOUT + 2 * MiB, WL_D2 = WL_GU2 + 11 * MiB, WL_LAYER = 41 * MiB;
static_assert(WL_D2 + 5632 * 1024 == WL_LAYER, "weight map");
constexpr int LDS_BYTES = 155648;
#define LAS __attribute__((address_space(3)))
typedef unsigned short bf16;
typedef unsigned v4u __attribute__((ext_vector_type(4)));
typedef float f32x4 __attribute__((ext_vector_type(4)));
#define LDS_WAIT() asm volatile("s_waitcnt lgkmcnt(0)" ::: "memory")
__device__ __forceinline__ float wave_sum(float v) { return wave_sum_u(v); }
__device__ __forceinline__ int std8(int o) { return 16 * ((o >> 2) & 1) + 4 * (o >> 3) + (o & 3); }
__device__ __forceinline__ int rowmap(int mode, int nn) {
    if (mode == 0) return (nn & ~31) + std8(nn & 31);
    if (mode == 1) { const int bj = nn >= DFF ? 1 : 0, i = nn - DFF * bj, ip = i & 127; return 256 * (i >> 7) + 128 * bj + (ip & ~31) + std8(ip & 31); }
    const int d = nn & 63; return (nn & ~63) + 32 * ((d >> 4) & 1) + 16 * (d >> 5) + 4 * ((d >> 2) & 3) + (d & 3);
}
__device__ __forceinline__ void conv_item(const float* W, int ldw, int coff, int K, int nblk, const float* gain, bf16* WT, int mode, int base, LAS float* scr, int item, int lane) {
    const int kb = item / nblk, nb = item % nblk, k0 = 64 * kb, n0 = 32 * nb;
    { float wv[32]; const float* wp = W + (size_t)(k0 + (lane >> 5)) * ldw + coff + n0 + (lane & 31);
#pragma unroll
      for (int i = 0; i < 32; ++i) wv[i] = wp[(size_t)(2 * i) * ldw];
      if (gain) {
#pragma unroll
          for (int i = 0; i < 32; ++i) wv[i] *= gain[k0 + 2 * i + (lane >> 5)]; }
#pragma unroll
      for (int i = 0; i < 32; ++i) scr[(2 * i + (lane >> 5)) * 33 + (lane & 31)] = wv[i]; }
    LDS_WAIT(); asm volatile("" ::: "memory");
    const int c = lane & 7;
#pragma unroll
    for (int j = 0; j < 4; ++j) { const int n = (lane >> 3) + 8 * j; const LAS float* s = scr + (8 * c) * 33 + n;
        v4u o; o.x = pg8::cvt_pk_bf16(s[0 * 33], s[1 * 33]); o.y = pg8::cvt_pk_bf16(s[2 * 33], s[3 * 33]); o.z = pg8::cvt_pk_bf16(s[4 * 33], s[5 * 33]); o.w = pg8::cvt_pk_bf16(s[6 * 33], s[7 * 33]);
        *(v4u*)(WT + (size_t)(base + rowmap(mode, n0 + n)) * K + k0 + 8 * c) = o; }
    LDS_WAIT(); asm volatile("" ::: "memory");
}
#define XB_TMO      128
#define XB_XCNT(j)  (256  + 64 * (j))
#define XB_XSUB(j)  (1280 + 64 * (j))
#define XB_XGEN(j)  (2304 + 64 * (j))
#define XB_TOP      3328
#define XB_TOPGEN   3392
#define XCD_BAR_WORDS 3456
#define XB_SPIN_CAP (1u << 18)

__device__ __forceinline__ unsigned xb_ld(unsigned* p)              { return __hip_atomic_load(p, __ATOMIC_RELAXED, __HIP_MEMORY_SCOPE_AGENT); }
__device__ __forceinline__ unsigned xb_add(unsigned* p, unsigned v) { return __hip_atomic_fetch_add(p, v, __ATOMIC_RELAXED, __HIP_MEMORY_SCOPE_AGENT); }
__device__ __forceinline__ unsigned xb_xcc_id() { return (unsigned)__builtin_amdgcn_s_getreg((3 << 11) | 20) & 0xFu; }
#define XB_SPIN(cond, bar) do { unsigned _sp = 0; while (cond) { __builtin_amdgcn_s_sleep(1); \
    if ((++_sp & 255u) == 0u) { if (xb_ld(&(bar)[XB_TMO])) break; if (_sp > XB_SPIN_CAP) { atomicAdd(&(bar)[XB_TMO], 1u); break; } } } } while (0)

struct XcdBarrier {
    unsigned* bar; unsigned x;
    volatile LAS unsigned* st;
};

__device__ __forceinline__ XcdBarrier xcd_barrier_post(unsigned* bar, volatile LAS unsigned* st) {
    XcdBarrier b; b.bar = bar; b.x = xb_xcc_id(); b.st = st;
    if (threadIdx.x == 0) (void)xb_add(&bar[XB_XCNT(b.x)], 1u);
    return b;
}
__device__ __forceinline__ void xcd_barrier_complete(unsigned* bar, unsigned x, unsigned& nloc, unsigned& nx) {
    const unsigned G = gridDim.x * gridDim.y * gridDim.z;
    unsigned sum, cnt, mine, sp = 0u;
    for (;;) {
        sum = 0u; cnt = 0u; mine = 0u;
#pragma unroll
        for (unsigned j = 0; j < 16; ++j) { const unsigned c = xb_ld(&bar[XB_XCNT(j)]); sum += c; cnt += (c > 0u) ? 1u : 0u; mine = (j == x) ? c : mine; }
        if (sum == G) break;
        __builtin_amdgcn_s_sleep(1);
        if ((++sp & 255u) == 0u) { if (xb_ld(&bar[XB_TMO])) break; if (sp > XB_SPIN_CAP) { atomicAdd(&bar[XB_TMO], 1u); break; } }
    }
    nloc = mine > 0u ? mine : 1u; nx = cnt > 0u ? cnt : 1u;
}

__device__ __forceinline__ void xcd_barrier(const XcdBarrier& b) {
    asm volatile("s_waitcnt vmcnt(0)" ::: "memory");
    __syncthreads();
    if (threadIdx.x == 0) {
        unsigned* bar = b.bar;
        __builtin_amdgcn_s_waitcnt(0);
        unsigned nloc = b.st[0], nx = b.st[1];
        if (nloc == 0u) { xcd_barrier_complete(bar, b.x, nloc, nx); b.st[0] = nloc; b.st[1] = nx; }
        const unsigned old = xb_add(&bar[XB_XSUB(b.x)], 1u);
        const unsigned gen = old / nloc;
        if (old + 1u == (gen + 1u) * nloc) {
            __builtin_amdgcn_fence(__ATOMIC_RELEASE, "agent");
            asm volatile("s_waitcnt vmcnt(0)" ::: "memory");
            const unsigned og = xb_add(&bar[XB_TOP], 1u);
            const unsigned tg = og / nx;
            if (og + 1u == (tg + 1u) * nx) xb_add(&bar[XB_TOPGEN], 1u);
            else XB_SPIN(xb_ld(&bar[XB_TOPGEN]) == tg, bar);
            __builtin_amdgcn_fence(__ATOMIC_ACQUIRE, "agent");
            xb_add(&bar[XB_XGEN(b.x)], 1u);
            asm volatile("s_waitcnt vmcnt(0)" ::: "memory");
        } else {
            XB_SPIN(xb_ld(&bar[XB_XGEN(b.x)]) == gen, bar);
            __builtin_amdgcn_fence(__ATOMIC_ACQUIRE, "agent");
            asm volatile("s_waitcnt vmcnt(0)" ::: "memory");
        }
    }
    __syncthreads();
}

struct Args { const float* in[17]; float* out; unsigned char* ws; int ph_lo, ph_hi; };
#define GAS1 __attribute__((address_space(1)))
#define KAS4 __attribute__((address_space(4)))
__device__ __forceinline__ const float* karg_in(int i) { size_t off = 8u * (unsigned)i; asm volatile("" : "+s"(off)); return (const float*)*(const GAS1 float* const KAS4*)((const char KAS4*)__builtin_amdgcn_kernarg_segment_ptr() + off); }
__device__ __forceinline__ float* karg_out() { size_t off = 8u * 17u; asm volatile("" : "+s"(off)); return (float*)*(GAS1 float* const KAS4*)((const char KAS4*)__builtin_amdgcn_kernarg_segment_ptr() + off); }
__device__ __forceinline__ unsigned char* karg_ws() { size_t off = 8u * 18u; asm volatile("" : "+s"(off)); return (unsigned char*)*(GAS1 unsigned char* const KAS4*)((const char KAS4*)__builtin_amdgcn_kernarg_segment_ptr() + off); }
static_assert(offsetof(Args, out) == 8 * 17 && offsetof(Args, ws) == 8 * 18, "kernarg layout");
enum { I_X = 0, I_N1 = 1, I_GU1 = 2, I_D1 = 3, I_NM = 4, I_WIN = 5, I_FB = 6, I_LQ1 = 7, I_LK1 = 8, I_LQ2 = 9, I_LK2 = 10, I_SUB = 11, I_WOUT = 12, I_N2 = 13, I_GU2 = 14, I_D2 = 15, I_NF = 16 };

__device__ __forceinline__ void prologue(LAS unsigned char* lds, int vcu, int G, int tid, int lane, int wave) {
    unsigned char* ws = karg_ws();
    LAS float* scr = (LAS float*)(lds + wave * 16384);
    const int gw = vcu * NWAVES + wave, NGW = G * NWAVES;
    constexpr int J0 = 2816, J1 = 1408, J2 = 768, J3 = 256, J6 = 512, PER_LAYER = 2 * J0 + 2 * J1 + J2 + 3 * J3 + J6;
    for (int it = gw; it < 2 * PER_LAYER; it += NGW) {
        const int l = it / PER_LAYER; int r = it - l * PER_LAYER;
        bf16* wl = (bf16*)(ws + WS_W + (size_t)l * WL_LAYER);
        const float* gu1 = karg_in(I_GU1) + (size_t)l * DMODEL * 2 * DFF; const float* gu2 = karg_in(I_GU2) + (size_t)l * DMODEL * 2 * DFF;
        const float* d1 = karg_in(I_D1) + (size_t)l * DFF * DMODEL; const float* d2 = karg_in(I_D2) + (size_t)l * DFF * DMODEL;
        const float* win = karg_in(I_WIN) + (size_t)l * DMODEL * INC; const float* wout = karg_in(I_WOUT) + (size_t)l * DMODEL * DMODEL;
        const float* n1 = karg_in(I_N1) + l * DMODEL; const float* nm = karg_in(I_NM) + l * DMODEL; const float* n2 = karg_in(I_N2) + l * DMODEL;
        bf16* wwin = (bf16*)((unsigned char*)wl + WL_WIN);
        if (r < J0) { conv_item(gu1, 2 * DFF, 0, DMODEL, 2 * DFF / 32, n1, (bf16*)((unsigned char*)wl + WL_GU1), 1, 0, scr, r, lane); continue; } r -= J0;
        if (r < J1) { conv_item(d1, DMODEL, 0, DFF, DMODEL / 32, nullptr, (bf16*)((unsigned char*)wl + WL_D1), 0, 0, scr, r, lane); continue; } r -= J1;
        if (r < J2) { conv_item(win, INC, 0, DMODEL, 1536 / 32, nm, wwin, 0, 0, scr, r, lane); continue; } r -= J2;
        if (r < J3) { conv_item(win, INC, 1544, DMODEL, 512 / 32, nm, wwin, 2, 1536, scr, r, lane); continue; } r -= J3;
        if (r < J3) { conv_item(win, INC, 2056, DMODEL, 512 / 32, nm, wwin, 2, 2048, scr, r, lane); continue; } r -= J3;
        if (r < J3) { conv_item(win, INC, 2568, DMODEL, 512 / 32, nm, wwin, 0, 2560, scr, r, lane); continue; } r -= J3;
        if (r < J6) { conv_item(wout, DMODEL, 0, DMODEL, DMODEL / 32, nullptr, (bf16*)((unsigned char*)wl + WL_WOUT), 0, 0, scr, r, lane); continue; } r -= J6;
        if (r < J0) { conv_item(gu2, 2 * DFF, 0, DMODEL, 2 * DFF / 32, n2, (bf16*)((unsigned char*)wl + WL_GU2), 1, 0, scr, r, lane); continue; } r -= J0;
        conv_item(d2, DMODEL, 0, DFF, DMODEL / 32, nullptr, (bf16*)((unsigned char*)wl + WL_D2), 0, 0, scr, r, lane);
    }
    const float* x = karg_in(I_X); bf16* XB = (bf16*)(ws + WS_XB); float* ss0 = (float*)(ws + WS_SS);
    for (int m0 = 2 * gw; m0 < M; m0 += 2 * NGW) {
        f32x4 v[2][4];
#pragma unroll
        for (int r = 0; r < 2; ++r)
#pragma unroll
            for (int j = 0; j < 4; ++j) v[r][j] = ((const f32x4*)(x + (size_t)(m0 + r) * DMODEL) + lane)[64 * j];
#pragma unroll
        for (int r = 0; r < 2; ++r) { const int m = m0 + r; float s = 0.f;
#pragma unroll
            for (int j = 0; j < 4; ++j) s += (v[r][j][0] * v[r][j][0] + v[r][j][1] * v[r][j][1]) + (v[r][j][2] * v[r][j][2] + v[r][j][3] * v[r][j][3]);
            s = wave_sum(s);
            unsigned long long* o8 = (unsigned long long*)(XB + (size_t)m * DMODEL) + lane;
#pragma unroll
            for (int j = 0; j < 4; ++j) o8[64 * j] = (unsigned long long)pg8::cvt_pk_bf16(v[r][j][0], v[r][j][1]) | ((unsigned long long)pg8::cvt_pk_bf16(v[r][j][2], v[r][j][3]) << 32);
            if (lane < 16) ss0[(size_t)m * 16 + lane] = lane == 0 ? s : 0.f; }
    }
    float* cosT = (float*)(ws + WS_COS); float* sinT = (float*)(ws + WS_SIN);
    for (int i = vcu * NWAVES * 64 + tid; i < SEQ * 32; i += G * NWAVES * 64) {
        const int pos = i >> 5, d = i & 31; const float inv = 1.0f / powf(10000.0f, (float)d * (1.0f / 32.0f)); const float ang = (float)pos * inv;
        cosT[i] = cosf(ang); sinT[i] = sinf(ang);
    }
}
__device__ __forceinline__ void ff_chunk(int chunk, const bf16* XB, const float* ss, const float* win_l, const float* gain, const float* fbias, float* LC, float* CT, LAS float* sl, int tid, int lane, int wave) {
#pragma unroll 1
    for (int hp = 0; hp < 2; ++hp) {
        float w[16][4];
#pragma unroll
        for (int i = 0; i < 16; ++i) { const int k = (i < 8) ? 8 * lane + i : 512 + 8 * lane + (i - 8); const float g = gain[k];
            const f32x4 a = *(const f32x4*)(win_l + (size_t)k * INC + 1536 + 4 * hp);
            w[i][0] = a[0] * g; w[i][1] = a[1] * g; w[i][2] = a[2] * g; w[i][3] = a[3] * g; }
        const float fb = fbias[4 * hp + (lane & 3)];
#pragma unroll 1
        for (int rr0 = 0; rr0 < 16; rr0 += 4) {
          v4u xav[4], xbv[4]; float ssv[4];
#pragma unroll
          for (int r4 = 0; r4 < 4; ++r4) { const size_t row_ = (size_t)(chunk * 128 + wave * 16 + rr0 + r4);
              xav[r4] = *(const v4u*)(XB + row_ * DMODEL + 8 * lane); xbv[r4] = *(const v4u*)(XB + row_ * DMODEL + 512 + 8 * lane); ssv[r4] = ss[row_ * 16 + (lane & 15)]; }
#pragma unroll
          for (int r4 = 0; r4 < 4; ++r4) {
            const int rr = rr0 + r4;
            const v4u xa = xav[r4], xb = xbv[r4];
            float xs[16];
            xs[0] = __uint_as_float(xa.x << 16); xs[1] = __uint_as_float(xa.x & 0xffff0000u); xs[2] = __uint_as_float(xa.y << 16); xs[3] = __uint_as_float(xa.y & 0xffff0000u);
            xs[4] = __uint_as_float(xa.z << 16); xs[5] = __uint_as_float(xa.z & 0xffff0000u); xs[6] = __uint_as_float(xa.w << 16); xs[7] = __uint_as_float(xa.w & 0xffff0000u);
            xs[8] = __uint_as_float(xb.x << 16); xs[9] = __uint_as_float(xb.x & 0xffff0000u); xs[10] = __uint_as_float(xb.y << 16); xs[11] = __uint_as_float(xb.y & 0xffff0000u);
            xs[12] = __uint_as_float(xb.z << 16); xs[13] = __uint_as_float(xb.z & 0xffff0000u); xs[14] = __uint_as_float(xb.w << 16); xs[15] = __uint_as_float(xb.w & 0xffff0000u);
            float a[4];
#pragma unroll
            for (int h = 0; h < 4; ++h) { float s = 0.f;
#pragma unroll
                for (int i = 0; i < 16; ++i) s += xs[i] * w[i][h];
                a[h] = wave_sum(s); }
            const float q = wave_sum(ssv[r4]) * 0.25f;
            const float rstd = __builtin_amdgcn_rsqf(q * (1.0f / 1024.0f) + 1e-5f);
            const int hh = lane & 3;
            float mine = a[0]; mine = hh == 1 ? a[1] : mine; mine = hh == 2 ? a[2] : mine; mine = hh == 3 ? a[3] : mine;
            const float z = mine * rstd + fb;
            const float lf = fminf(z, 0.f) - log1pf(expf(-fabsf(z)));
            if (lane < 4) sl[(wave * 16 + rr) * 8 + 4 * hp + lane] = lf;
          }
        }
    }
    __syncthreads();
    if (tid < 8) { float c = 0.f; for (int r = 0; r < 128; ++r) { c += sl[r * 8 + tid]; sl[r * 8 + tid] = c; } }
    __syncthreads();
    for (int i = tid; i < 1024; i += NWAVES * 64) { const int h = i >> 7, r = i & 127, row = chunk * 128 + r, b = row >> 14, s = row & 16383; const float v = sl[r * 8 + h];
        LC[((size_t)(b * 8 + h) << 14) + s] = v; if (r == 127) CT[(b * 8 + h) * 128 + (s >> 7)] = v; }
    __syncthreads();
}
__device__ __forceinline__ void diff_combine(int b, int qb, int h, bf16* QKV, float lam, int layer, const float* subln) {
    int tid = threadIdx.x; asm volatile("s_waitcnt vmcnt(0)" : "+v"(tid) :: "memory"); const int lane = tid & 63, wave = __builtin_amdgcn_readfirstlane(tid >> 6);
    int lo_ = layer; asm volatile("" : "+s"(lo_)); const float oscale = lo_ == 0 ? 0.8f : 0.64449094f;
    __builtin_amdgcn_fence(__ATOMIC_ACQUIRE, "agent");
    const size_t row0 = (size_t)b * SEQ + (size_t)qb * 256 + wave * 32; const int ch = lane & 15;
    const f32x4 g0 = *(const f32x4*)(subln + ch * 8) * oscale, g1 = *(const f32x4*)(subln + ch * 8 + 4) * oscale;
#pragma unroll 4
    for (int p = 0; p < 8; ++p) { const size_t row = row0 + p * 4 + (lane >> 4);
        const bf16* pa = QKV + row * PQ + 3072 + h * 128 + ch * 8; bf16* pq = QKV + row * PQ + 512 + h * 128 + ch * 8;
        const v4u a = *(const v4u*)pa, q = *(const v4u*)pq;
        f32x4 d0, d1;
        d0[0] = __uint_as_float(a.x << 16) - lam * __uint_as_float(q.x << 16); d0[1] = __uint_as_float(a.x & 0xffff0000u) - lam * __uint_as_float(q.x & 0xffff0000u);
        d0[2] = __uint_as_float(a.y << 16) - lam * __uint_as_float(q.y << 16); d0[3] = __uint_as_float(a.y & 0xffff0000u) - lam * __uint_as_float(q.y & 0xffff0000u);
        d1[0] = __uint_as_float(a.z << 16) - lam * __uint_as_float(q.z << 16); d1[1] = __uint_as_float(a.z & 0xffff0000u) - lam * __uint_as_float(q.z & 0xffff0000u);
        d1[2] = __uint_as_float(a.w << 16) - lam * __uint_as_float(q.w << 16); d1[3] = __uint_as_float(a.w & 0xffff0000u) - lam * __uint_as_float(q.w & 0xffff0000u);
        float s = (d0[0] * d0[0] + d0[1] * d0[1]) + (d0[2] * d0[2] + d0[3] * d0[3]) + (d1[0] * d1[0] + d1[1] * d1[1]) + (d1[2] * d1[2] + d1[3] * d1[3]);
        s = row16_sum(s);
        const float r = __builtin_amdgcn_rsqf(s * (1.0f / 128.0f) + 1e-5f);
        d0 = d0 * r * g0; d1 = d1 * r * g1;
        v4u o; o.x = pg8::cvt_pk_bf16(d0[0], d0[1]); o.y = pg8::cvt_pk_bf16(d0[2], d0[3]); o.z = pg8::cvt_pk_bf16(d1[0], d1[1]); o.w = pg8::cvt_pk_bf16(d1[2], d1[3]);
        *(v4u*)pq = o; }
}

__global__ void __launch_bounds__(NWAVES * 64, 2) mega_fwd(Args args) {
    extern __shared__ __attribute__((aligned(16))) unsigned char lds[];
    LAS unsigned char* ldsl = (LAS unsigned char*)lds;
#define OPQ_TID() int tid = threadIdx.x; asm volatile("" : "+v"(tid)); const int lane = tid & 63, wave = __builtin_amdgcn_readfirstlane(tid >> 6)
#define UNI() int G = gridDim.x, bx = blockIdx.x; asm volatile("" : "+s"(G), "+s"(bx)); const int vcu = (G % 8 == 0) ? (bx % 8) * (G / 8) + bx / 8 : bx; (void)vcu
    cg::grid_group grid = cg::this_grid();
    if (threadIdx.x < 2) ((volatile LAS unsigned*)(ldsl + MISC_OFF))[threadIdx.x] = 0u;
    __syncthreads();
    XcdBarrier xbar = xcd_barrier_post((unsigned*)(karg_ws() + WS_CTL) + 1024, (volatile LAS unsigned*)(ldsl + MISC_OFF));
#define PTRS() UNI(); unsigned char* ws = karg_ws();     bf16* XB = (bf16*)(ws + WS_XB); bf16* HB = (bf16*)(ws + WS_H); bf16* QKV = (bf16*)(ws + WS_QKV); \
    float* LC = (float*)(ws + WS_LC); float* CT = (float*)(ws + WS_CT); float* SS = (float*)(ws + WS_SS); const float* cosT = (const float*)(ws + WS_COS); const float* sinT = (const float*)(ws + WS_SIN); \
    const unsigned char* wl = ws + WS_W + (size_t)l * WL_LAYER; float* ssl = SS + (size_t)(3 * l) * M * 16; \
    (void)XB; (void)HB; (void)QKV; (void)LC; (void)CT; (void)cosT; (void)sinT; (void)wl; (void)ssl
#ifndef PROBE
#define PROBE 0
#endif
#ifndef PHMASK
#define PHMASK 0x1ff
#endif
#define EN(kind) (((PHMASK) >> (kind)) & 1)
#define IN(k) true
#define SEAM(k) do { if (IN(k) && IN((k) + 1)) { if ((k) == 0) grid.sync(); else xcd_barrier(xbar); } } while (0)
    for (int rp = 0; rp < (PROBE == 1 ? 2 : 1); ++rp)
    if (EN(0) && IN(0)) { UNI(); OPQ_TID(); prologue(ldsl, vcu, G, tid, lane, wave); __syncthreads(); if (PROBE == 1) grid.sync(); }
    if (PROBE == 5) for (int rp = 0; rp < 20; ++rp) grid.sync();
    SEAM(0);
#pragma unroll 1
    for (int l = 0; l < 2; ++l) {
        const int p0 = 1 + 7 * l;
        for (int rp = 0; rp < ((PROBE == 2 && l == 0) ? 3 : 1); ++rp)
        if (EN(1) && IN(p0 + 0)) { PTRS();
            if (PROBE == 2 && rp) grid.sync();
            pg8::Gemm g{XB, (const bf16*)(wl + WL_GU1), M, 2 * DFF, DMODEL, DMODEL}; pg8::StaticOrder S; S.init(M, 2 * DFF, G, bx);
            pg8::EpiSwiGLU E{HB, ssl, DFF};
            pg8::rstd_cache_reset();
            pg8::gemm_phase<pg8::EpiSwiGLU, pg8::StaticOrder, true, true>(ldsl, g, S, E);
        }
        SEAM(p0 + 0);
        if (EN(2) && IN(p0 + 1)) { PTRS();
            pg8::Gemm g{HB, (const bf16*)(wl + WL_D1), M, DMODEL, DFF, DFF}; pg8::StaticOrder S; S.init(M, DMODEL, G, bx);
            pg8::EpiResidual E{l == 0 ? karg_in(I_X) : (const float*)nullptr, XB, (float*)nullptr, XB, ssl + (size_t)1 * M * 16, 0.5f};
            pg8::gemm_phase<pg8::EpiResidual, pg8::StaticOrder, true, true>(ldsl, g, S, E);
        }
        SEAM(p0 + 1);
        for (int rp = 0; rp < (((PROBE == 3 || PROBE == 4) && l == 0) ? 2 : 1); ++rp) {
        if ((PROBE == 3 || PROBE == 4) && rp) grid.sync();
        if (EN(3) && IN(p0 + 2)) { PTRS();
            const float* ssi = ssl + (size_t)1 * M * 16;
            { OPQ_TID();
            for (int chunk = vcu; chunk < M / 128; chunk += G)
                ff_chunk(chunk, XB, ssi, karg_in(I_WIN) + (size_t)l * DMODEL * INC, karg_in(I_NM) + l * DMODEL, karg_in(I_FB) + l * 8, LC, CT, (LAS float*)ldsl, tid, lane, wave); }
            pg8::Gemm g{XB, (const bf16*)(wl + WL_WIN), M, NQKV, DMODEL, DMODEL}; pg8::StaticOrder S; S.init(M, NQKV, G, bx);
            pg8::EpiQKV E{QKV, ssi, cosT, sinT, attn_body::C2, (unsigned*)(ws + WS_CTL + 32768) + l * 128};
            pg8::rstd_cache_reset();
            pg8::gemm_phase<pg8::EpiQKV, pg8::StaticOrder, true, true>(ldsl, g, S, E);
        }
        SEAM(p0 + 2);
        if (EN(4) && IN(p0 + 3)) { PTRS();
            const float lam_init = (l == 0) ? 0.2f : 0.35550906f;
            float lam;
            { OPQ_TID(); (void)wave;
              const float p1 = wave_sum(karg_in(I_LQ1)[l * 64 + lane] * karg_in(I_LK1)[l * 64 + lane]), p2 = wave_sum(karg_in(I_LQ2)[l * 64 + lane] * karg_in(I_LK2)[l * 64 + lane]);
              lam = __int_as_float(__builtin_amdgcn_readfirstlane(__float_as_int(expf(p1) - expf(p2) + lam_init))); }
            const attn_body::bf16* Qb = (const attn_body::bf16*)QKV; attn_body::bf16* Qw = (attn_body::bf16*)QKV;
            for (int v = vcu; v < 256; v += G) {
                { const int bh = v >> 5, b = bh >> 2, h = bh & 3, sp = v & 31;
#pragma unroll 1
                  for (int j = 0; j < 4; ++j) { const int qb = (j & 1) ? sp : 63 - sp, c = j >> 1;
                      const float* nrm = (const float*)(ws + WS_CTL + 32768) + l * 128;
                      attn_body::attn_unit_dv128<8>(b, qb, Qb + 512 + (h * 2 + c) * 64, Qb + 2048 + (h * 2 + c) * 64, Qb + 2560 + h * 128, (c == 0) ? Qw + 3072 + h * 128 : Qw + 512 + h * 128,
                                                    nrm + ((2 * 2 + b) * 8 + h * 2 + c) * 2, nrm + ((3 * 2 + b) * 8 + h * 2 + c) * 2, (char*)lds); }
#pragma unroll 1
                  for (int j = 0; j < 2; ++j) diff_combine(b, j ? sp : 63 - sp, h, QKV, lam, l, karg_in(I_SUB) + l * 128); }
            }
            {
                const float* nrm = (const float*)(ws + WS_CTL + 32768) + l * 128; unsigned* qctr = (unsigned*)(ws + WS_CTL + 40960) + l * 64 + (PROBE == 3 ? rp * 16 : 0);
                volatile LAS unsigned* qw = (volatile LAS unsigned*)(ldsl + MISC_OFF + 16);
#pragma unroll 1
                for (;;) {
                    if (threadIdx.x == 0) qw[0] = atomicAdd(qctr, 1u);
                    __syncthreads();
                    const int idx = __builtin_amdgcn_readfirstlane((int)qw[0]);
                    if (idx >= 1024) break;
                    const int qb = 63 - (idx >> 4), bh = idx & 15, b = bh >> 3, h = bh & 7;
                    const float* nq_ = nrm + ((0 * 2 + b) * 8 + h) * 2; const float* nk_ = nrm + ((1 * 2 + b) * 8 + h) * 2;
                    const bool nomx = 1.05f * sqrtf((nq_[0] + nq_[1]) * (nk_[0] + nk_[1])) < 40.0f;
                    if (nomx) attn_body::attn_unit<8, true, true>(b, qb, Qb + h * 64, Qb + 1024 + h * 64, Qb + 1536 + h * 64, Qw + h * 64, LC + ((size_t)(b * 8 + h) << 14), CT + (b * 8 + h) * 128, nq_, nk_, (char*)lds);
                    else      attn_body::attn_unit<8, true, false>(b, qb, Qb + h * 64, Qb + 1024 + h * 64, Qb + 1536 + h * 64, Qw + h * 64, LC + ((size_t)(b * 8 + h) << 14), CT + (b * 8 + h) * 128, nq_, nk_, (char*)lds); }
            }
        }
        }
        SEAM(p0 + 3);
        if (EN(5) && IN(p0 + 4)) { PTRS();
            pg8::Gemm g{QKV, (const bf16*)(wl + WL_WOUT), M, DMODEL, DMODEL, PQ}; pg8::StaticOrder S; S.init(M, DMODEL, G, bx);
            pg8::EpiResidual E{(const float*)nullptr, XB, (float*)nullptr, XB, ssl + (size_t)2 * M * 16, 1.0f};
            pg8::gemm_phase<pg8::EpiResidual, pg8::StaticOrder, true, true>(ldsl, g, S, E);
        }
        SEAM(p0 + 4);
        if (EN(6) && IN(p0 + 5)) { PTRS();
            pg8::Gemm g{XB, (const bf16*)(wl + WL_GU2), M, 2 * DFF, DMODEL, DMODEL}; pg8::StaticOrder S; S.init(M, 2 * DFF, G, bx);
            pg8::EpiSwiGLU E{HB, ssl + (size_t)2 * M * 16, DFF};
            pg8::rstd_cache_reset();
            pg8::gemm_phase<pg8::EpiSwiGLU, pg8::StaticOrder, true, true>(ldsl, g, S, E);
        }
        SEAM(p0 + 5);
        if (EN(7) && IN(p0 + 6)) { PTRS();
            pg8::Gemm g{HB, (const bf16*)(wl + WL_D2), M, DMODEL, DFF, DFF}; pg8::StaticOrder S; S.init(M, DMODEL, G, bx);
            pg8::EpiResidual E{(const float*)nullptr, XB, (float*)nullptr, XB, ssl + (size_t)3 * M * 16, 0.5f};
            pg8::gemm_phase<pg8::EpiResidual, pg8::StaticOrder, true, true>(ldsl, g, S, E);
        }
        SEAM(p0 + 6);
    }
    if (EN(8) && IN(15)) {
        UNI(); OPQ_TID();
        const float* ssf = (const float*)(karg_ws() + WS_SS) + (size_t)6 * M * 16; const float* gf = karg_in(I_NF);
        f32x4 gv[4];
#pragma unroll
        for (int j = 0; j < 4; ++j) gv[j] = *((const f32x4*)gf + lane + 64 * j);
        for (int m0 = 4 * (vcu * NWAVES + wave); m0 < M; m0 += 4 * G * NWAVES) {
            f32x4 v[4][4]; float q[4]; const bf16* xbf = (const bf16*)(karg_ws() + WS_XB);
#pragma unroll
            for (int r = 0; r < 4; ++r) { q[r] = ssf[(size_t)(m0 + r) * 16 + (lane & 15)];
#pragma unroll
                for (int j = 0; j < 4; ++j) { const unsigned long long w = ((const unsigned long long*)(xbf + (size_t)(m0 + r) * DMODEL) + lane)[64 * j];
                    v[r][j] = (f32x4){__uint_as_float((unsigned)w << 16), __uint_as_float((unsigned)w & 0xffff0000u), __uint_as_float((unsigned)(w >> 32) << 16), __uint_as_float((unsigned)(w >> 32) & 0xffff0000u)}; } }
#pragma unroll
            for (int r = 0; r < 4; ++r) { const float rstd = __builtin_amdgcn_rsqf(wave_sum(q[r]) * 0.25f * (1.0f / 1024.0f) + 1e-5f);
#pragma unroll
                for (int j = 0; j < 4; ++j) ((f32x4*)(karg_out() + (size_t)(m0 + r) * DMODEL) + lane)[64 * j] = v[r][j] * rstd * gv[j]; }
        }
    }
#undef IN
#undef SEAM
}

extern "C" void kernel_launch(void* const* d_in, const int* in_sizes, int n_in, void* d_out, int out_size, void* d_ws, size_t ws_size, hipStream_t stream) {
    static int grid = 0;
    if (grid == 0) {
        if (n_in != 17 || in_sizes[0] != M * DMODEL || out_size != M * DMODEL || ws_size < WS_END) { fprintf(stderr, "kernel_launch: unexpected shapes (n_in %d, in0 %d, out %d, ws %zu)\n", n_in, n_in > 0 ? in_sizes[0] : -1, out_size, ws_size); grid = -1; return; }
        int dev = 0, cus = 0, per_cu = 0;
        if (hipGetDevice(&dev) != hipSuccess || hipDeviceGetAttribute(&cus, hipDeviceAttributeMultiprocessorCount, dev) != hipSuccess) { grid = -1; return; }
        if (hipFuncSetAttribute((const void*)mega_fwd, hipFuncAttributeMaxDynamicSharedMemorySize, LDS_BYTES) != hipSuccess) { fprintf(stderr, "kernel_launch: hipFuncSetAttribute failed\n"); grid = -1; return; }
        if (hipOccupancyMaxActiveBlocksPerMultiprocessor(&per_cu, (const void*)mega_fwd, NWAVES * 64, LDS_BYTES) != hipSuccess || per_cu < 1) { fprintf(stderr, "kernel_launch: occupancy query says %d\n", per_cu); per_cu = 1; }
        (void)hipGetLastError();
        grid = cus * 1;
    }
    if (grid < 0) return;
    if (hipMemsetAsync((char*)d_ws + WS_CTL, 0, CTL_ZERO_BYTES, stream) != hipSuccess) { fprintf(stderr, "kernel_launch: memset failed\n"); return; }
    Args a{};
    for (int i = 0; i < 17; ++i) a.in[i] = (const float*)d_in[i];
    a.out = (float*)d_out; a.ws = (unsigned char*)d_ws;
#if MK_LAUNCH_PER_PHASE
    for (int p = 0; p < NPHASE; ++p) { a.ph_lo = p; a.ph_hi = p + 1; hipLaunchKernelGGL(mega_fwd, dim3(grid), dim3(NWAVES * 64), LDS_BYTES, stream, a); }
#else
    a.ph_lo = 0; a.ph_hi = NPHASE;
    void* kargs[] = {&a};
    hipError_t e = hipLaunchCooperativeKernel((const void*)mega_fwd, dim3(grid), dim3(NWAVES * 64), kargs, LDS_BYTES, stream);
    if (e != hipSuccess) fprintf(stderr, "kernel_launch: cooperative launch failed: %s (grid %d)\n", hipGetErrorString(e), grid);
#endif
}
```

```cpp
#include <hip/hip_runtime.h>
#include <cstdio>
#include <cstdint>
template <int CTRL> __device__ __forceinline__ float dpp_f(float v) { return __builtin_bit_cast(float, __builtin_amdgcn_update_dpp(0, __builtin_bit_cast(int, v), CTRL, 0xf, 0xf, true)); }
__device__ __forceinline__ float row16_sum(float v) { v += dpp_f<0xB1>(v); v += dpp_f<0x4E>(v); v += dpp_f<0x141>(v); v += dpp_f<0x140>(v); return v; }
__device__ __forceinline__ float row16_max(float v) { v = fmaxf(v, dpp_f<0xB1>(v)); v = fmaxf(v, dpp_f<0x4E>(v)); v = fmaxf(v, dpp_f<0x141>(v)); v = fmaxf(v, dpp_f<0x140>(v)); return v; }
__device__ __forceinline__ float sum_x16_x32(float v) {
    float a = v, b = v; asm volatile("s_nop 1\n\tv_permlane16_swap_b32 %0, %1" : "+v"(a), "+v"(b)); v = a + b;
    a = v; b = v;       asm volatile("s_nop 1\n\tv_permlane32_swap_b32 %0, %1" : "+v"(a), "+v"(b)); return a + b; }
__device__ __forceinline__ float wave_sum_u(float v) { v = row16_sum(v); return (__builtin_bit_cast(float, __builtin_amdgcn_readlane(__builtin_bit_cast(int, v), 0)) + __builtin_bit_cast(float, __builtin_amdgcn_readlane(__builtin_bit_cast(int, v), 16)))
    + (__builtin_bit_cast(float, __builtin_amdgcn_readlane(__builtin_bit_cast(int, v), 32)) + __builtin_bit_cast(float, __builtin_amdgcn_readlane(__builtin_bit_cast(int, v), 48))); }
namespace pg8 {
#define PG8_LAS __attribute__((address_space(3)))
typedef unsigned short bf16_t;
typedef short bf16x8 __attribute__((ext_vector_type(8)));
typedef float f32x4 __attribute__((ext_vector_type(4)));
typedef unsigned u32x4 __attribute__((ext_vector_type(4)));
constexpr int BM = 256, BK = 64, HALF = 128, HTB = HALF * BK * 2  , STAGE_BYTES = 8 * HTB, NXCD = 8, WGM = 8;

__host__ __device__ __forceinline__ int lds_byte(int r, int c) { const int st = (r >> 4) * 2 + (c >> 5), rr = r & 15, cc = c & 31, ob = rr * 64 + cc * 2; return st * 1024 + (ob ^ (((ob >> 9) & 1) << 5)); }
__host__ __device__ __forceinline__ void stage_rc(int b, int& R, int& C) { const int st = b / 1024, sb = b % 1024, swz = sb ^ (((sb >> 9) & 1) << 5); R = (st >> 1) * 16 + swz / 64; C = (st & 1) * 32 + (swz % 64) / 2; }
__host__ __device__ __forceinline__ int perm32(int rho) { const int n = rho >> 4, i = rho & 15; return 8 * (i >> 2) + 4 * n + (i & 3); }

struct Unit { int pm, pn; };
struct Gemm { const bf16_t* A; const bf16_t* Bt; int M, N, K, lda; };

struct StaticOrder {
    int nM, nN, nwg, G, c;
    __host__ __device__ void init(int M, int N, int G_, int c_) { nM = M / BM; nN = N / BM; nwg = nM * nN; G = G_; c = c_; }
    __host__ __device__ bool next(int i, Unit& u) const {
        const long L = (long)i * G + c; if (L >= nwg) return false;
        int wgid = (int)L; { const int q = nwg / NXCD, r = nwg % NXCD, xcd = wgid % NXCD, off = wgid / NXCD; wgid = (xcd < r ? xcd * (q + 1) : r * (q + 1) + (xcd - r) * q) + off; }
        const int nig = WGM * nN, gid = wgid / nig, fm = gid * WGM, gsz = (nM - fm) < WGM ? (nM - fm) : WGM;
        u.pm = fm + ((wgid % nig) % gsz); u.pn = (wgid % nig) / gsz; return true;
    }
    __device__ __forceinline__ void a_ready(const Unit&) const {}
    __device__ __forceinline__ void done(const Unit&) const {}
};

__device__ __forceinline__ unsigned cvt_pk_bf16(float lo, float hi) { unsigned r; asm volatile("v_cvt_pk_bf16_f32 %0, %1, %2" : "=v"(r) : "v"(lo), "v"(hi)); return r; }
typedef float f32x2 __attribute__((ext_vector_type(2)));
constexpr float RMS_EPS = 1e-5f;
__device__ __forceinline__ void row_rstd(float (&rs)[2][4], const float* ss, int row0, int fq) {
#pragma unroll
    for (int ai = 0; ai < 2; ++ai)
#pragma unroll
        for (int m = 0; m < 4; ++m) { const f32x4 v = *(const f32x4*)(ss + (size_t)(row0 + ai * HALF + m * 16) * 16 + fq * 4);
            float s = (v[0] + v[1]) + (v[2] + v[3]); s = sum_x16_x32(s); rs[ai][m] = __builtin_amdgcn_rsqf(s * (1.0f / 1024.0f) + RMS_EPS);     }
}
constexpr int RSC_TAG_OFF = 131072, RSC_VAL_OFF = 131072 + 64;
extern __shared__ __attribute__((aligned(16))) unsigned char pg8_dyn_lds[];
__device__ __forceinline__ void rstd_cache_reset() { if ((threadIdx.x & 63) == 0) ((PG8_LAS int*)((PG8_LAS unsigned char*)pg8_dyn_lds + RSC_TAG_OFF))[threadIdx.x >> 6] = -1; }
__device__ __forceinline__ void row_rstd_cached(float (&rs)[2][4], const float* ss, int pm, int wr, int wc, int fr, int fq) {
    const int wid = wr * 4 + wc, lane = fq * 16 + fr;
    PG8_LAS int* tag = (PG8_LAS int*)((PG8_LAS unsigned char*)pg8_dyn_lds + RSC_TAG_OFF) + wid;
    PG8_LAS f32x4* val = (PG8_LAS f32x4*)((PG8_LAS unsigned char*)pg8_dyn_lds + RSC_VAL_OFF) + (wid * 64 + lane) * 2;
    if (__builtin_amdgcn_readfirstlane(tag[0]) == pm) { const f32x4 a = val[0], b = val[1];
        rs[0][0] = a[0]; rs[0][1] = a[1]; rs[0][2] = a[2]; rs[0][3] = a[3]; rs[1][0] = b[0]; rs[1][1] = b[1]; rs[1][2] = b[2]; rs[1][3] = b[3]; }
    else { row_rstd(rs, ss, pm * BM + wr * 64 + fr, fq);
        val[0] = (f32x4){rs[0][0], rs[0][1], rs[0][2], rs[0][3]}; val[1] = (f32x4){rs[1][0], rs[1][1], rs[1][2], rs[1][3]};
        if (lane == 0) tag[0] = pm; }
}
__device__ __forceinline__ float silu_mul(float g, float u) { const float e = __builtin_amdgcn_exp2f(g * -1.4426950408889634f); return g * u * __builtin_amdgcn_rcpf(1.0f + e); }
struct EpiSwiGLU {
    static constexpr bool PERM = false, AFTER_DRAIN = false;
    bf16_t* H; const float* ss; int ldh;
    __device__ __forceinline__ void operator()(const f32x4 (&acc)[2][2][4][2], const Unit& u, int wr, int wc, int fr, int fq) const {
        const int row0 = u.pm * BM + wr * 64 + fr; float rs[2][4]; row_rstd_cached(rs, ss, u.pm, wr, wc, fr, fq);
        const int col0 = u.pn * HALF + wc * 32 + 8 * fq;
#pragma unroll
        for (int ai = 0; ai < 2; ++ai)
#pragma unroll
            for (int m = 0; m < 4; ++m) { const float r = rs[ai][m]; bf16_t* rowp = H + (size_t)(row0 + ai * HALF + m * 16) * ldh + col0;
                const f32x4 g0 = acc[ai][0][m][0] * r, g1 = acc[ai][0][m][1] * r, u0 = acc[ai][1][m][0] * r, u1 = acc[ai][1][m][1] * r;
                u32x4 w; w.x = cvt_pk_bf16(silu_mul(g0[0], u0[0]), silu_mul(g0[1], u0[1])); w.y = cvt_pk_bf16(silu_mul(g0[2], u0[2]), silu_mul(g0[3], u0[3]));
                w.z = cvt_pk_bf16(silu_mul(g1[0], u1[0]), silu_mul(g1[1], u1[1])); w.w = cvt_pk_bf16(silu_mul(g1[2], u1[2]), silu_mul(g1[3], u1[3]));
                *(u32x4*)rowp = w; }
    }
};
struct EpiResidual {
    static constexpr bool PERM = false, AFTER_DRAIN = false;
    const float* src; const bf16_t* srcb; float* dst; bf16_t* xb; float* ss_out; float scale;
    __device__ __forceinline__ void operator()(const f32x4 (&acc)[2][2][4][2], const Unit& u, int wr, int wc, int fr, int fq) const {
        const int row0 = u.pm * BM + wr * 64 + fr, col0 = u.pn * BM + wc * 32 + 8 * fq;
#pragma unroll
        for (int ai = 0; ai < 2; ++ai) {
          u32x4 xov[4][2];
          if (!src) {
#pragma unroll
                for (int m = 0; m < 4; ++m)
#pragma unroll
                    for (int bj = 0; bj < 2; ++bj) xov[m][bj] = *(const u32x4*)(srcb + (size_t)(row0 + ai * HALF + m * 16) * 1024 + col0 + bj * HALF);
          }
#pragma unroll
            for (int m = 0; m < 4; ++m) { const int row = row0 + ai * HALF + m * 16; float q = 0.f;
#pragma unroll
                for (int bj = 0; bj < 2; ++bj) { const size_t off = (size_t)row * 1024 + col0 + bj * HALF;
                    f32x4 a, b;
                    if (src) { a = *(const f32x4*)(src + off); b = *(const f32x4*)(src + off + 4); }
                    else { const u32x4 xo = xov[m][bj];
                        a = (f32x4){__uint_as_float(xo.x << 16), __uint_as_float(xo.x & 0xffff0000u), __uint_as_float(xo.y << 16), __uint_as_float(xo.y & 0xffff0000u)};
                        b = (f32x4){__uint_as_float(xo.z << 16), __uint_as_float(xo.z & 0xffff0000u), __uint_as_float(xo.w << 16), __uint_as_float(xo.w & 0xffff0000u)}; }
                    a = a + acc[ai][bj][m][0] * scale; b = b + acc[ai][bj][m][1] * scale;
                    if (dst) { *(f32x4*)(dst + off) = a; *(f32x4*)(dst + off + 4) = b; }
                    u32x4 w; w.x = cvt_pk_bf16(a[0], a[1]); w.y = cvt_pk_bf16(a[2], a[3]); w.z = cvt_pk_bf16(b[0], b[1]); w.w = cvt_pk_bf16(b[2], b[3]);
                    if (xb) *(u32x4*)(xb + off) = w;
                    q += (a[0] * a[0] + a[1] * a[1]) + (a[2] * a[2] + a[3] * a[3]) + (b[0] * b[0] + b[1] * b[1]) + (b[2] * b[2] + b[3] * b[3]); }
                q = sum_x16_x32(q);
                if (fq == 0) ss_out[(size_t)row * 16 + u.pn * 4 + wc] = q; }
        }
    }
};
struct EpiQKV {
    static constexpr bool PERM = false, AFTER_DRAIN = false;
    bf16_t* O; const float* ss; const float* cosT; const float* sinT; float qscale; unsigned* nrm;
    __device__ __forceinline__ void operator()(const f32x4 (&acc)[2][2][4][2], const Unit& u, int wr, int wc, int fr, int fq) const {
        typedef unsigned u32x2v __attribute__((ext_vector_type(2)));
        const int row0 = u.pm * BM + wr * 64 + fr; float rs[2][4]; row_rstd_cached(rs, ss, u.pm, wr, wc, fr, fq);
        const int pn = u.pn, rg = pn >> 1; const bool rope = (pn >= 6 && pn < 10);
        const int cbase = (rg == 0 ? 0 : rg == 1 ? 1024 : rg == 2 ? 1536 : rg == 3 ? 512 : rg == 4 ? 2048 : 2560) + (pn & 1) * 256; const float sc = (pn < 2 || pn == 6 || pn == 7) ? qscale : 1.0f;
        if (!rope) {
            const int col0 = cbase + wc * 32 + 8 * fq; float mx[2] = {0.f, 0.f};
#pragma unroll
            for (int ai = 0; ai < 2; ++ai)
#pragma unroll
                for (int m = 0; m < 4; ++m) { const float r = rs[ai][m] * sc; bf16_t* rowp = O + (size_t)(row0 + ai * HALF + m * 16) * 3584 + col0;
#pragma unroll
                    for (int bj = 0; bj < 2; ++bj) { const f32x4 v0 = acc[ai][bj][m][0] * r, v1 = acc[ai][bj][m][1] * r;
                        u32x4 w; w.x = cvt_pk_bf16(v0[0], v0[1]); w.y = cvt_pk_bf16(v0[2], v0[3]); w.z = cvt_pk_bf16(v1[0], v1[1]); w.w = cvt_pk_bf16(v1[2], v1[3]);
                        *(u32x4*)(rowp + bj * HALF) = w;
                        if (pn < 4) { float q = (v0[0] * v0[0] + v0[1] * v0[1]) + (v0[2] * v0[2] + v0[3] * v0[3]) + (v1[0] * v1[0] + v1[1] * v1[1]) + (v1[2] * v1[2] + v1[3] * v1[3]);
                            q = sum_x16_x32(q); mx[bj] = fmaxf(mx[bj], q); } } }
            if (pn < 4) {
#pragma unroll
                for (int bj = 0; bj < 2; ++bj) { float v = mx[bj]; v = row16_max(v);
                    if (fr == 0 && fq == 0) atomicMax(nrm + (((pn >> 1) * 2 + (u.pm >> 6)) * 8 + (pn & 1) * 4 + 2 * bj + (wc >> 1)) * 2 + (wc & 1), __float_as_uint(v)); } }
        } else {
            const int d0 = 16 * (wc & 1) + 4 * fq, colb = cbase + (wc >> 1) * 64 + d0; float mx[2] = {0.f, 0.f};
#pragma unroll
            for (int ai = 0; ai < 2; ++ai) {
                f32x4 cv[4], sv[4];
#pragma unroll
                for (int m = 0; m < 4; ++m) { const int pos_ = (row0 + ai * HALF + m * 16) & 16383; cv[m] = *(const f32x4*)(cosT + pos_ * 32 + d0); sv[m] = *(const f32x4*)(sinT + pos_ * 32 + d0); }
#pragma unroll
                for (int m = 0; m < 4; ++m) { const int row = row0 + ai * HALF + m * 16; const float r = rs[ai][m] * sc;
                    const f32x4 c4 = cv[m], s4 = sv[m];
                    bf16_t* rowp = O + (size_t)row * 3584 + colb;
#pragma unroll
                    for (int bj = 0; bj < 2; ++bj) { const f32x4 x1 = acc[ai][bj][m][0] * r, x2 = acc[ai][bj][m][1] * r;
                        const f32x4 o1 = x1 * c4 - x2 * s4, o2 = x2 * c4 + x1 * s4;
                        u32x2v w1, w2; w1.x = cvt_pk_bf16(o1[0], o1[1]); w1.y = cvt_pk_bf16(o1[2], o1[3]); w2.x = cvt_pk_bf16(o2[0], o2[1]); w2.y = cvt_pk_bf16(o2[2], o2[3]);
                        *(u32x2v*)(rowp + bj * HALF) = w1; *(u32x2v*)(rowp + bj * HALF + 32) = w2;
                        { float q = (x1[0] * x1[0] + x1[1] * x1[1]) + (x1[2] * x1[2] + x1[3] * x1[3]) + (x2[0] * x2[0] + x2[1] * x2[1]) + (x2[2] * x2[2] + x2[3] * x2[3]);
                          q = sum_x16_x32(q); mx[bj] = fmaxf(mx[bj], q); } } } }
#pragma unroll
            for (int bj = 0; bj < 2; ++bj) { float v = row16_max(mx[bj]);
                if (fr == 0 && fq == 0) atomicMax(nrm + (((pn >> 1) * 2 - 2 + (u.pm >> 6)) * 8 + (pn & 1) * 4 + 2 * bj + (wc >> 1)) * 2 + (wc & 1), __float_as_uint(v)); }
        }
    }
};

template <class Epi, class Sched, bool ALIGN_EPI = false, bool SP2 = false>
__device__ __forceinline__ void gemm_phase(PG8_LAS unsigned char* lds, const Gemm g, const Sched& S, const Epi& E) {
    int tid_ = threadIdx.x; asm volatile("" : "+v"(tid_));
    const int tid = tid_, wid = __builtin_amdgcn_readfirstlane(tid >> 6), lane = tid & 63, wr = wid >> 2, wc = wid & 3, fr = lane & 15, fq = lane >> 4;
    const int K = g.K, nt = K / BK;
    unsigned voffA[2], voffB[2];
#pragma unroll
    for (int i = 0; i < 2; ++i) { int R, C; stage_rc(tid * 16 + i * 8192, R, C); const int Rb = Epi::PERM ? ((R & ~31) + perm32(R & 31)) : R;
        voffA[i] = (unsigned)(R * g.lda + C) * 2u; voffB[i] = (unsigned)(Rb * K + C) * 2u; }
    const size_t kstep = (size_t)(BK * 2);
    const size_t hstep = (size_t)HALF * K * 2;
    const size_t tstep = 2 * hstep;
    const size_t hstepA = (size_t)HALF * g.lda * 2, tstepA = 2 * hstepA;
    const unsigned ldsw = (unsigned)wid * 1024u;
    const int aoff = lds_byte(wr * 64 + fr, fq * 8), boff = lds_byte(wc * 32 + fr, fq * 8);
#define PG8_SA(b, h) (((b) * 2 + (h)) * HTB)
#define PG8_SB(b, h) ((4 + (b) * 2 + (h)) * HTB)
#define PG8_STAGE(bufoff, gbase, voff) do { _Pragma("unroll") for (int _i = 0; _i < 2; ++_i) \
        __builtin_amdgcn_global_load_lds((const unsigned*)((const char*)(gbase) + (voff)[_i]), (PG8_LAS unsigned*)(lds + (bufoff) + ldsw + _i * 8192), 16, 0, 0); } while (0)
#define PG8_LDA(dst, b, h) do { _Pragma("unroll") for (int m = 0; m < 4; ++m) _Pragma("unroll") for (int k = 0; k < 2; ++k) dst[m][k] = *(const PG8_LAS bf16x8*)(lds + PG8_SA(b, h) + aoff + m * 2048 + k * 1024); } while (0)
#define PG8_LDB(dst, b, h) do { _Pragma("unroll") for (int n = 0; n < 2; ++n) _Pragma("unroll") for (int k = 0; k < 2; ++k) dst[n][k] = *(const PG8_LAS bf16x8*)(lds + PG8_SB(b, h) + boff + n * 2048 + k * 1024); } while (0)
#define PG8_MMA(ai, bj, At, Bt) do { __builtin_amdgcn_s_setprio(1); _Pragma("unroll") for (int m = 0; m < 4; ++m) _Pragma("unroll") for (int n = 0; n < 2; ++n) _Pragma("unroll") for (int k = 0; k < 2; ++k) \
        acc[ai][bj][m][n] = __builtin_amdgcn_mfma_f32_16x16x32_bf16(Bt[n][k], At[m][k], acc[ai][bj][m][n], 0, 0, 0); __builtin_amdgcn_s_setprio(0); } while (0)
#define PG8_WAIT_V(n) asm volatile("s_waitcnt vmcnt(" #n ")" ::: "memory")
#define PG8_WAIT_L(n) asm volatile("s_waitcnt lgkmcnt(" #n ")" ::: "memory")
#define PG8_BAR __builtin_amdgcn_s_barrier()
#define PG8_SCHED __builtin_amdgcn_sched_barrier(0)
    Unit cur, nxt; int ui = 0;
    if (!S.next(0, cur)) return;
    f32x4 acc[2][2][4][2];
#pragma unroll
    for (int a = 0; a < 2; ++a)
#pragma unroll
        for (int b = 0; b < 2; ++b)
#pragma unroll
            for (int m = 0; m < 4; ++m)
#pragma unroll
                for (int n = 0; n < 2; ++n) acc[a][b][m][n] = (f32x4){0.f, 0.f, 0.f, 0.f};
    bf16x8 At[4][2], B0[2][2], B1[2][2];
    const char* cA = (const char*)g.A + (size_t)cur.pm * tstepA; const char* cB = (const char*)g.Bt + (size_t)cur.pn * tstep;
    S.a_ready(cur);
    if constexpr (SP2) {
        PG8_STAGE(PG8_SB(0, 0), cB, voffB); PG8_STAGE(PG8_SB(0, 1), cB + hstep, voffB); PG8_STAGE(PG8_SA(0, 0), cA, voffA); PG8_STAGE(PG8_SA(0, 1), cA + hstepA, voffA);
        if (wr == 1) PG8_BAR;
        PG8_WAIT_V(2); PG8_BAR;
        PG8_STAGE(PG8_SB(1, 0), cB + kstep, voffB); PG8_STAGE(PG8_SA(1, 0), cA + kstep, voffA); PG8_STAGE(PG8_SB(1, 1), cB + hstep + kstep, voffB);
        PG8_WAIT_V(6); PG8_BAR;
    } else {
        PG8_STAGE(PG8_SB(0, 0), cB, voffB); PG8_STAGE(PG8_SA(0, 0), cA, voffA); PG8_STAGE(PG8_SB(0, 1), cB + hstep, voffB); PG8_STAGE(PG8_SA(0, 1), cA + hstepA, voffA);
        if (wr == 1) PG8_BAR;
        PG8_WAIT_V(4); PG8_BAR;
        PG8_STAGE(PG8_SB(1, 0), cB + kstep, voffB); PG8_STAGE(PG8_SA(1, 0), cA + kstep, voffA); PG8_STAGE(PG8_SB(1, 1), cB + hstep + kstep, voffB);
        PG8_WAIT_V(6); PG8_BAR;
    }
    for (;;) {
        const bool has_next = S.next(ui + 1, nxt);
        const char* nA = has_next ? (const char*)g.A + (size_t)nxt.pm * tstepA : cA; const char* nB = has_next ? (const char*)g.Bt + (size_t)nxt.pn * tstep : cB;
        for (int t = 0; t < nt; t += 2) {
            const bool last = (t == nt - 2);
            const char* a1 = cA + (size_t)(t + 1) * kstep;
            const char* a2 = last ? nA : cA + (size_t)(t + 2) * kstep; const char* b2 = last ? nB : cB + (size_t)(t + 2) * kstep;
            const char* a3 = a2 + kstep; const char* b3 = b2 + kstep;
            if (last && has_next) S.a_ready(nxt);
            if constexpr (SP2) {
            PG8_LDB(B0, 0, 0); PG8_LDB(B1, 0, 1); PG8_SCHED; PG8_LDA(At, 0, 0); PG8_STAGE(PG8_SA(1, 1), a1 + hstepA, voffA);
            PG8_WAIT_V(8); PG8_WAIT_L(0); PG8_BAR; PG8_MMA(0, 0, At, B0); PG8_MMA(0, 1, At, B1); PG8_BAR; PG8_SCHED;
            PG8_LDA(At, 0, 1); PG8_STAGE(PG8_SB(0, 0), b2, voffB); PG8_STAGE(PG8_SB(0, 1), b2 + hstep, voffB); PG8_STAGE(PG8_SA(0, 0), a2, voffA);
            PG8_WAIT_V(8); PG8_WAIT_L(0); PG8_BAR; PG8_MMA(1, 0, At, B0); PG8_MMA(1, 1, At, B1); PG8_BAR; PG8_SCHED;
            PG8_LDB(B0, 1, 0); PG8_LDB(B1, 1, 1); PG8_SCHED; PG8_LDA(At, 1, 0); PG8_STAGE(PG8_SA(0, 1), a2 + hstepA, voffA);
            PG8_WAIT_V(8); PG8_WAIT_L(0); PG8_BAR; PG8_MMA(0, 0, At, B0); PG8_MMA(0, 1, At, B1); PG8_BAR; PG8_SCHED;
            PG8_LDA(At, 1, 1); PG8_STAGE(PG8_SB(1, 0), b3, voffB); PG8_STAGE(PG8_SB(1, 1), b3 + hstep, voffB); PG8_STAGE(PG8_SA(1, 0), a3, voffA);
            PG8_WAIT_V(8); PG8_WAIT_L(0); PG8_BAR; PG8_MMA(1, 0, At, B0); PG8_MMA(1, 1, At, B1); PG8_BAR; PG8_SCHED;
            } else {
            PG8_LDB(B0, 0, 0); PG8_SCHED; PG8_LDA(At, 0, 0); PG8_STAGE(PG8_SA(1, 1), a1 + hstepA, voffA);
            PG8_WAIT_L(8); PG8_BAR; PG8_WAIT_L(0); PG8_MMA(0, 0, At, B0); PG8_BAR; PG8_SCHED;
            PG8_LDB(B1, 0, 1); PG8_STAGE(PG8_SB(0, 0), b2, voffB);
            PG8_BAR; PG8_WAIT_L(0); PG8_MMA(0, 1, At, B1); PG8_BAR;
            PG8_LDA(At, 0, 1); PG8_STAGE(PG8_SA(0, 0), a2, voffA);
            PG8_BAR; PG8_WAIT_L(0); PG8_MMA(1, 0, At, B0); PG8_BAR; PG8_SCHED;
            PG8_STAGE(PG8_SB(0, 1), b2 + hstep, voffB);
            PG8_WAIT_V(6); PG8_BAR; PG8_MMA(1, 1, At, B1); PG8_BAR;
            PG8_LDB(B0, 1, 0); PG8_SCHED; PG8_LDA(At, 1, 0); PG8_STAGE(PG8_SA(0, 1), a2 + hstepA, voffA);
            PG8_WAIT_L(8); PG8_BAR; PG8_WAIT_L(0); PG8_MMA(0, 0, At, B0); PG8_BAR; PG8_SCHED;
            PG8_LDB(B1, 1, 1); PG8_STAGE(PG8_SB(1, 0), b3, voffB);
            PG8_BAR; PG8_WAIT_L(0); PG8_MMA(0, 1, At, B1); PG8_BAR;
            PG8_LDA(At, 1, 1); PG8_STAGE(PG8_SA(1, 0), a3, voffA);
            PG8_BAR; PG8_WAIT_L(0); PG8_MMA(1, 0, At, B0); PG8_BAR; PG8_SCHED;
            PG8_STAGE(PG8_SB(1, 1), b3 + hstep, voffB);
            PG8_WAIT_V(6); PG8_BAR; PG8_MMA(1, 1, At, B1); PG8_BAR;
            }
        }
        if constexpr (ALIGN_EPI) { if (wr == 0) PG8_BAR; }
        if constexpr (!Epi::AFTER_DRAIN) { E(acc, cur, wr, wc, fr, fq); S.done(cur); }
        if (!has_next) break;
#pragma unroll
        for (int a = 0; a < 2; ++a)
#pragma unroll
            for (int b = 0; b < 2; ++b)
#pragma unroll
                for (int m = 0; m < 4; ++m)
#pragma unroll
                    for (int n = 0; n < 2; ++n) acc[a][b][m][n] = (f32x4){0.f, 0.f, 0.f, 0.f};
        cur = nxt; cA = nA; cB = nB; ++ui;
        if constexpr (ALIGN_EPI) { if (wr == 1) PG8_BAR; }
    }
    PG8_WAIT_V(0);
    if constexpr (!ALIGN_EPI) { if (wr == 0) PG8_BAR; }
    PG8_BAR;
    if constexpr (Epi::AFTER_DRAIN) { E.fused(acc, cur, wr, wc, fr, fq, lds, wid, lane); S.done(cur); }
#undef PG8_SA
#undef PG8_SB
#undef PG8_STAGE
#undef PG8_LDA
#undef PG8_LDB
#undef PG8_MMA
#undef PG8_WAIT_V
#undef PG8_WAIT_L
#undef PG8_BAR
#undef PG8_SCHED
}
}

#ifndef PG8_SP2
#define PG8_SP2 true
#endif
#ifndef PG8_ALIGN
#define PG8_ALIGN true
#endif
#include <hip/hip_bf16.h>
#include <cmath>
namespace attn_body {
using bf16=__hip_bfloat16;
using bf16x8=__attribute__((ext_vector_type(8)))short;
using s16x4=__attribute__((ext_vector_type(4)))short;
using f32x16=__attribute__((ext_vector_type(16)))float;
using u32x4=__attribute__((ext_vector_type(4)))unsigned;
constexpr int BATCH=2,SEQ=16384,D=64,PQ=3584;
constexpr int NW=8,QBLK=32,QB=QBLK*NW,KVBLK=64,NQB=SEQ/QB;
constexpr int ATTN_UNIT_ROWS=QB; typedef float f32x4_t __attribute__((ext_vector_type(4)));
__device__ __forceinline__ int crow(int r,int hi){return (r&3)+8*(r>>2)+4*hi;}
#define SBAR() __builtin_amdgcn_sched_barrier(0)
__device__ __forceinline__ void cmask(f32x16&p0,f32x16&p1,int jb,int qrel,int hi){
  const float NEG=-INFINITY; int kb=64*jb+4*hi;
  #pragma unroll
  for(int r=0;r<16;++r){int kv=kb+(r&3)+8*(r>>2); if(kv>qrel)p0[r]=NEG; if(kv+32>qrel)p1[r]=NEG;}
}

constexpr int NSLOT=3, SLOTB=8192;
constexpr int LDS_K=0, LDS_V=NSLOT*SLOTB, LDS_WS=2*NSLOT*SLOTB, LDS_OST=LDS_WS+NW*64*4, LDS_BYTES=LDS_OST+NW*4096;
constexpr int NCS_OFF=LDS_BYTES;
constexpr float C2=0.125f*1.4426950408889634f;
__device__ __forceinline__ void glds16(const void*gsrc,unsigned lds_dst){unsigned keep;
  asm volatile("s_mov_b32 %0, m0\n\ts_mov_b32 m0, %2\n\ts_nop 0\n\tglobal_load_lds_dwordx4 %1, off\n\ts_mov_b32 m0, %0":"=&s"(keep):"v"(gsrc),"s"(lds_dst):"memory");}
__device__ __forceinline__ float max3f(float a,float b,float c){float r;asm("v_max3_f32 %0, %1, %2, %3":"=v"(r):"v"(a),"v"(b),"v"(c));return r;}
__device__ __forceinline__ float max2f(float a,float b){float r;asm("v_max_f32_e32 %0, %1, %2":"=v"(r):"v"(a),"v"(b));return r;}
__device__ __forceinline__ float fadd_s(float a,float b){float r;asm("v_add_f32_e32 %0, %1, %2":"=v"(r):"v"(a),"v"(b));return r;}
__device__ __forceinline__ float fsub_s(float a,float b){float r;asm("v_sub_f32_e32 %0, %1, %2":"=v"(r):"v"(a),"v"(b));return r;}
typedef float f32x2_t __attribute__((ext_vector_type(2))); typedef __bf16 bf16x2_t __attribute__((ext_vector_type(2)));
__device__ __forceinline__ unsigned cvtpk_s(float lo,float hi){f32x2_t v={lo,hi};bf16x2_t b=__builtin_convertvector(v,bf16x2_t);return __builtin_bit_cast(unsigned,b);}
#define WAIT_BAR(N) asm volatile("s_waitcnt vmcnt(" #N ") lgkmcnt(0)\n\ts_barrier":::"memory")

__device__ __forceinline__ void qkt(f32x16&p0,f32x16&p1,const char*Kslot,const bf16x8*qr,const f32x16&negm,int r32,int hi){
  const char*kb=Kslot+hi*1024+r32*16;
  #pragma unroll
  for(int d0=0;d0<4;++d0){
    const bf16x8 b0=*reinterpret_cast<const bf16x8*>(kb+d0*2048);
    const bf16x8 b1=*reinterpret_cast<const bf16x8*>(kb+d0*2048+512);
    if(d0==0){p0=__builtin_amdgcn_mfma_f32_32x32x16_bf16(b0,qr[0],negm,0,0,0);p1=__builtin_amdgcn_mfma_f32_32x32x16_bf16(b1,qr[0],negm,0,0,0);}
    else{p0=__builtin_amdgcn_mfma_f32_32x32x16_bf16(b0,qr[d0],p0,0,0,0);p1=__builtin_amdgcn_mfma_f32_32x32x16_bf16(b1,qr[d0],p1,0,0,0);}}
}
typedef __attribute__((address_space(3))) const char* lds_cptr;
typedef short v4i16_t __attribute__((ext_vector_type(4)));
__device__ __forceinline__ void kload8(bf16x8*kf,lds_cptr kp){
  kf[0]=*(const __attribute__((address_space(3))) bf16x8*)(kp);      kf[1]=*(const __attribute__((address_space(3))) bf16x8*)(kp+512);
  kf[2]=*(const __attribute__((address_space(3))) bf16x8*)(kp+2048); kf[3]=*(const __attribute__((address_space(3))) bf16x8*)(kp+2560);
  kf[4]=*(const __attribute__((address_space(3))) bf16x8*)(kp+4096); kf[5]=*(const __attribute__((address_space(3))) bf16x8*)(kp+4608);
  kf[6]=*(const __attribute__((address_space(3))) bf16x8*)(kp+6144); kf[7]=*(const __attribute__((address_space(3))) bf16x8*)(kp+6656);
}
__device__ __forceinline__ void kload2(bf16x8*kf,lds_cptr kp,int j){ kf[2*j]=*(const __attribute__((address_space(3))) bf16x8*)(kp+j*2048); kf[2*j+1]=*(const __attribute__((address_space(3))) bf16x8*)(kp+j*2048+512); }
__device__ __forceinline__ s16x4 vtr(lds_cptr p){ return __builtin_bit_cast(s16x4,__builtin_amdgcn_ds_read_tr16_b64_v4i16((__attribute__((address_space(3))) v4i16_t*)p)); }
__device__ __forceinline__ float rowmax(const f32x16&p0,const f32x16&p1){
  float a=max3f(p0[0],p0[1],p1[0]),b=max3f(p0[2],p0[3],p1[1]);a=max3f(a,p1[2],p1[3]);
  #pragma unroll
  for(int r=4;r<16;r+=4){a=max3f(a,p0[r],p0[r+1]);b=max3f(b,p0[r+2],p0[r+3]);a=max3f(a,p1[r],p1[r+1]);b=max3f(b,p1[r+2],p1[r+3]);}
  const float m=max2f(a,b);
  auto rr=__builtin_amdgcn_permlane32_swap(__float_as_uint(m),__float_as_uint(m),false,false);
  return max2f(__uint_as_float(rr[0]),__uint_as_float(rr[1]));
}
__device__ __forceinline__ void pv(f32x16*o,int vb,bf16x8 pa0,bf16x8 pa1,bf16x8 pa2,bf16x8 pa3){
  #pragma unroll
  for(int d0=0;d0<2;++d0){s16x4 lo[4],hi[4];
    #pragma unroll
    for(int ks=0;ks<4;++ks){
      asm volatile("ds_read_b64_tr_b16 %0,%1 offset:%c2":"=&v"(lo[ks]):"v"(vb),"i"(d0*4096+ks*1024):"memory");
      asm volatile("ds_read_b64_tr_b16 %0,%1 offset:%c2":"=&v"(hi[ks]):"v"(vb),"i"(d0*4096+ks*1024+512):"memory");}
    asm volatile("s_waitcnt lgkmcnt(0)":::"memory");SBAR();
    #define PK(k) (bf16x8){lo[k][0],lo[k][1],lo[k][2],lo[k][3],hi[k][0],hi[k][1],hi[k][2],hi[k][3]}
    o[d0]=__builtin_amdgcn_mfma_f32_32x32x16_bf16(pa0,PK(0),o[d0],0,0,0);
    o[d0]=__builtin_amdgcn_mfma_f32_32x32x16_bf16(pa1,PK(1),o[d0],0,0,0);
    o[d0]=__builtin_amdgcn_mfma_f32_32x32x16_bf16(pa2,PK(2),o[d0],0,0,0);
    o[d0]=__builtin_amdgcn_mfma_f32_32x32x16_bf16(pa3,PK(3),o[d0],0,0,0);
    #undef PK
  }
}

#ifndef ATTN_STORE16
#define ATTN_STORE16(p,v) (*(u32x4*)(p)=(v))
#endif
template<int THRL,bool FOX,bool NOMX> __device__ __forceinline__ void attn_unit(int b,int qb,const bf16*Q,const bf16*__restrict__ K,const bf16*__restrict__ V,bf16*O,const float*lc,const float*ctot,const float*nq,const float*nk,char*shm){
  int tid_=threadIdx.x; asm volatile("":"+v"(tid_));   const int tid=tid_,lane=tid&63,r32=lane&31,hi=lane>>5; const int wid=__builtin_amdgcn_readfirstlane(tid>>6);
  const long rowbase=(long)b*SEQ; const int q0=qb*QB;
  const bf16*Qw=Q+(rowbase+q0+wid*QBLK)*PQ;
    typedef __attribute__((address_space(3))) float* lds_fptr;
  const lds_fptr ncs3=(lds_fptr)((__attribute__((address_space(3))) char*)shm+NCS_OFF); float ctq=0.f; int kofs=0;
  if(FOX){
    const lds_fptr pref3=(lds_fptr)((__attribute__((address_space(3))) char*)shm+NCS_OFF+65536);
    __attribute__((address_space(3))) unsigned* cnt3=(__attribute__((address_space(3))) unsigned*)((__attribute__((address_space(3))) char*)shm+NCS_OFF+65536+512);
    const int ntf_=(q0+QB)/KVBLK; const float lcq0_=lc[q0]; float lcj_=0.f; if(tid<ntf_-4)lcj_=lc[64*tid+63]; const float nqk_=(nq[0]+nq[1])*(nk[0]+nk[1]);
    if(wid==0){ const float a_=ctot[2*lane],b_=ctot[2*lane+1]; float s_=a_+b_;
      _Pragma("unroll") for(int o_=1;o_<64;o_<<=1){ const float t_=__builtin_bit_cast(float,__builtin_amdgcn_ds_bpermute((lane-o_)<<2,__builtin_bit_cast(int,s_))); if(lane>=o_)s_+=t_; }
      const float ex_=s_-(a_+b_); pref3[2*lane]=ex_; pref3[2*lane+1]=ex_+a_; if(lane==0)cnt3[0]=0u; }
    asm volatile("s_waitcnt lgkmcnt(0)\n\ts_barrier":::"memory");
    { const float thb_=42.0f+2.1f*sqrtf(nqk_);
      const float cq0_=(lcq0_+pref3[q0>>7])*1.4426950408889634f; bool skip_=false;
      if(tid<ntf_-4){ const int s_=64*tid+63; const float cj_=(lcj_+pref3[s_>>7])*1.4426950408889634f; skip_=(cq0_-cj_)<=-thb_; }
      const unsigned long long bal_=__ballot(skip_); if(lane==0&&bal_)__hip_atomic_fetch_add(cnt3,(unsigned)__popcll(bal_),__ATOMIC_RELAXED,__HIP_MEMORY_SCOPE_WORKGROUP); }
    asm volatile("s_waitcnt lgkmcnt(0)\n\ts_barrier":::"memory");
    kofs=__builtin_amdgcn_readfirstlane((int)(cnt3[0]&~1u))*KVBLK;
    const int n4_=(q0+QB)>>2;
    for(int i_=tid+(kofs>>2);i_<n4_;i_+=NW*64){ const f32x4_t v_=*(const f32x4_t*)(lc+4*i_); const float p_=pref3[i_>>5];
      f32x4_t w_; w_[0]=(v_[0]+p_)*-1.4426950408889634f; w_[1]=(v_[1]+p_)*-1.4426950408889634f; w_[2]=(v_[2]+p_)*-1.4426950408889634f; w_[3]=(v_[3]+p_)*-1.4426950408889634f;
      *(__attribute__((address_space(3))) f32x4_t*)(ncs3+4*i_)=w_; }
  }
  const bf16*Kh=K+(rowbase+kofs)*PQ,*Vh=V+(rowbase+kofs)*PQ;
  const unsigned lds0=(unsigned)(uintptr_t)shm;
  float*wsf=(float*)(shm+LDS_WS)+wid*64;
  const bf16*ksrc=Kh+(long)lane*PQ+wid*8;
  const bf16*vsrc=Vh+(long)(16*(wid&3)+(lane>>2))*PQ+(wid>>2)*32+(lane&3)*8;
  const unsigned kdst=lds0+LDS_K+wid*1024, vdst=lds0+LDS_V+wid*1024;
  #define DMA_K(t,slot) glds16(ksrc+(long)(t)*KVBLK*PQ,(unsigned)__builtin_amdgcn_readfirstlane(kdst+(slot)))
  #define DMA_V(t,slot) glds16(vsrc+(long)(t)*KVBLK*PQ,(unsigned)__builtin_amdgcn_readfirstlane(vdst+(slot)))
  const int vb0=(int)(lds0+LDS_V)+((lane>>4)&1)*32+(lane&3)*8+(4*hi+((lane&15)>>2))*64;
  const char*Kbase=shm+LDS_K; bf16x8 kf[8];
  const lds_cptr shm3=(lds_cptr)shm; const lds_cptr kp0=shm3+LDS_K+hi*1024+r32*16; const lds_cptr vp0=shm3+LDS_V+((lane>>4)&1)*32+(lane&3)*8+(4*hi+((lane&15)>>2))*64;
  const int NT=(q0+QB-kofs)/KVBLK;
  #define CINIT (FOX?f32x16{}:negm)
  #define FBIAS(P0,P1,t) do{ if(FOX){ const float nm_=ctq-mhat; const __attribute__((address_space(3))) f32x4_t* bp_=(const __attribute__((address_space(3))) f32x4_t*)(ncs3+kofs+64*(t)+4*hi); \
    _Pragma("unroll") for(int g_=0;g_<4;++g_){ const f32x4_t b0_=bp_[2*g_]+nm_, b1_=bp_[2*g_+8]+nm_; \
      _Pragma("unroll") for(int j_=0;j_<4;++j_){ P0[4*g_+j_]+=b0_[j_]; P1[4*g_+j_]+=b1_[j_]; } } } \
    }while(0)
  DMA_K(0,0);DMA_V(0,0);DMA_K(1,SLOTB);
  bf16x8 qr[4];
  #pragma unroll
  for(int d0=0;d0<4;++d0)qr[d0]=*reinterpret_cast<const bf16x8*>(&Qw[(long)r32*PQ+d0*16+hi*8]);
  float mhat=0.f,l_reg=0.f;f32x16 o[2];o[0]=f32x16{};o[1]=f32x16{};f32x16 negm=f32x16{}; if(!FOX){asm volatile("":"+v"(negm));}
  const int qrel=wid*QBLK+r32;
  #define CMASK(P0,P1,t) do{int jb_=(t)-(NT-4); if(jb_>=0)cmask(P0,P1,jb_,qrel,hi);}while(0)
  bool resc=false;
  #define START(P0,P1) do{ resc=false; \
    if(!NOMX){ const float rm=rowmax(P0,P1); const float dl=rm; mhat=fadd_s(mhat,dl); \
      _Pragma("unroll") for(int r=0;r<16;++r){P0[r]=fsub_s(P0[r],dl);P1[r]=fsub_s(P1[r],dl);} \
      if(!FOX){ _Pragma("unroll") for(int r=0;r<16;++r)negm[r]=-mhat; asm volatile("":"+v"(negm)); } } \
    _Pragma("unroll") for(int r=0;r<16;++r)P0[r]=__builtin_amdgcn_exp2f(P0[r]); }while(0)
  #define RESC() do{ if(resc){ asm volatile("s_waitcnt lgkmcnt(0)":::"memory"); \
      _Pragma("unroll") for(int d_=0;d_<2;++d_) _Pragma("unroll") for(int r=0;r<16;++r)o[d_][r]*=wsf[crow(r,hi)]; } }while(0)
  f32x16 pA0,pA1,pB0,pB1;
  int sl_prev=0,sl_cur=0,sl_next=SLOTB;
  #define ROT() do{sl_prev=sl_cur;sl_cur=sl_next;sl_next=(sl_next==(NSLOT-1)*SLOTB)?0:sl_next+SLOTB;}while(0)
  DMA_K(2,2*SLOTB);
  WAIT_BAR(3); if(FOX){ ctq=-ncs3[q0+wid*QBLK+r32]; }
  qkt(pA0,pA1,Kbase,qr,CINIT,r32,hi);asm volatile("s_nop 15\n\ts_nop 7":"+v"(pA0),"+v"(pA1));FBIAS(pA0,pA1,0);CMASK(pA0,pA1,0);
  START(pA0,pA1);
  _Pragma("unroll") for(int r=0;r<16;++r)pA1[r]=__builtin_amdgcn_exp2f(pA1[r]);
  WAIT_BAR(0);
  DMA_K(3,0);DMA_V(1,SLOTB);
  ROT();
  kload8(kf,kp0+sl_cur);
  WAIT_BAR(2);
  s16x4 vlo[8],vhi[8]; u32x4 pw0,pw1,pw2,pw3;
  #define PKW(P,B) cvtpk_s(P[B],P[B+1])
  #define PAF(k) __builtin_bit_cast(bf16x8,pw##k)
  #define VFR(i) (bf16x8){vlo[i][0],vlo[i][1],vlo[i][2],vlo[i][3],vhi[i][0],vhi[i][1],vhi[i][2],vhi[i][3]}
  #define PIN(x) asm volatile("":"+v"(x))
  #define MX3(a,b,c) __builtin_fmaxf(__builtin_fmaxf((a),(b)),(c))
  #define GAPA(MF,A0,A1,A2,A3,W0,W1,PW) do{ MF; sacc+=A0; sacc+=A1; sacc+=A2; sacc+=A3; PIN(sacc); W0; W1; PIN(PW); SBAR(); }while(0)
  #define EX(v) __builtin_amdgcn_exp2f(v)
  #define GAPB(MF,X,B) do{ MF; X[B]=EX(X[B]); X[B+1]=EX(X[B+1]); X[B+2]=EX(X[B+2]); X[B+3]=EX(X[B+3]); PIN(X); SBAR(); }while(0)
  #define VRD(i) do{ vlo[i]=vtr(vp_+(((i)>>2)*4096+((i)&3)*1024)); vhi[i]=vtr(vp_+(((i)>>2)*4096+((i)&3)*1024+512)); }while(0)
  #define KRD(G,j) do{ if(G){ kload2(kf,kp0+sl_next,j); SBAR(); } }while(0)
  #define STEP(C0,C1,P0,P1,t,GK,GV,GL) do{ SBAR(); \
    const lds_cptr vp_=vp0+sl_prev; \
    VRD(0); SBAR(); float sacc=(P0[0]+P0[1]); \
    GAPA(C0=__builtin_amdgcn_mfma_f32_32x32x16_bf16(kf[0],qr[0],CINIT,0,0,0), P0[2],P0[3],P0[4],P0[5],     pw0[0]=PKW(P0,0), pw0[1]=PKW(P0,2), pw0); \
    VRD(4); SBAR(); GAPA(C1=__builtin_amdgcn_mfma_f32_32x32x16_bf16(kf[1],qr[0],CINIT,0,0,0), P0[6],P0[7],P0[8],P0[9],     pw0[2]=PKW(P0,4), pw0[3]=PKW(P0,6), pw0); \
    VRD(1); SBAR(); GAPA(C0=__builtin_amdgcn_mfma_f32_32x32x16_bf16(kf[2],qr[1],C0,0,0,0),   P0[10],P0[11],P0[12],P0[13], pw1[0]=PKW(P0,8), pw1[1]=PKW(P0,10), pw1); \
    VRD(5); SBAR(); GAPA(C1=__builtin_amdgcn_mfma_f32_32x32x16_bf16(kf[3],qr[1],C1,0,0,0),   P0[14],P0[15],P1[0],P1[1],   pw1[2]=PKW(P0,12),pw1[3]=PKW(P0,14), pw1); \
    VRD(2); SBAR(); GAPA(C0=__builtin_amdgcn_mfma_f32_32x32x16_bf16(kf[4],qr[2],C0,0,0,0),   P1[2],P1[3],P1[4],P1[5],     pw2[0]=PKW(P1,0), pw2[1]=PKW(P1,2), pw2); \
    VRD(6); SBAR(); GAPA(C1=__builtin_amdgcn_mfma_f32_32x32x16_bf16(kf[5],qr[2],C1,0,0,0),   P1[6],P1[7],P1[8],P1[9],     pw2[2]=PKW(P1,4), pw2[3]=PKW(P1,6), pw2); \
    VRD(3); SBAR(); GAPA(C0=__builtin_amdgcn_mfma_f32_32x32x16_bf16(kf[6],qr[3],C0,0,0,0),   P1[10],P1[11],P1[12],P1[13], pw3[0]=PKW(P1,8), pw3[1]=PKW(P1,10), pw3); \
    VRD(7); SBAR(); GAPA(C1=__builtin_amdgcn_mfma_f32_32x32x16_bf16(kf[7],qr[3],C1,0,0,0),   P1[14],P1[15],0.f,0.f,       pw3[2]=PKW(P1,12),pw3[3]=PKW(P1,14), pw3); \
    l_reg+=sacc; \
    if(GK){DMA_K((t)+3,sl_cur);} if(GV){DMA_V((t)+1,sl_next);} \
    FBIAS(C0,C1,t); CMASK(C0,C1,t); \
    { float a=MX3(C0[0],C0[1],C1[0]),b=MX3(C0[2],C0[3],C1[1]); a=MX3(a,C1[2],C1[3]); \
      _Pragma("unroll") for(int r=4;r<16;r+=4){a=MX3(a,C0[r],C0[r+1]);b=MX3(b,C0[r+2],C0[r+3]);a=MX3(a,C1[r],C1[r+1]);b=MX3(b,C1[r+2],C1[r+3]);} \
      float rm=__builtin_fmaxf(a,b); if(NOMX){rm=0.f;} else { auto rr=__builtin_amdgcn_permlane32_swap(__float_as_uint(rm),__float_as_uint(rm),false,false); rm=__builtin_fmaxf(__uint_as_float(rr[0]),__uint_as_float(rr[1])); } \
      resc=false; \
      if(!NOMX&&__builtin_expect(__any(rm>(float)THRL),0)){ const float dl=__builtin_fmaxf(rm,0.f); mhat+=dl; \
        _Pragma("unroll") for(int r=0;r<16;++r){C0[r]-=dl;C1[r]-=dl;} \
        if(!FOX){ _Pragma("unroll") for(int r=0;r<16;++r)negm[r]=-mhat; asm volatile("":"+v"(negm)); } \
        const float f=__builtin_amdgcn_exp2f(-dl); l_reg*=f; if(hi==0)wsf[r32]=f; resc=true; } } \
    SBAR(); \
    GAPB(o[0]=__builtin_amdgcn_mfma_f32_32x32x16_bf16(PAF(0),VFR(0),o[0],0,0,0), C0,0); \
    GAPB(o[1]=__builtin_amdgcn_mfma_f32_32x32x16_bf16(PAF(0),VFR(4),o[1],0,0,0), C0,4); \
    KRD(GL,0); GAPB(o[0]=__builtin_amdgcn_mfma_f32_32x32x16_bf16(PAF(1),VFR(1),o[0],0,0,0), C0,8); \
    KRD(GL,1); GAPB(o[1]=__builtin_amdgcn_mfma_f32_32x32x16_bf16(PAF(1),VFR(5),o[1],0,0,0), C0,12); \
    KRD(GL,2); GAPB(o[0]=__builtin_amdgcn_mfma_f32_32x32x16_bf16(PAF(2),VFR(2),o[0],0,0,0), C1,0); \
    KRD(GL,3); GAPB(o[1]=__builtin_amdgcn_mfma_f32_32x32x16_bf16(PAF(2),VFR(6),o[1],0,0,0), C1,4); \
    GAPB(o[0]=__builtin_amdgcn_mfma_f32_32x32x16_bf16(PAF(3),VFR(3),o[0],0,0,0), C1,8); \
    GAPB(o[1]=__builtin_amdgcn_mfma_f32_32x32x16_bf16(PAF(3),VFR(7),o[1],0,0,0), C1,12); \
    }while(0)
  int t=1;
  #undef CMASK
  #define CMASK(P0,P1,t) do{}while(0)
  for(;t+5<NT;t+=2){
    STEP(pB0,pB1,pA0,pA1,t,true,true,true);     WAIT_BAR(2); RESC(); ROT();
    STEP(pA0,pA1,pB0,pB1,t+1,true,true,true);   WAIT_BAR(2); RESC(); ROT();
  }
  #undef CMASK
  #define CMASK(P0,P1,t) do{int jb_=(t)-(NT-4); if(jb_>=0)cmask(P0,P1,jb_,qrel,hi);}while(0)
  #define ENDW(tt) do{ if((tt)+3<NT){WAIT_BAR(2);} else if((tt)+2<NT){WAIT_BAR(1);} else {WAIT_BAR(0);} }while(0)
  for(;t+1<NT;t+=2){
    STEP(pB0,pB1,pA0,pA1,t,(t+3<NT),(t+1<NT),(t+1<NT));       ENDW(t);   RESC(); ROT();
    STEP(pA0,pA1,pB0,pB1,t+1,(t+4<NT),(t+2<NT),(t+2<NT));     ENDW(t+1); RESC(); ROT();
  }
  STEP(pB0,pB1,pA0,pA1,NT-1,false,false,false); RESC();
  { float sacc=pB0[0]+pB0[1]; _Pragma("unroll") for(int r=2;r<16;++r)sacc+=pB0[r]; _Pragma("unroll") for(int r=0;r<16;++r)sacc+=pB1[r]; l_reg+=sacc;
    pw0=(u32x4){PKW(pB0,0),PKW(pB0,2),PKW(pB0,4),PKW(pB0,6)};pw1=(u32x4){PKW(pB0,8),PKW(pB0,10),PKW(pB0,12),PKW(pB0,14)};pw2=(u32x4){PKW(pB1,0),PKW(pB1,2),PKW(pB1,4),PKW(pB1,6)};pw3=(u32x4){PKW(pB1,8),PKW(pB1,10),PKW(pB1,12),PKW(pB1,14)};
    SBAR(); pv(o,vb0+sl_cur,PAF(0),PAF(1),PAF(2),PAF(3)); }
  #undef PKW
  #undef PAF
  #undef VFR
  #undef PIN
  #undef MX3
  #undef GAPA
  #undef GAPB
  #undef EX
  #undef VRD
  #undef KRD
  #undef STEP
  #undef ENDW
  {auto rr=__builtin_amdgcn_permlane32_swap(__float_as_uint(l_reg),__float_as_uint(l_reg),false,false);l_reg=__uint_as_float(rr[0])+__uint_as_float(rr[1]);}
  if(hi==0)wsf[32+r32]=l_reg;asm volatile("s_waitcnt lgkmcnt(0)":::"memory");
  float rli[16];
  #pragma unroll
  for(int r=0;r<16;++r)rli[r]=__builtin_amdgcn_rcpf(wsf[32+crow(r,hi)]);
  bf16*Ow=O+(rowbase+q0+wid*QBLK)*PQ;
  { bf16*stg=(bf16*)(shm+LDS_OST)+wid*2048;
    #pragma unroll
    for(int r=0;r<16;++r){const int orow=crow(r,hi);
      #pragma unroll
      for(int d0=0;d0<2;++d0)stg[orow*64+d0*32+r32]=__float2bfloat16(o[d0][r]*rli[r]);}
    asm volatile("s_waitcnt lgkmcnt(0)":::"memory");
    #pragma unroll
    for(int i=0;i<4;++i){const int row=i*8+(lane>>3),ch=lane&7; const u32x4 v=*(const u32x4*)(stg+row*64+ch*8); ATTN_STORE16(Ow+(long)row*PQ+ch*8,v);} }
  asm volatile("s_waitcnt lgkmcnt(0)\n\ts_barrier":::"memory");
  #undef FBIAS
  #undef CINIT
  #undef DMA_K
  #undef DMA_V
  #undef CMASK
  #undef START
  #undef RESC
  #undef ROT
}
constexpr int XK=0, XV=16384, XWS=49152, XOST=51200, DV128_LDS_BYTES=XOST+NW*4096;
template<int THRL> __device__ __forceinline__ void attn_unit_dv128(int b,int qb,const bf16*Q,const bf16*__restrict__ K,const bf16*__restrict__ V,bf16*O,const float*nq,const float*nk,char*shm){
  int tid_=threadIdx.x; asm volatile("":"+v"(tid_)); const int tid=tid_,lane=tid&63,r32=lane&31,hi=lane>>5; const int wid=__builtin_amdgcn_readfirstlane(tid>>6);
  const long rowbase=(long)b*SEQ; const int q0=qb*QB;
  const bf16*Qw=Q+(rowbase+q0+wid*QBLK)*PQ;
  const bf16*Kh=K+rowbase*PQ,*Vh=V+rowbase*PQ;
  const unsigned lds0=(unsigned)(uintptr_t)shm;
  typedef __attribute__((address_space(3))) float* lds_fptr;
  const lds_fptr wsf=(lds_fptr)((__attribute__((address_space(3))) char*)shm+XWS)+wid*64;
  const bf16*ksrc=Kh+(long)lane*PQ+wid*8;
  const bf16*vsrc=Vh+(long)(16*(wid&3)+(lane>>2))*PQ+(wid>>2)*32+(lane&3)*8;
  const unsigned kdst=lds0+XK+wid*1024, vdst=lds0+XV+wid*1024;
  #define DMA_K(t,slot) glds16(ksrc+(long)(t)*KVBLK*PQ,(unsigned)__builtin_amdgcn_readfirstlane(kdst+(slot)*8192))
  #define DMA_V(t,slot) do{ glds16(vsrc+(long)(t)*KVBLK*PQ,(unsigned)__builtin_amdgcn_readfirstlane(vdst+(slot)*16384)); glds16(vsrc+64+(long)(t)*KVBLK*PQ,(unsigned)__builtin_amdgcn_readfirstlane(vdst+(slot)*16384+8192)); }while(0)
  const int vb0=(int)(lds0+XV)+((lane>>4)&1)*32+(lane&3)*8+(4*hi+((lane&15)>>2))*64;
  const int NT=(q0+QB)/KVBLK;
  const lds_cptr kp0=(lds_cptr)shm+XK+hi*1024+r32*16;
  const lds_cptr vp0=(lds_cptr)shm+XV+((lane>>4)&1)*32+(lane&3)*8+(4*hi+((lane&15)>>2))*64;
  DMA_K(0,0);
  bf16x8 qr[4];
  #pragma unroll
  for(int d0=0;d0<4;++d0)qr[d0]=*reinterpret_cast<const bf16x8*>(&Qw[(long)r32*PQ+d0*16+hi*8]);
  float mhat=0.f,l_reg=0.f; f32x16 o[4]; o[0]=f32x16{};o[1]=f32x16{};o[2]=f32x16{};o[3]=f32x16{}; f32x16 negm=f32x16{};
  const int qrel=wid*QBLK+r32;
  u32x4 pw0=u32x4{},pw1=u32x4{},pw2=u32x4{},pw3=u32x4{};
  #define MX3(a,b,c) __builtin_fmaxf(__builtin_fmaxf((a),(b)),(c))
  #define PKW(P,B) cvtpk_s(P[B],P[B+1])
  #define SBAR_() __builtin_amdgcn_sched_barrier(0)
  #define VLOAD(VP) do{ _Pragma("unroll") for(int i_=0;i_<8;++i_){ vlo[i_]=vtr((VP)+(i_>>2)*4096+(i_&3)*1024); vhi[i_]=vtr((VP)+(i_>>2)*4096+(i_&3)*1024+512); } }while(0)
  #define VFR_(i) (bf16x8){vlo[i][0],vlo[i][1],vlo[i][2],vlo[i][3],vhi[i][0],vhi[i][1],vhi[i][2],vhi[i][3]}
  #define PAF_(k) __builtin_bit_cast(bf16x8,pw##k)
  #define VMMA(OA,OB) do{ \
      OA=__builtin_amdgcn_mfma_f32_32x32x16_bf16(PAF_(0),VFR_(0),OA,0,0,0); OB=__builtin_amdgcn_mfma_f32_32x32x16_bf16(PAF_(0),VFR_(4),OB,0,0,0); \
      OA=__builtin_amdgcn_mfma_f32_32x32x16_bf16(PAF_(1),VFR_(1),OA,0,0,0); OB=__builtin_amdgcn_mfma_f32_32x32x16_bf16(PAF_(1),VFR_(5),OB,0,0,0); \
      OA=__builtin_amdgcn_mfma_f32_32x32x16_bf16(PAF_(2),VFR_(2),OA,0,0,0); OB=__builtin_amdgcn_mfma_f32_32x32x16_bf16(PAF_(2),VFR_(6),OB,0,0,0); \
      OA=__builtin_amdgcn_mfma_f32_32x32x16_bf16(PAF_(3),VFR_(3),OA,0,0,0); OB=__builtin_amdgcn_mfma_f32_32x32x16_bf16(PAF_(3),VFR_(7),OB,0,0,0); }while(0)
  #define DV_TILE(T,HASPV,MASKMODE,NOMAX) do{ const int t_=(T); \
    asm volatile("s_waitcnt vmcnt(0) lgkmcnt(0)\n\ts_barrier":::"memory");     \
    if(t_+1<NT){ DMA_K(t_+1,(t_+1)&1); } DMA_V(t_,t_&1); \
    f32x16 p0,p1; float f=1.f; bool resc=false; \
    { bf16x8 kf[8]; kload8(kf,kp0+(t_&1)*8192); SBAR_();                         \
      p0=__builtin_amdgcn_mfma_f32_32x32x16_bf16(kf[0],qr[0],negm,0,0,0); p1=__builtin_amdgcn_mfma_f32_32x32x16_bf16(kf[1],qr[0],negm,0,0,0); \
      p0=__builtin_amdgcn_mfma_f32_32x32x16_bf16(kf[2],qr[1],p0,0,0,0); p1=__builtin_amdgcn_mfma_f32_32x32x16_bf16(kf[3],qr[1],p1,0,0,0); \
      p0=__builtin_amdgcn_mfma_f32_32x32x16_bf16(kf[4],qr[2],p0,0,0,0); p1=__builtin_amdgcn_mfma_f32_32x32x16_bf16(kf[5],qr[2],p1,0,0,0); \
      p0=__builtin_amdgcn_mfma_f32_32x32x16_bf16(kf[6],qr[3],p0,0,0,0); p1=__builtin_amdgcn_mfma_f32_32x32x16_bf16(kf[7],qr[3],p1,0,0,0); } \
    if(MASKMODE==1){ cmask(p0,p1,t_-(NT-4),qrel,hi); } else if(MASKMODE==2){ const int jb=t_-(NT-4); if(jb>=0)cmask(p0,p1,jb,qrel,hi); } \
    if(!(NOMAX)){ \
    float rm; \
    { float a=MX3(p0[0],p0[1],p1[0]),bq=MX3(p0[2],p0[3],p1[1]); a=MX3(a,p1[2],p1[3]); \
      _Pragma("unroll") for(int r=4;r<16;r+=4){a=MX3(a,p0[r],p0[r+1]);bq=MX3(bq,p0[r+2],p0[r+3]);a=MX3(a,p1[r],p1[r+1]);bq=MX3(bq,p1[r+2],p1[r+3]);} \
      rm=__builtin_fmaxf(a,bq); float x0=rm,x1=rm; asm volatile("s_nop 1\n\tv_permlane32_swap_b32 %0, %1":"+v"(x0),"+v"(x1)); rm=__builtin_fmaxf(x0,x1); }     \
      \
    if(HASPV){ resc=__any(rm>(float)THRL); } \
    if(!(HASPV)||resc){ const float dl=(HASPV)?__builtin_fmaxf(rm,0.f):rm; mhat+=dl; f=__builtin_amdgcn_exp2f(-dl);     \
      _Pragma("unroll") for(int r=0;r<16;++r){p0[r]-=dl;p1[r]-=dl;negm[r]=-mhat;} } \
    } \
    { const lds_cptr vp=vp0+((t_-1)&1)*16384; float sacc=0.f;                    \
      s16x4 vlo[8],vhi[8]; \
      if(HASPV){ SBAR_(); VLOAD(vp); SBAR_(); } \
      _Pragma("unroll") for(int r=0;r<16;++r){ p0[r]=__builtin_amdgcn_exp2f(p0[r]); sacc+=p0[r]; } asm volatile("":"+v"(p0),"+v"(sacc));     \
      if(HASPV){ SBAR_(); VMMA(o[0],o[1]); SBAR_(); VLOAD(vp+8192); SBAR_(); } \
      _Pragma("unroll") for(int r=0;r<16;++r){ p1[r]=__builtin_amdgcn_exp2f(p1[r]); sacc+=p1[r]; } asm volatile("":"+v"(p1),"+v"(sacc)); \
      if(HASPV){ SBAR_(); VMMA(o[2],o[3]); SBAR_(); } \
      pw0=(u32x4){PKW(p0,0),PKW(p0,2),PKW(p0,4),PKW(p0,6)}; pw1=(u32x4){PKW(p0,8),PKW(p0,10),PKW(p0,12),PKW(p0,14)}; \
      pw2=(u32x4){PKW(p1,0),PKW(p1,2),PKW(p1,4),PKW(p1,6)}; pw3=(u32x4){PKW(p1,8),PKW(p1,10),PKW(p1,12),PKW(p1,14)}; \
      if(resc){ l_reg*=f; if(hi==0)wsf[r32]=f;                                   \
        asm volatile("s_waitcnt lgkmcnt(0)":::"memory"); \
        _Pragma("unroll") for(int r=0;r<16;++r){ const float fr_=wsf[crow(r,hi)]; o[0][r]*=fr_; o[1][r]*=fr_; o[2][r]*=fr_; o[3][r]*=fr_; } \
        asm volatile("s_waitcnt lgkmcnt(0)":::"memory"); } \
      l_reg+=sacc; } \
  }while(0)
  const float bqk_=1.05f*sqrtf((nq[0]+nq[1])*(nk[0]+nk[1]));
  if(bqk_<40.0f){
    DV_TILE(0,false,2,true);
    { int t=1;
      #pragma unroll 1
      for(;t<NT-4;++t){ DV_TILE(t,true,0,true); }
      #pragma unroll 1
      for(;t<NT;++t){ DV_TILE(t,true,1,true); } }
  } else {
    DV_TILE(0,false,2,false);
    { int t=1;
      #pragma unroll 1
      for(;t<NT-4;++t){ DV_TILE(t,true,0,false); }
      #pragma unroll 1
      for(;t<NT;++t){ DV_TILE(t,true,1,false); } }
  }
  asm volatile("s_waitcnt vmcnt(0) lgkmcnt(0)\n\ts_barrier":::"memory");
  { const lds_cptr vp=vp0+((NT-1)&1)*16384; s16x4 vlo[8],vhi[8]; VLOAD(vp); SBAR_(); VMMA(o[0],o[1]); SBAR_(); VLOAD(vp+8192); SBAR_(); VMMA(o[2],o[3]); }
  #undef DV_TILE
  #undef VLOAD
  #undef VFR_
  #undef PAF_
  #undef VMMA
  #undef SBAR_
  #undef MX3
  #undef PKW
  {float x0=l_reg,x1=l_reg; asm volatile("s_nop 1\n\tv_permlane32_swap_b32 %0, %1":"+v"(x0),"+v"(x1)); l_reg=x0+x1;}
  if(hi==0)wsf[32+r32]=l_reg; asm volatile("s_waitcnt lgkmcnt(0)":::"memory");
  float rli[16];
  #pragma unroll
  for(int r=0;r<16;++r)rli[r]=__builtin_amdgcn_rcpf(wsf[32+crow(r,hi)]);
  bf16*Ow=O+(rowbase+q0+wid*QBLK)*PQ;
  bf16*stg=(bf16*)(shm+XOST)+wid*2048;
  #pragma unroll
  for(int hf=0;hf<2;++hf){
    #pragma unroll
    for(int r=0;r<16;++r){const int orow=crow(r,hi);
      #pragma unroll
      for(int d0=0;d0<2;++d0)stg[orow*64+d0*32+r32]=__float2bfloat16(o[2*hf+d0][r]*rli[r]);}
    asm volatile("s_waitcnt lgkmcnt(0)":::"memory");
    #pragma unroll
    for(int i=0;i<4;++i){const int row=i*8+(lane>>3),ch=lane&7; const u32x4 v=*(const u32x4*)(stg+row*64+ch*8); *(u32x4*)(Ow+(long)row*PQ+hf*64+ch*8)=v;}
    asm volatile("s_waitcnt lgkmcnt(0)":::"memory"); }
  asm volatile("s_waitcnt lgkmcnt(0)\n\ts_barrier":::"memory");
  #undef DMA_K
  #undef DMA_V
}
constexpr int ATTN_LDS_BYTES=LDS_BYTES;
#undef SBAR
#undef WAIT_BAR
}
#include <hip/hip_cooperative_groups.h>
namespace cg = cooperative_groups;
#ifndef MK_LAUNCH_PER_PHASE
#define MK_LAUNCH_PER_PHASE 0
#endif
constexpr int NWAVES = 8;
constexpr int SEQ = 16384, DMODEL = 1024, M = 2 * SEQ, DFF = 2816, INC = 3080, NQKV = 3072, PQ = 3584, NPHASE = 16;
constexpr size_t MiB = 1u << 20;
constexpr size_t WS_CTL = 0  , CTL_ZERO_BYTES = 65536;
constexpr int MISC_OFF = 153600;
constexpr size_t WS_COS = 2 * MiB, WS_SIN = 4 * MiB, WS_LC = 7 * MiB, WS_CT = 8 * MiB, WS_SS = 10 * MiB  , WS_W = 24 * MiB  , WS_XB = 108 * MiB  ,
                 WS_BIG = 172 * MiB, WS_H = WS_BIG  , WS_QKV = WS_BIG  , WS_END = 396 * MiB;
constexpr size_t WL_GU1 = 0, WL_D1 = 11 * MiB, WL_WIN = 11 * MiB + 5632 * 1024, WL_WOUT = WL_WIN + 6 * MiB, WL_GU2 = WL_WOUT + 2 * MiB, WL_D2 = WL_GU2 + 11 * MiB, WL_LAYER = 41 * MiB;
static_assert(WL_D2 + 5632 * 1024 == WL_LAYER, "weight map");
constexpr int LDS_BYTES = 155648;
#define LAS __attribute__((address_space(3)))
typedef unsigned short bf16;
typedef unsigned v4u __attribute__((ext_vector_type(4)));
typedef float f32x4 __attribute__((ext_vector_type(4)));
#define LDS_WAIT() asm volatile("s_waitcnt lgkmcnt(0)" ::: "memory")
__device__ __forceinline__ float wave_sum(float v) { return wave_sum_u(v); }
__device__ __forceinline__ int std8(int o) { return 16 * ((o >> 2) & 1) + 4 * (o >> 3) + (o & 3); }
__device__ __forceinline__ int rowmap(int mode, int nn) {
    if (mode == 0) return (nn & ~31) + std8(nn & 31);
    if (mode == 1) { const int bj = nn >= DFF ? 1 : 0, i = nn - DFF * bj, ip = i & 127; return 256 * (i >> 7) + 128 * bj + (ip & ~31) + std8(ip & 31); }
    const int d = nn & 63; return (nn & ~63) + 32 * ((d >> 4) & 1) + 16 * (d >> 5) + 4 * ((d >> 2) & 3) + (d & 3);
}
__device__ __forceinline__ void conv_item(const float* W, int ldw, int coff, int K, int nblk, const float* gain, bf16* WT, int mode, int base, LAS float* scr, int item, int lane) {
    const int kb = item / nblk, nb = item % nblk, k0 = 64 * kb, n0 = 32 * nb;
    { float wv[32]; const float* wp = W + (size_t)(k0 + (lane >> 5)) * ldw + coff + n0 + (lane & 31);
#pragma unroll
      for (int i = 0; i < 32; ++i) wv[i] = wp[(size_t)(2 * i) * ldw];
      if (gain) {
#pragma unroll
          for (int i = 0; i < 32; ++i) wv[i] *= gain[k0 + 2 * i + (lane >> 5)]; }
#pragma unroll
      for (int i = 0; i < 32; ++i) scr[(2 * i + (lane >> 5)) * 33 + (lane & 31)] = wv[i]; }
    LDS_WAIT(); asm volatile("" ::: "memory");
    const int c = lane & 7;
#pragma unroll
    for (int j = 0; j < 4; ++j) { const int n = (lane >> 3) + 8 * j; const LAS float* s = scr + (8 * c) * 33 + n;
        v4u o; o.x = pg8::cvt_pk_bf16(s[0 * 33], s[1 * 33]); o.y = pg8::cvt_pk_bf16(s[2 * 33], s[3 * 33]); o.z = pg8::cvt_pk_bf16(s[4 * 33], s[5 * 33]); o.w = pg8::cvt_pk_bf16(s[6 * 33], s[7 * 33]);
        *(v4u*)(WT + (size_t)(base + rowmap(mode, n0 + n)) * K + k0 + 8 * c) = o; }
    LDS_WAIT(); asm volatile("" ::: "memory");
}
#define XB_TMO      128
#define XB_XCNT(j)  (256  + 64 * (j))
#define XB_XSUB(j)  (1280 + 64 * (j))
#define XB_XGEN(j)  (2304 + 64 * (j))
#define XB_TOP      3328
#define XB_TOPGEN   3392
#define XCD_BAR_WORDS 3456
#define XB_SPIN_CAP (1u << 18)

__device__ __forceinline__ unsigned xb_ld(unsigned* p)              { return __hip_atomic_load(p, __ATOMIC_RELAXED, __HIP_MEMORY_SCOPE_AGENT); }
__device__ __forceinline__ unsigned xb_add(unsigned* p, unsigned v) { return __hip_atomic_fetch_add(p, v, __ATOMIC_RELAXED, __HIP_MEMORY_SCOPE_AGENT); }
__device__ __forceinline__ unsigned xb_xcc_id() { return (unsigned)__builtin_amdgcn_s_getreg((3 << 11) | 20) & 0xFu; }
#define XB_SPIN(cond, bar) do { unsigned _sp = 0; while (cond) { __builtin_amdgcn_s_sleep(1); \
    if ((++_sp & 255u) == 0u) { if (xb_ld(&(bar)[XB_TMO])) break; if (_sp > XB_SPIN_CAP) { atomicAdd(&(bar)[XB_TMO], 1u); break; } } } } while (0)

struct XcdBarrier {
    unsigned* bar; unsigned x;
    volatile LAS unsigned* st;
};

__device__ __forceinline__ XcdBarrier xcd_barrier_post(unsigned* bar, volatile LAS unsigned* st) {
    XcdBarrier b; b.bar = bar; b.x = xb_xcc_id(); b.st = st;
    if (threadIdx.x == 0) (void)xb_add(&bar[XB_XCNT(b.x)], 1u);
    return b;
}
__device__ __forceinline__ void xcd_barrier_complete(unsigned* bar, unsigned x, unsigned& nloc, unsigned& nx) {
    const unsigned G = gridDim.x * gridDim.y * gridDim.z;
    unsigned sum, cnt, mine, sp = 0u;
    for (;;) {
        sum = 0u; cnt = 0u; mine = 0u;
#pragma unroll
        for (unsigned j = 0; j < 16; ++j) { const unsigned c = xb_ld(&bar[XB_XCNT(j)]); sum += c; cnt += (c > 0u) ? 1u : 0u; mine = (j == x) ? c : mine; }
        if (sum == G) break;
        __builtin_amdgcn_s_sleep(1);
        if ((++sp & 255u) == 0u) { if (xb_ld(&bar[XB_TMO])) break; if (sp > XB_SPIN_CAP) { atomicAdd(&bar[XB_TMO], 1u); break; } }
    }
    nloc = mine > 0u ? mine : 1u; nx = cnt > 0u ? cnt : 1u;
}

__device__ __forceinline__ void xcd_barrier(const XcdBarrier& b) {
    asm volatile("s_waitcnt vmcnt(0)" ::: "memory");
    __syncthreads();
    if (threadIdx.x == 0) {
        unsigned* bar = b.bar;
        __builtin_amdgcn_s_waitcnt(0);
        unsigned nloc = b.st[0], nx = b.st[1];
        if (nloc == 0u) { xcd_barrier_complete(bar, b.x, nloc, nx); b.st[0] = nloc; b.st[1] = nx; }
        const unsigned old = xb_add(&bar[XB_XSUB(b.x)], 1u);
        const unsigned gen = old / nloc;
        if (old + 1u == (gen + 1u) * nloc) {
            __builtin_amdgcn_fence(__ATOMIC_RELEASE, "agent");
            asm volatile("s_waitcnt vmcnt(0)" ::: "memory");
            const unsigned og = xb_add(&bar[XB_TOP], 1u);
            const unsigned tg = og / nx;
            if (og + 1u == (tg + 1u) * nx) xb_add(&bar[XB_TOPGEN], 1u);
            else XB_SPIN(xb_ld(&bar[XB_TOPGEN]) == tg, bar);
            __builtin_amdgcn_fence(__ATOMIC_ACQUIRE, "agent");
            xb_add(&bar[XB_XGEN(b.x)], 1u);
            asm volatile("s_waitcnt vmcnt(0)" ::: "memory");
        } else {
            XB_SPIN(xb_ld(&bar[XB_XGEN(b.x)]) == gen, bar);
            __builtin_amdgcn_fence(__ATOMIC_ACQUIRE, "agent");
            asm volatile("s_waitcnt vmcnt(0)" ::: "memory");
        }
    }
    __syncthreads();
}

struct Args { const float* in[17]; float* out; unsigned char* ws; int ph_lo, ph_hi; };
#define GAS1 __attribute__((address_space(1)))
#define KAS4 __attribute__((address_space(4)))
__device__ __forceinline__ const float* karg_in(int i) { size_t off = 8u * (unsigned)i; asm volatile("" : "+s"(off)); return (const float*)*(const GAS1 float* const KAS4*)((const char KAS4*)__builtin_amdgcn_kernarg_segment_ptr() + off); }
__device__ __forceinline__ float* karg_out() { size_t off = 8u * 17u; asm volatile("" : "+s"(off)); return (float*)*(GAS1 float* const KAS4*)((const char KAS4*)__builtin_amdgcn_kernarg_segment_ptr() + off); }
__device__ __forceinline__ unsigned char* karg_ws() { size_t off = 8u * 18u; asm volatile("" : "+s"(off)); return (unsigned char*)*(GAS1 unsigned char* const KAS4*)((const char KAS4*)__builtin_amdgcn_kernarg_segment_ptr() + off); }
static_assert(offsetof(Args, out) == 8 * 17 && offsetof(Args, ws) == 8 * 18, "kernarg layout");
enum { I_X = 0, I_N1 = 1, I_GU1 = 2, I_D1 = 3, I_NM = 4, I_WIN = 5, I_FB = 6, I_LQ1 = 7, I_LK1 = 8, I_LQ2 = 9, I_LK2 = 10, I_SUB = 11, I_WOUT = 12, I_N2 = 13, I_GU2 = 14, I_D2 = 15, I_NF = 16 };

__device__ __forceinline__ void prologue(LAS unsigned char* lds, int vcu, int G, int tid, int lane, int wave) {
    unsigned char* ws = karg_ws();
    LAS float* scr = (LAS float*)(lds + wave * 16384);
    const int gw = vcu * NWAVES + wave, NGW = G * NWAVES;
    constexpr int J0 = 2816, J1 = 1408, J2 = 768, J3 = 256, J6 = 512, PER_LAYER = 2 * J0 + 2 * J1 + J2 + 3 * J3 + J6;
    for (int it = gw; it < 2 * PER_LAYER; it += NGW) {
        const int l = it / PER_LAYER; int r = it - l * PER_LAYER;
        bf16* wl = (bf16*)(ws + WS_W + (size_t)l * WL_LAYER);
        const float* gu1 = karg_in(I_GU1) + (size_t)l * DMODEL * 2 * DFF; const float* gu2 = karg_in(I_GU2) + (size_t)l * DMODEL * 2 * DFF;
        const float* d1 = karg_in(I_D1) + (size_t)l * DFF * DMODEL; const float* d2 = karg_in(I_D2) + (size_t)l * DFF * DMODEL;
        const float* win = karg_in(I_WIN) + (size_t)l * DMODEL * INC; const float* wout = karg_in(I_WOUT) + (size_t)l * DMODEL * DMODEL;
        const float* n1 = karg_in(I_N1) + l * DMODEL; const float* nm = karg_in(I_NM) + l * DMODEL; const float* n2 = karg_in(I_N2) + l * DMODEL;
        bf16* wwin = (bf16*)((unsigned char*)wl + WL_WIN);
        if (r < J0) { conv_item(gu1, 2 * DFF, 0, DMODEL, 2 * DFF / 32, n1, (bf16*)((unsigned char*)wl + WL_GU1), 1, 0, scr, r, lane); continue; } r -= J0;
        if (r < J1) { conv_item(d1, DMODEL, 0, DFF, DMODEL / 32, nullptr, (bf16*)((unsigned char*)wl + WL_D1), 0, 0, scr, r, lane); continue; } r -= J1;
        if (r < J2) { conv_item(win, INC, 0, DMODEL, 1536 / 32, nm, wwin, 0, 0, scr, r, lane); continue; } r -= J2;
        if (r < J3) { conv_item(win, INC, 1544, DMODEL, 512 / 32, nm, wwin, 2, 1536, scr, r, lane); continue; } r -= J3;
        if (r < J3) { conv_item(win, INC, 2056, DMODEL, 512 / 32, nm, wwin, 2, 2048, scr, r, lane); continue; } r -= J3;
        if (r < J3) { conv_item(win, INC, 2568, DMODEL, 512 / 32, nm, wwin, 0, 2560, scr, r, lane); continue; } r -= J3;
        if (r < J6) { conv_item(wout, DMODEL, 0, DMODEL, DMODEL / 32, nullptr, (bf16*)((unsigned char*)wl + WL_WOUT), 0, 0, scr, r, lane); continue; } r -= J6;
        if (r < J0) { conv_item(gu2, 2 * DFF, 0, DMODEL, 2 * DFF / 32, n2, (bf16*)((unsigned char*)wl + WL_GU2), 1, 0, scr, r, lane); continue; } r -= J0;
        conv_item(d2, DMODEL, 0, DFF, DMODEL / 32, nullptr, (bf16*)((unsigned char*)wl + WL_D2), 0, 0, scr, r, lane);
    }
    const float* x = karg_in(I_X); bf16* XB = (bf16*)(ws + WS_XB); float* ss0 = (float*)(ws + WS_SS);
    for (int m0 = 2 * gw; m0 < M; m0 += 2 * NGW) {
        f32x4 v[2][4];
#pragma unroll
        for (int r = 0; r < 2; ++r)
#pragma unroll
            for (int j = 0; j < 4; ++j) v[r][j] = ((const f32x4*)(x + (size_t)(m0 + r) * DMODEL) + lane)[64 * j];
#pragma unroll
        for (int r = 0; r < 2; ++r) { const int m = m0 + r; float s = 0.f;
#pragma unroll
            for (int j = 0; j < 4; ++j) s += (v[r][j][0] * v[r][j][0] + v[r][j][1] * v[r][j][1]) + (v[r][j][2] * v[r][j][2] + v[r][j][3] * v[r][j][3]);
            s = wave_sum(s);
            unsigned long long* o8 = (unsigned long long*)(XB + (size_t)m * DMODEL) + lane;
#pragma unroll
            for (int j = 0; j < 4; ++j) o8[64 * j] = (unsigned long long)pg8::cvt_pk_bf16(v[r][j][0], v[r][j][1]) | ((unsigned long long)pg8::cvt_pk_bf16(v[r][j][2], v[r][j][3]) << 32);
            if (lane < 16) ss0[(size_t)m * 16 + lane] = lane == 0 ? s : 0.f; }
    }
    float* cosT = (float*)(ws + WS_COS); float* sinT = (float*)(ws + WS_SIN);
    for (int i = vcu * NWAVES * 64 + tid; i < SEQ * 32; i += G * NWAVES * 64) {
        const int pos = i >> 5, d = i & 31; const float inv = 1.0f / powf(10000.0f, (float)d * (1.0f / 32.0f)); const float ang = (float)pos * inv;
        cosT[i] = cosf(ang); sinT[i] = sinf(ang);
    }
}
__device__ __forceinline__ void ff_chunk(int chunk, const bf16* XB, const float* ss, const float* win_l, const float* gain, const float* fbias, float* LC, float* CT, LAS float* sl, int tid, int lane, int wave) {
#pragma unroll 1
    for (int hp = 0; hp < 2; ++hp) {
        float w[16][4];
#pragma unroll
        for (int i = 0; i < 16; ++i) { const int k = (i < 8) ? 8 * lane + i : 512 + 8 * lane + (i - 8); const float g = gain[k];
            const f32x4 a = *(const f32x4*)(win_l + (size_t)k * INC + 1536 + 4 * hp);
            w[i][0] = a[0] * g; w[i][1] = a[1] * g; w[i][2] = a[2] * g; w[i][3] = a[3] * g; }
        const float fb = fbias[4 * hp + (lane & 3)];
#pragma unroll 1
        for (int rr0 = 0; rr0 < 16; rr0 += 4) {
          v4u xav[4], xbv[4]; float ssv[4];
#pragma unroll
          for (int r4 = 0; r4 < 4; ++r4) { const size_t row_ = (size_t)(chunk * 128 + wave * 16 + rr0 + r4);
              xav[r4] = *(const v4u*)(XB + row_ * DMODEL + 8 * lane); xbv[r4] = *(const v4u*)(XB + row_ * DMODEL + 512 + 8 * lane); ssv[r4] = ss[row_ * 16 + (lane & 15)]; }
#pragma unroll
          for (int r4 = 0; r4 < 4; ++r4) {
            const int rr = rr0 + r4;
            const v4u xa = xav[r4], xb = xbv[r4];
            float xs[16];
            xs[0] = __uint_as_float(xa.x << 16); xs[1] = __uint_as_float(xa.x & 0xffff0000u); xs[2] = __uint_as_float(xa.y << 16); xs[3] = __uint_as_float(xa.y & 0xffff0000u);
            xs[4] = __uint_as_float(xa.z << 16); xs[5] = __uint_as_float(xa.z & 0xffff0000u); xs[6] = __uint_as_float(xa.w << 16); xs[7] = __uint_as_float(xa.w & 0xffff0000u);
            xs[8] = __uint_as_float(xb.x << 16); xs[9] = __uint_as_float(xb.x & 0xffff0000u); xs[10] = __uint_as_float(xb.y << 16); xs[11] = __uint_as_float(xb.y & 0xffff0000u);
            xs[12] = __uint_as_float(xb.z << 16); xs[13] = __uint_as_float(xb.z & 0xffff0000u); xs[14] = __uint_as_float(xb.w << 16); xs[15] = __uint_as_float(xb.w & 0xffff0000u);
            float a[4];
#pragma unroll
            for (int h = 0; h < 4; ++h) { float s = 0.f;
#pragma unroll
                for (int i = 0; i < 16; ++i) s += xs[i] * w[i][h];
                a[h] = wave_sum(s); }
            const float q = wave_sum(ssv[r4]) * 0.25f;
            const float rstd = __builtin_amdgcn_rsqf(q * (1.0f / 1024.0f) + 1e-5f);
            const int hh = lane & 3;
            float mine = a[0]; mine = hh == 1 ? a[1] : mine; mine = hh == 2 ? a[2] : mine; mine = hh == 3 ? a[3] : mine;
            const float z = mine * rstd + fb;
            const float lf = fminf(z, 0.f) - log1pf(expf(-fabsf(z)));
            if (lane < 4) sl[(wave * 16 + rr) * 8 + 4 * hp + lane] = lf;
          }
        }
    }
    __syncthreads();
    if (tid < 8) { float c = 0.f; for (int r = 0; r < 128; ++r) { c += sl[r * 8 + tid]; sl[r * 8 + tid] = c; } }
    __syncthreads();
    for (int i = tid; i < 1024; i += NWAVES * 64) { const int h = i >> 7, r = i & 127, row = chunk * 128 + r, b = row >> 14, s = row & 16383; const float v = sl[r * 8 + h];
        LC[((size_t)(b * 8 + h) << 14) + s] = v; if (r == 127) CT[(b * 8 + h) * 128 + (s >> 7)] = v; }
    __syncthreads();
}
__device__ __forceinline__ void diff_combine(int b, int qb, int h, bf16* QKV, float lam, int layer, const float* subln) {
    int tid = threadIdx.x; asm volatile("s_waitcnt vmcnt(0)" : "+v"(tid) :: "memory"); const int lane = tid & 63, wave = __builtin_amdgcn_readfirstlane(tid >> 6);
    int lo_ = layer; asm volatile("" : "+s"(lo_)); const float oscale = lo_ == 0 ? 0.8f : 0.64449094f;
    __builtin_amdgcn_fence(__ATOMIC_ACQUIRE, "agent");
    const size_t row0 = (size_t)b * SEQ + (size_t)qb * 256 + wave * 32; const int ch = lane & 15;
    const f32x4 g0 = *(const f32x4*)(subln + ch * 8) * oscale, g1 = *(const f32x4*)(subln + ch * 8 + 4) * oscale;
    v4u av[8], qv[8];
#pragma unroll
    for (int p = 0; p < 8; ++p) { const size_t row = row0 + p * 4 + (lane >> 4); av[p] = *(const v4u*)(QKV + row * PQ + 3072 + h * 128 + ch * 8); qv[p] = *(const v4u*)(QKV + row * PQ + 512 + h * 128 + ch * 8); }
#pragma unroll
    for (int p = 0; p < 8; ++p) { const size_t row = row0 + p * 4 + (lane >> 4);
        bf16* pq = QKV + row * PQ + 512 + h * 128 + ch * 8;
        const v4u a = av[p], q = qv[p];
        f32x4 d0, d1;
        d0[0] = __uint_as_float(a.x << 16) - lam * __uint_as_float(q.x << 16); d0[1] = __uint_as_float(a.x & 0xffff0000u) - lam * __uint_as_float(q.x & 0xffff0000u);
        d0[2] = __uint_as_float(a.y << 16) - lam * __uint_as_float(q.y << 16); d0[3] = __uint_as_float(a.y & 0xffff0000u) - lam * __uint_as_float(q.y & 0xffff0000u);
        d1[0] = __uint_as_float(a.z << 16) - lam * __uint_as_float(q.z << 16); d1[1] = __uint_as_float(a.z & 0xffff0000u) - lam * __uint_as_float(q.z & 0xffff0000u);
        d1[2] = __uint_as_float(a.w << 16) - lam * __uint_as_float(q.w << 16); d1[3] = __uint_as_float(a.w & 0xffff0000u) - lam * __uint_as_float(q.w & 0xffff0000u);
        float s = (d0[0] * d0[0] + d0[1] * d0[1]) + (d0[2] * d0[2] + d0[3] * d0[3]) + (d1[0] * d1[0] + d1[1] * d1[1]) + (d1[2] * d1[2] + d1[3] * d1[3]);
        s = row16_sum(s);
        const float r = __builtin_amdgcn_rsqf(s * (1.0f / 128.0f) + 1e-5f);
        d0 = d0 * r * g0; d1 = d1 * r * g1;
        v4u o; o.x = pg8::cvt_pk_bf16(d0[0], d0[1]); o.y = pg8::cvt_pk_bf16(d0[2], d0[3]); o.z = pg8::cvt_pk_bf16(d1[0], d1[1]); o.w = pg8::cvt_pk_bf16(d1[2], d1[3]);
        *(v4u*)pq = o; }
}

__global__ void __launch_bounds__(NWAVES * 64, 2) mega_fwd(Args args) {
    extern __shared__ __attribute__((aligned(16))) unsigned char lds[];
    LAS unsigned char* ldsl = (LAS unsigned char*)lds;
#define OPQ_TID() int tid = threadIdx.x; asm volatile("" : "+v"(tid)); const int lane = tid & 63, wave = __builtin_amdgcn_readfirstlane(tid >> 6)
#define UNI() int G = gridDim.x, bx = blockIdx.x; asm volatile("" : "+s"(G), "+s"(bx)); const int vcu = (G % 8 == 0) ? (bx % 8) * (G / 8) + bx / 8 : bx; (void)vcu
    cg::grid_group grid = cg::this_grid();
    if (threadIdx.x < 2) ((volatile LAS unsigned*)(ldsl + MISC_OFF))[threadIdx.x] = 0u;
    __syncthreads();
    XcdBarrier xbar = xcd_barrier_post((unsigned*)(karg_ws() + WS_CTL) + 1024, (volatile LAS unsigned*)(ldsl + MISC_OFF));
#define PTRS() UNI(); unsigned char* ws = karg_ws();     bf16* XB = (bf16*)(ws + WS_XB); bf16* HB = (bf16*)(ws + WS_H); bf16* QKV = (bf16*)(ws + WS_QKV); \
    float* LC = (float*)(ws + WS_LC); float* CT = (float*)(ws + WS_CT); float* SS = (float*)(ws + WS_SS); const float* cosT = (const float*)(ws + WS_COS); const float* sinT = (const float*)(ws + WS_SIN); \
    const unsigned char* wl = ws + WS_W + (size_t)l * WL_LAYER; float* ssl = SS + (size_t)(3 * l) * M * 16; \
    (void)XB; (void)HB; (void)QKV; (void)LC; (void)CT; (void)cosT; (void)sinT; (void)wl; (void)ssl
#ifndef PROBE
#define PROBE 0
#endif
#ifndef PHMASK
#define PHMASK 0x1ff
#endif
#define EN(kind) (((PHMASK) >> (kind)) & 1)
#define IN(k) true
#define SEAM(k) do { if (IN(k) && IN((k) + 1)) { if ((k) == 0) grid.sync(); else xcd_barrier(xbar); } } while (0)
    for (int rp = 0; rp < (PROBE == 1 ? 2 : 1); ++rp)
    if (EN(0) && IN(0)) { UNI(); OPQ_TID(); prologue(ldsl, vcu, G, tid, lane, wave); __syncthreads(); if (PROBE == 1) grid.sync(); }
    if (PROBE == 5) for (int rp = 0; rp < 20; ++rp) grid.sync();
    SEAM(0);
#pragma unroll 1
    for (int l = 0; l < 2; ++l) {
        const int p0 = 1 + 7 * l;
        for (int rp = 0; rp < ((PROBE == 2 && l == 0) ? 3 : 1); ++rp)
        if (EN(1) && IN(p0 + 0)) { PTRS();
            if (PROBE == 2 && rp) grid.sync();
            pg8::Gemm g{XB, (const bf16*)(wl + WL_GU1), M, 2 * DFF, DMODEL, DMODEL}; pg8::StaticOrder S; S.init(M, 2 * DFF, G, bx);
            pg8::EpiSwiGLU E{HB, ssl, DFF};
            pg8::rstd_cache_reset();
            pg8::gemm_phase<pg8::EpiSwiGLU, pg8::StaticOrder, true, true>(ldsl, g, S, E);
        }
        SEAM(p0 + 0);
        if (EN(2) && IN(p0 + 1)) { PTRS();
            pg8::Gemm g{HB, (const bf16*)(wl + WL_D1), M, DMODEL, DFF, DFF}; pg8::StaticOrder S; S.init(M, DMODEL, G, bx);
            pg8::EpiResidual E{l == 0 ? karg_in(I_X) : (const float*)nullptr, XB, (float*)nullptr, XB, ssl + (size_t)1 * M * 16, 0.5f};
            pg8::gemm_phase<pg8::EpiResidual, pg8::StaticOrder, true, true>(ldsl, g, S, E);
        }
        SEAM(p0 + 1);
        for (int rp = 0; rp < (((PROBE == 3 || PROBE == 4) && l == 0) ? 2 : 1); ++rp) {
        if ((PROBE == 3 || PROBE == 4) && rp) grid.sync();
        if (EN(3) && IN(p0 + 2)) { PTRS();
            const float* ssi = ssl + (size_t)1 * M * 16;
            { OPQ_TID();
            for (int chunk = vcu; chunk < M / 128; chunk += G)
                ff_chunk(chunk, XB, ssi, karg_in(I_WIN) + (size_t)l * DMODEL * INC, karg_in(I_NM) + l * DMODEL, karg_in(I_FB) + l * 8, LC, CT, (LAS float*)ldsl, tid, lane, wave); }
            pg8::Gemm g{XB, (const bf16*)(wl + WL_WIN), M, NQKV, DMODEL, DMODEL}; pg8::StaticOrder S; S.init(M, NQKV, G, bx);
            pg8::EpiQKV E{QKV, ssi, cosT, sinT, attn_body::C2, (unsigned*)(ws + WS_CTL + 32768) + l * 128};
            pg8::rstd_cache_reset();
            pg8::gemm_phase<pg8::EpiQKV, pg8::StaticOrder, true, true>(ldsl, g, S, E);
        }
        SEAM(p0 + 2);
        if (EN(4) && IN(p0 + 3)) { PTRS();
            const float lam_init = (l == 0) ? 0.2f : 0.35550906f;
            float lam;
            { OPQ_TID(); (void)wave;
              const float p1 = wave_sum(karg_in(I_LQ1)[l * 64 + lane] * karg_in(I_LK1)[l * 64 + lane]), p2 = wave_sum(karg_in(I_LQ2)[l * 64 + lane] * karg_in(I_LK2)[l * 64 + lane]);
              lam = __int_as_float(__builtin_amdgcn_readfirstlane(__float_as_int(expf(p1) - expf(p2) + lam_init))); }
            const attn_body::bf16* Qb = (const attn_body::bf16*)QKV; attn_body::bf16* Qw = (attn_body::bf16*)QKV;
            for (int v = vcu; v < 256; v += G) {
                { const int bh = v >> 5, b = bh >> 2, h = bh & 3, sp = v & 31;
#pragma unroll 1
                  for (int j = 0; j < 4; ++j) { const int qb = (j & 1) ? sp : 63 - sp, c = j >> 1;
                      const float* nrm = (const float*)(ws + WS_CTL + 32768) + l * 128;
                      attn_body::attn_unit_dv128<8>(b, qb, Qb + 512 + (h * 2 + c) * 64, Qb + 2048 + (h * 2 + c) * 64, Qb + 2560 + h * 128, (c == 0) ? Qw + 3072 + h * 128 : Qw + 512 + h * 128,
                                                    nrm + ((2 * 2 + b) * 8 + h * 2 + c) * 2, nrm + ((3 * 2 + b) * 8 + h * 2 + c) * 2, (char*)lds); }
#pragma unroll 1
                  for (int j = 0; j < 2; ++j) diff_combine(b, j ? sp : 63 - sp, h, QKV, lam, l, karg_in(I_SUB) + l * 128); }
            }
            {
                const float* nrm = (const float*)(ws + WS_CTL + 32768) + l * 128; unsigned* qctr = (unsigned*)(ws + WS_CTL + 40960) + l * 64 + (PROBE == 3 ? rp * 16 : 0);
                volatile LAS unsigned* qw = (volatile LAS unsigned*)(ldsl + MISC_OFF + 16);
#pragma unroll 1
                for (;;) {
                    if (threadIdx.x == 0) qw[0] = atomicAdd(qctr, 1u);
                    __syncthreads();
                    const int idx = __builtin_amdgcn_readfirstlane((int)qw[0]);
                    if (idx >= 1024) break;
                    const int qb = 63 - (idx >> 4), bh = idx & 15, b = bh >> 3, h = bh & 7;
                    const float* nq_ = nrm + ((0 * 2 + b) * 8 + h) * 2; const float* nk_ = nrm + ((1 * 2 + b) * 8 + h) * 2;
                    const bool nomx = 1.05f * sqrtf((nq_[0] + nq_[1]) * (nk_[0] + nk_[1])) < 40.0f;
                    if (nomx) attn_body::attn_unit<8, true, true>(b, qb, Qb + h * 64, Qb + 1024 + h * 64, Qb + 1536 + h * 64, Qw + h * 64, LC + ((size_t)(b * 8 + h) << 14), CT + (b * 8 + h) * 128, nq_, nk_, (char*)lds);
                    else      attn_body::attn_unit<8, true, false>(b, qb, Qb + h * 64, Qb + 1024 + h * 64, Qb + 1536 + h * 64, Qw + h * 64, LC + ((size_t)(b * 8 + h) << 14), CT + (b * 8 + h) * 128, nq_, nk_, (char*)lds); }
            }
        }
        }
        SEAM(p0 + 3);
        if (EN(5) && IN(p0 + 4)) { PTRS();
            pg8::Gemm g{QKV, (const bf16*)(wl + WL_WOUT), M, DMODEL, DMODEL, PQ}; pg8::StaticOrder S; S.init(M, DMODEL, G, bx);
            pg8::EpiResidual E{(const float*)nullptr, XB, (float*)nullptr, XB, ssl + (size_t)2 * M * 16, 1.0f};
            pg8::gemm_phase<pg8::EpiResidual, pg8::StaticOrder, true, true>(ldsl, g, S, E);
        }
        SEAM(p0 + 4);
        if (EN(6) && IN(p0 + 5)) { PTRS();
            pg8::Gemm g{XB, (const bf16*)(wl + WL_GU2), M, 2 * DFF, DMODEL, DMODEL}; pg8::StaticOrder S; S.init(M, 2 * DFF, G, bx);
            pg8::EpiSwiGLU E{HB, ssl + (size_t)2 * M * 16, DFF};
            pg8::rstd_cache_reset();
            pg8::gemm_phase<pg8::EpiSwiGLU, pg8::StaticOrder, true, true>(ldsl, g, S, E);
        }
        SEAM(p0 + 5);
        if (EN(7) && IN(p0 + 6)) { PTRS();
            pg8::Gemm g{HB, (const bf16*)(wl + WL_D2), M, DMODEL, DFF, DFF}; pg8::StaticOrder S; S.init(M, DMODEL, G, bx);
            pg8::EpiResidual E{(const float*)nullptr, XB, (float*)nullptr, XB, ssl + (size_t)3 * M * 16, 0.5f};
            pg8::gemm_phase<pg8::EpiResidual, pg8::StaticOrder, true, true>(ldsl, g, S, E);
        }
        SEAM(p0 + 6);
    }
    if (EN(8) && IN(15)) {
        UNI(); OPQ_TID();
        const float* ssf = (const float*)(karg_ws() + WS_SS) + (size_t)6 * M * 16; const float* gf = karg_in(I_NF);
        f32x4 gv[4];
#pragma unroll
        for (int j = 0; j < 4; ++j) gv[j] = *((const f32x4*)gf + lane + 64 * j);
        for (int m0 = 4 * (vcu * NWAVES + wave); m0 < M; m0 += 4 * G * NWAVES) {
            f32x4 v[4][4]; float q[4]; const bf16* xbf = (const bf16*)(karg_ws() + WS_XB);
#pragma unroll
            for (int r = 0; r < 4; ++r) { q[r] = ssf[(size_t)(m0 + r) * 16 + (lane & 15)];
#pragma unroll
                for (int j = 0; j < 4; ++j) { const unsigned long long w = ((const unsigned long long*)(xbf + (size_t)(m0 + r) * DMODEL) + lane)[64 * j];
                    v[r][j] = (f32x4){__uint_as_float((unsigned)w << 16), __uint_as_float((unsigned)w & 0xffff0000u), __uint_as_float((unsigned)(w >> 32) << 16), __uint_as_float((unsigned)(w >> 32) & 0xffff0000u)}; } }
#pragma unroll
            for (int r = 0; r < 4; ++r) { const float rstd = __builtin_amdgcn_rsqf(wave_sum(q[r]) * 0.25f * (1.0f / 1024.0f) + 1e-5f);
#pragma unroll
                for (int j = 0; j < 4; ++j) ((f32x4*)(karg_out() + (size_t)(m0 + r) * DMODEL) + lane)[64 * j] = v[r][j] * rstd * gv[j]; }
        }
    }
#undef IN
#undef SEAM
}

extern "C" void kernel_launch(void* const* d_in, const int* in_sizes, int n_in, void* d_out, int out_size, void* d_ws, size_t ws_size, hipStream_t stream) {
    static int grid = 0;
    if (grid == 0) {
        if (n_in != 17 || in_sizes[0] != M * DMODEL || out_size != M * DMODEL || ws_size < WS_END) { fprintf(stderr, "kernel_launch: unexpected shapes (n_in %d, in0 %d, out %d, ws %zu)\n", n_in, n_in > 0 ? in_sizes[0] : -1, out_size, ws_size); grid = -1; return; }
        int dev = 0, cus = 0, per_cu = 0;
        if (hipGetDevice(&dev) != hipSuccess || hipDeviceGetAttribute(&cus, hipDeviceAttributeMultiprocessorCount, dev) != hipSuccess) { grid = -1; return; }
        if (hipFuncSetAttribute((const void*)mega_fwd, hipFuncAttributeMaxDynamicSharedMemorySize, LDS_BYTES) != hipSuccess) { fprintf(stderr, "kernel_launch: hipFuncSetAttribute failed\n"); grid = -1; return; }
        if (hipOccupancyMaxActiveBlocksPerMultiprocessor(&per_cu, (const void*)mega_fwd, NWAVES * 64, LDS_BYTES) != hipSuccess || per_cu < 1) { fprintf(stderr, "kernel_launch: occupancy query says %d\n", per_cu); per_cu = 1; }
        (void)hipGetLastError();
        grid = cus * 1;
    }
    if (grid < 0) return;
    if (hipMemsetAsync((char*)d_ws + WS_CTL, 0, CTL_ZERO_BYTES, stream) != hipSuccess) { fprintf(stderr, "kernel_launch: memset failed\n"); return; }
    Args a{};
    for (int i = 0; i < 17; ++i) a.in[i] = (const float*)d_in[i];
    a.out = (float*)d_out; a.ws = (unsigned char*)d_ws;
#if MK_LAUNCH_PER_PHASE
    for (int p = 0; p < NPHASE; ++p) { a.ph_lo = p; a.ph_hi = p + 1; hipLaunchKernelGGL(mega_fwd, dim3(grid), dim3(NWAVES * 64), LDS_BYTES, stream, a); }
#else
    a.ph_lo = 0; a.ph_hi = NPHASE;
    void* kargs[] = {&a};
    hipError_t e = hipLaunchCooperativeKernel((const void*)mega_fwd, dim3(grid), dim3(NWAVES * 64), kargs, LDS_BYTES, stream);
    if (e != hipSuccess) fprintf(stderr, "kernel_launch: cooperative launch failed: %s (grid %d)\n", hipGetErrorString(e), grid);
#endif
}
```
